# Optimizing an MI355X kernel written in HIP

```python
import math
import jax, jax.numpy as jnp
from jax import lax
import numpy as np

D_MODEL = 1024
BATCH = 1
SEQ = 16384
DEPTH = 2

HEAD_DIM = 64
GRID_W = 64
RMS_EPS = 1e-6
NEG = -1e30

A_HEADS = 8
B_HEADS = 8
DILATED_BRANCHES = ((128, 1), (512, 4), (2048, 16))
WIN_BLOCK = 128
NA_ROWS = 8
NA_COLS = 16

C_HEADS = 16
Q_LORA = 384
KV_LORA = 128
QK_NOPE = 64
QK_ROPE = 32
V_DIM = 64
ROPE_THETA = 10000.0
Q_BLOCK = 128

T5_BUCKETS = 32
T5_MAX_DIST = 1024
T5_HEADS = max(A_HEADS, C_HEADS)

D_FF = -(-8 * D_MODEL // (3 * 256)) * 256

N_EVEN = (DEPTH + 1) // 2
N_ODD = DEPTH // 2

kernel_name = "hybrid_dilated_natten_mla_encoder"


def rmsnorm(x, g):
    xf = x.astype(jnp.float32)
    y = xf * lax.rsqrt(jnp.mean(xf * xf, axis=-1, keepdims=True) + RMS_EPS)
    return (y * g.astype(jnp.float32)).astype(x.dtype)


def t5_bucket(rel):
    half = T5_BUCKETS // 2
    max_exact = half // 2
    n = jnp.abs(rel)
    nf = jnp.maximum(n, max_exact).astype(jnp.float32)
    large = max_exact + (jnp.log(nf / max_exact) / math.log(T5_MAX_DIST / max_exact)
                         * (half - max_exact)).astype(jnp.int32)
    large = jnp.minimum(large, half - 1)
    return jnp.where(rel > 0, half, 0) + jnp.where(n < max_exact, n, large)


def t5_bias(t5_table, rel, n_heads):
    return t5_table[:, :n_heads].T[:, t5_bucket(rel)].astype(jnp.float32)


def dilated_branch(q, k, v, t5_table, window, dil):
    B, S, H, D = q.shape
    side = window // (2 * dil)
    L = S // dil
    nb = -(-L // WIN_BLOCK)
    Lp = nb * WIN_BLOCK
    span = WIN_BLOCK + 2 * side

    def to_sub(a):
        return a.reshape(B, L, dil, H, D).transpose(0, 2, 1, 3, 4)

    qs = jnp.pad(to_sub(q), ((0, 0), (0, 0), (0, Lp - L), (0, 0), (0, 0)))
    qs = qs.reshape(B, dil, nb, WIN_BLOCK, H, D)
    kv_pad = ((0, 0), (0, 0), (side, Lp - L + side), (0, 0), (0, 0))
    ks = jnp.pad(to_sub(k), kv_pad)
    vs = jnp.pad(to_sub(v), kv_pad)
    idx = jnp.arange(nb)[:, None] * WIN_BLOCK + jnp.arange(span)[None, :]
    kb = ks[:, :, idx]
    vb = vs[:, :, idx]

    s = jnp.einsum('brnqhd,brnkhd->brnhqk', qs, kb).astype(jnp.float32) * (D ** -0.5)
    j = jnp.arange(span)[None, :] - side - jnp.arange(WIN_BLOCK)[:, None]
    mk = idx - side
    valid = (jnp.abs(j) <= side)[None] & ((mk >= 0) & (mk < L))[:, None, :]
    s = s + t5_bias(t5_table, j * dil, H)[None, None, None]
    s = jnp.where(valid[None, None, :, None], s, NEG)
    m = jnp.max(s, axis=-1, keepdims=True)
    p = jnp.exp(s - m)
    den = jnp.sum(p, axis=-1, keepdims=True)
    o = jnp.einsum('brnhqk,brnkhd->brnqhd', (p / den).astype(v.dtype), vb)
    lse = (m + jnp.log(den))[..., 0]

    o = o.reshape(B, dil, Lp, H, D)[:, :, :L].transpose(0, 2, 1, 3, 4).reshape(B, S, H, D)
    lse = lse.transpose(0, 1, 2, 4, 3).reshape(B, dil, Lp, H)[:, :, :L]
    lse = lse.transpose(0, 2, 1, 3).reshape(B, S, H)
    return o, lse


def dilated_mixture(q, k, v, t5_table):
    outs, lses = [], []
    for window, dil in DILATED_BRANCHES:
        o, l = dilated_branch(q, k, v, t5_table, window, dil)
        outs.append(o)
        lses.append(l)
    w = jax.nn.softmax(jnp.stack(lses, axis=0), axis=0)
    o = jnp.sum(w[..., None] * jnp.stack(outs, axis=0).astype(jnp.float32), axis=0)
    return o.astype(q.dtype)


def neighbourhood_attention(q, k, v, rpb):
    B, S, H, D = q.shape
    rows = S // GRID_W
    kr = min(NA_ROWS, rows)
    kc = NA_COLS
    qg = q.reshape(B, rows, GRID_W, H, D)
    kg = k.reshape(B, rows, GRID_W, H, D)
    vg = v.reshape(B, rows, GRID_W, H, D)
    r = jnp.arange(rows)
    r0 = jnp.clip(r - kr // 2, 0, rows - kr)
    row_idx = r0[:, None] + jnp.arange(kr)[None, :]
    kb = kg[:, row_idx]
    vb = vg[:, row_idx]
    c = jnp.arange(GRID_W)
    c0 = jnp.clip(c - kc // 2, 0, GRID_W - kc)
    col_ok = (c[None, :] >= c0[:, None]) & (c[None, :] < c0[:, None] + kc)

    s = jnp.einsum('brqhd,brkwhd->bhrqkw', qg, kb).astype(jnp.float32) * (D ** -0.5)
    roff = row_idx - r[:, None] + (NA_ROWS - 1)
    coff = jnp.clip(c[None, :] - c[:, None] + (NA_COLS - 1), 0, 2 * NA_COLS - 2)
    bias = rpb[:, roff[:, None, :, None], coff[None, :, None, :]]
    s = s + bias[None].astype(jnp.float32)
    s = jnp.where(col_ok[:, None, :], s, NEG)
    sh = s.shape
    p = jax.nn.softmax(s.reshape(sh[:4] + (kr * GRID_W,)), axis=-1).reshape(sh)
    o = jnp.einsum('bhrqkw,brkwhd->brqhd', p.astype(v.dtype), vb)
    return o.reshape(B, S, H, D)


def even_mixer(h, w_in, rpb, w_out, t5_table):
    B, S, _ = h.shape
    proj = h @ w_in
    a_part = proj[..., :3 * A_HEADS * HEAD_DIM]
    b_part = proj[..., 3 * A_HEADS * HEAD_DIM:]
    qa, ka, va = [t.reshape(B, S, A_HEADS, HEAD_DIM) for t in jnp.split(a_part, 3, axis=-1)]
    qb, kb, vb = [t.reshape(B, S, B_HEADS, HEAD_DIM) for t in jnp.split(b_part, 3, axis=-1)]
    oa = dilated_mixture(qa, ka, va, t5_table)
    ob = neighbourhood_attention(qb, kb, vb, rpb)
    o = jnp.concatenate([oa.reshape(B, S, -1), ob.reshape(B, S, -1)], axis=-1)
    return o @ w_out


def rotate(x, cos, sin):
    half = x.shape[-1] // 2
    x1, x2 = x[..., :half], x[..., half:]
    return jnp.concatenate([x1 * cos - x2 * sin, x1 * sin + x2 * cos], axis=-1)


def mla_mixer(h, w_in, q_norm, w_uq, kv_norm, w_uk, w_uv, w_out, t5_table):
    B, S, _ = h.shape
    H = C_HEADS
    proj = h @ w_in
    cq = rmsnorm(proj[..., :Q_LORA], q_norm)
    ckv = rmsnorm(proj[..., Q_LORA:Q_LORA + KV_LORA], kv_norm)
    kr = proj[..., Q_LORA + KV_LORA:]

    pos = jnp.arange(S, dtype=jnp.float32)
    freqs = ROPE_THETA ** (-jnp.arange(0, QK_ROPE, 2, dtype=jnp.float32) / QK_ROPE)
    ang = pos[:, None] * freqs[None, :]
    cos = jnp.cos(ang).astype(h.dtype)
    sin = jnp.sin(ang).astype(h.dtype)

    q = (cq @ w_uq).reshape(B, S, H, QK_NOPE + QK_ROPE)
    q_nope = q[..., :QK_NOPE]
    q_rope = rotate(q[..., QK_NOPE:], cos[None, :, None], sin[None, :, None])
    k_rope = rotate(kr, cos[None], sin[None])
    k_nope = (ckv @ w_uk).reshape(B, S, H, QK_NOPE)
    v = (ckv @ w_uv).reshape(B, S, H, V_DIM)
    scale = (QK_NOPE + QK_ROPE) ** -0.5

    nb = S // Q_BLOCK
    qn_blocks = q_nope.reshape(B, nb, Q_BLOCK, H, QK_NOPE).transpose(1, 0, 2, 3, 4)
    qr_blocks = q_rope.reshape(B, nb, Q_BLOCK, H, QK_ROPE).transpose(1, 0, 2, 3, 4)
    kpos = jnp.arange(S)

    def block(args):
        qn, qr, i = args
        s = (jnp.einsum('bqhd,bkhd->bhqk', qn, k_nope)
             + jnp.einsum('bqhd,bkd->bhqk', qr, k_rope)).astype(jnp.float32) * scale
        qpos = i * Q_BLOCK + jnp.arange(Q_BLOCK)
        s = s + t5_bias(t5_table, kpos[None, :] - qpos[:, None], H)[None]
        p = jax.nn.softmax(s, axis=-1)
        return jnp.einsum('bhqk,bkhd->bqhd', p.astype(v.dtype), v)

    o = lax.map(block, (qn_blocks, qr_blocks, jnp.arange(nb)))
    o = o.transpose(1, 0, 2, 3, 4).reshape(B, S, H * V_DIM)
    return o @ w_out


def swiglu(h, w_gate, w_up, w_down):
    return (jax.nn.silu(h @ w_gate) * (h @ w_up)) @ w_down


def setup_inputs(seed: int = 0) -> dict:
    key = jax.random.key(seed)
    ks = jax.random.split(key, 20)
    f32 = jnp.float32

    def w(k, shape, fan_in):
        return jax.random.normal(k, shape, f32) * (fan_in ** -0.5)

    def gain(k, shape):
        return 1.0 + 0.01 * jax.random.normal(k, shape, f32)

    mix_a_b = (A_HEADS + B_HEADS) * HEAD_DIM
    return {
        "x": jax.random.normal(ks[0], (BATCH, SEQ, D_MODEL), f32),
        "t5_table": 0.1 * jax.random.normal(ks[1], (T5_BUCKETS, T5_HEADS), f32),
        "attn_norm": gain(ks[2], (DEPTH, D_MODEL)),
        "ffn_norm": gain(ks[3], (DEPTH, D_MODEL)),
        "even_w_in": w(ks[4], (N_EVEN, D_MODEL, 3 * mix_a_b), D_MODEL),
        "na_rpb": 0.1 * jax.random.normal(ks[5], (N_EVEN, B_HEADS, 2 * NA_ROWS - 1, 2 * NA_COLS - 1), f32),
        "even_w_out": w(ks[6], (N_EVEN, mix_a_b, D_MODEL), mix_a_b),
        "odd_w_in": w(ks[7], (N_ODD, D_MODEL, Q_LORA + KV_LORA + QK_ROPE), D_MODEL),
        "mla_q_norm": gain(ks[8], (N_ODD, Q_LORA)),
        "mla_w_uq": w(ks[9], (N_ODD, Q_LORA, C_HEADS * (QK_NOPE + QK_ROPE)), Q_LORA),
        "mla_kv_norm": gain(ks[10], (N_ODD, KV_LORA)),
        "mla_w_uk": w(ks[11], (N_ODD, KV_LORA, C_HEADS * QK_NOPE), KV_LORA),
        "mla_w_uv": w(ks[12], (N_ODD, KV_LORA, C_HEADS * V_DIM), KV_LORA),
        "odd_w_out": w(ks[13], (N_ODD, C_HEADS * V_DIM, D_MODEL), C_HEADS * V_DIM),
        "ffn_w_gate": w(ks[14], (DEPTH, D_MODEL, D_FF), D_MODEL),
        "ffn_w_up": w(ks[15], (DEPTH, D_MODEL, D_FF), D_MODEL),
        "ffn_w_down": w(ks[16], (DEPTH, D_FF, D_MODEL), D_FF),
        "final_norm": gain(ks[17], (D_MODEL,)),
    }


def reference(x, t5_table, attn_norm, ffn_norm, even_w_in, na_rpb, even_w_out,
              odd_w_in, mla_q_norm, mla_w_uq, mla_kv_norm, mla_w_uk, mla_w_uv, odd_w_out,
              ffn_w_gate, ffn_w_up, ffn_w_down, final_norm):
    for layer in range(DEPTH):
        h = rmsnorm(x, attn_norm[layer])
        if layer % 2 == 0:
            i = layer // 2
            x = x + even_mixer(h, even_w_in[i], na_rpb[i], even_w_out[i], t5_table)
        else:
            i = layer // 2
            x = x + mla_mixer(h, odd_w_in[i], mla_q_norm[i], mla_w_uq[i], mla_kv_norm[i],
                              mla_w_uk[i], mla_w_uv[i], odd_w_out[i], t5_table)
        h = rmsnorm(x, ffn_norm[layer])
        x = x + swiglu(h, ffn_w_gate[layer], ffn_w_up[layer], ffn_w_down[layer])
    return rmsnorm(x, final_norm)
```

```cpp
#include <hip/hip_runtime.h>
#include <cstdio>
#include <cstdint>

#ifndef DBG_CHECK
#define DBG_CHECK 0
#endif
#ifndef DBG_TOL
#define DBG_TOL 0.03f
#endif
#ifndef DBG_MAGSLOT
#define DBG_MAGSLOT 0
#endif

#define LAS __attribute__((address_space(3)))
#define GAS __attribute__((address_space(1)))
typedef unsigned short bf16;
typedef short bf16x8 __attribute__((ext_vector_type(8)));
typedef short s16x4 __attribute__((ext_vector_type(4)));
typedef float f32x4 __attribute__((ext_vector_type(4)));
typedef float f32x16 __attribute__((ext_vector_type(16)));
typedef unsigned u32x4 __attribute__((ext_vector_type(4)));
typedef unsigned u32x2 __attribute__((ext_vector_type(2)));
typedef float f32x2_t __attribute__((ext_vector_type(2)));
typedef __bf16 bf16x2_t __attribute__((ext_vector_type(2)));

constexpr int S = 16384, D = 1024, FF = 2816, NQKV = 3072;
constexpr int NIN1 = 544, NIN1P = 768, QL = 384, KVL = 128, KVLP = 256, NQ1 = 1536, NKV1 = 2048, KPITCH = 1536  ;
constexpr float RMS_EPS = 1e-6f, LOG2E = 1.4426950408889634f;
constexpr float C2_LOCAL = 0.125f * LOG2E;
constexpr float C2_MLA = 0.10206207261596577f * LOG2E;
constexpr float NEGB = -1e30f;

constexpr size_t MiB = 1u << 20;
constexpr size_t WS_CTL = 0, CTL_ZERO_BYTES = 1 * MiB;
constexpr size_t CTL_BAR = 16384;
constexpr size_t CTL_SS = 128 * 1024;
constexpr size_t CTL_STATS = 600 * 1024;
constexpr size_t CTL_RSTD = 640 * 1024;
constexpr size_t WS_ROPE = 1 * MiB;
constexpr size_t WS_TDIL = 3 * MiB;
constexpr size_t WS_TMLA = 3 * MiB + 128 * 1024;
constexpr size_t WS_TRPB = 3 * MiB + 256 * 1024;
constexpr size_t WS_W = 8 * MiB;
constexpr size_t W_IN0 = WS_W, W_OUT0 = W_IN0 + 6 * MiB, W_GU0 = W_OUT0 + 2 * MiB, W_D0 = W_GU0 + 11 * MiB, W_IN1 = W_D0 + 6 * MiB,
                 W_UQ = W_IN1 + 2 * MiB, W_UKV = W_UQ + 2 * MiB, W_OUT1 = W_UKV + 1 * MiB, W_GU1 = W_OUT1 + 2 * MiB, W_D1 = W_GU1 + 11 * MiB, W_END = W_D1 + 6 * MiB;
constexpr size_t WS_XB = 57 * MiB;
constexpr size_t WS_O = 89 * MiB;
constexpr size_t WS_BIG = 121 * MiB;
constexpr size_t WS_Q1 = WS_BIG, WS_K1 = WS_BIG + 48 * MiB, WS_V1 = 217 * MiB;
constexpr size_t WS_SAVE = 252 * MiB, WS_END = 256 * MiB;
static_assert(W_END <= WS_XB && WS_V1 + 32 * MiB <= WS_SAVE, "d_ws map");

constexpr int LDS_BYTES = 147456;
constexpr int MISC_OFF = 131072 + 320;
constexpr int LDSCTL_OFF = 131072;

__device__ __forceinline__ float bf2f(unsigned short b) { return __builtin_bit_cast(float, (unsigned)b << 16); }
__device__ __forceinline__ unsigned cvtpk(float lo, float hi) { f32x2_t v = {lo, hi}; bf16x2_t b = __builtin_convertvector(v, bf16x2_t); return __builtin_bit_cast(unsigned, b); }
__device__ __forceinline__ float wave_sum(float v) {
#pragma unroll
    for (int o = 1; o < 64; o <<= 1) v += __shfl_xor(v, o);
    return v;
}

namespace pg8 {
constexpr int BM = 256, BK = 64, HALF = 128, HTB = HALF * BK * 2, STAGE_BYTES = 8 * HTB, NXCD = 8, WGM = 8;
__host__ __device__ __forceinline__ int lds_byte(int r, int c) { const int st = (r >> 4) * 2 + (c >> 5), rr = r & 15, cc = c & 31, ob = rr * 64 + cc * 2; return st * 1024 + (ob ^ (((ob >> 9) & 1) << 5)); }
__host__ __device__ __forceinline__ void stage_rc(int b, int& R, int& C) { const int st = b / 1024, sb = b % 1024, swz = sb ^ (((sb >> 9) & 1) << 5); R = (st >> 1) * 16 + swz / 64; C = (st & 1) * 32 + (swz % 64) / 2; }
__host__ __device__ __forceinline__ int perm32(int rho) { const int n = rho >> 4, i = rho & 15; return 8 * (i >> 2) + 4 * n + (i & 3); }

struct Unit { int pm, pn; };
struct Gemm { const bf16* A; const bf16* Bt; int M, N, K, lda; };

struct StaticOrder {
    int nM, nN, nwg, G, c;
    __device__ void init(int M, int N, int G_, int c_) { nM = M / BM; nN = N / BM; nwg = nM * nN; G = G_; c = c_; }
    __device__ bool next(int i, Unit& u) const {
        const long L = (long)i * G + c; if (L >= nwg) return false;
        int wgid = (int)L; { const int q = nwg / NXCD, r = nwg % NXCD, xcd = wgid % NXCD, off = wgid / NXCD; wgid = (xcd < r ? xcd * (q + 1) : r * (q + 1) + (xcd - r) * q) + off; }
        const int nig = WGM * nN, gid = wgid / nig, fm = gid * WGM, gsz = (nM - fm) < WGM ? (nM - fm) : WGM;
        u.pm = fm + ((wgid % nig) % gsz); u.pn = (wgid % nig) / gsz; return true;
    }
};

typedef f32x4 Acc[2][2][4][2];

struct EpiRowScale {
    bf16* O; int ldc; const float* ss; float invk;
    __device__ __forceinline__ void operator()(const Acc& acc, const Unit& u, int wr, int wc, int fr, int fq) const {
        const int row0 = u.pm * BM + wr * 64 + fr, col0 = u.pn * BM + wc * 32 + 8 * fq;
#pragma unroll
        for (int ai = 0; ai < 2; ++ai)
#pragma unroll
            for (int m = 0; m < 4; ++m) { const int row = row0 + ai * HALF + m * 16; const float rs = __builtin_amdgcn_rsqf(ss[row] * invk + RMS_EPS);
                bf16* rowp = O + (size_t)row * ldc + col0;
#pragma unroll
                for (int bj = 0; bj < 2; ++bj) { const f32x4 v0 = acc[ai][bj][m][0] * rs, v1 = acc[ai][bj][m][1] * rs;
                    u32x4 w; w.x = cvtpk(v0[0], v0[1]); w.y = cvtpk(v0[2], v0[3]); w.z = cvtpk(v1[0], v1[1]); w.w = cvtpk(v1[2], v1[3]);
                    *(u32x4*)(rowp + bj * HALF) = w; } }
    }
};
struct EpiResid {
    const float* R; float* X; bf16* XB; float* ssout;
    __device__ __forceinline__ void operator()(const Acc& acc, const Unit& u, int wr, int wc, int fr, int fq) const {
        const int row0 = u.pm * BM + wr * 64 + fr, col0 = u.pn * BM + wc * 32 + 8 * fq;
#pragma unroll
        for (int ai = 0; ai < 2; ++ai)
#pragma unroll
            for (int m = 0; m < 4; ++m) { const int row = row0 + ai * HALF + m * 16; const size_t off = (size_t)row * D + col0; float sq = 0.f;
#pragma unroll
                for (int bj = 0; bj < 2; ++bj) { const f32x4 r0 = *(const f32x4*)(R + off + bj * HALF), r1 = *(const f32x4*)(R + off + bj * HALF + 4);
                    const f32x4 v0 = acc[ai][bj][m][0] + r0, v1 = acc[ai][bj][m][1] + r1;
                    *(f32x4*)(X + off + bj * HALF) = v0; *(f32x4*)(X + off + bj * HALF + 4) = v1;
                    u32x4 w; w.x = cvtpk(v0[0], v0[1]); w.y = cvtpk(v0[2], v0[3]); w.z = cvtpk(v1[0], v1[1]); w.w = cvtpk(v1[2], v1[3]);
                    *(u32x4*)(XB + off + bj * HALF) = w;
                    sq += (v0[0] * v0[0] + v0[1] * v0[1]) + (v0[2] * v0[2] + v0[3] * v0[3]) + (v1[0] * v1[0] + v1[1] * v1[1]) + (v1[2] * v1[2] + v1[3] * v1[3]); }
                sq += __shfl_xor(sq, 16); sq += __shfl_xor(sq, 32);
                if (fq == 0) atomicAdd(ssout + row, sq); }
    }
};
struct EpiSwiGLU {
    bf16* O; const float* ss;
    __device__ __forceinline__ void operator()(const Acc& acc, const Unit& u, int wr, int wc, int fr, int fq) const {
        const int row0 = u.pm * BM + wr * 64 + fr, col0 = u.pn * HALF + wc * 32 + 8 * fq;
#pragma unroll
        for (int ai = 0; ai < 2; ++ai)
#pragma unroll
            for (int m = 0; m < 4; ++m) { const int row = row0 + ai * HALF + m * 16; const float rs = __builtin_amdgcn_rsqf(ss[row] * (1.0f / D) + RMS_EPS);
                float a[8];
#pragma unroll
                for (int n = 0; n < 2; ++n)
#pragma unroll
                    for (int e = 0; e < 4; ++e) { const float g = acc[ai][0][m][n][e] * rs, up = acc[ai][1][m][n][e] * rs;
                        a[4 * n + e] = g * __builtin_amdgcn_rcpf(1.0f + __builtin_amdgcn_exp2f(-LOG2E * g)) * up; }
                u32x4 w; w.x = cvtpk(a[0], a[1]); w.y = cvtpk(a[2], a[3]); w.z = cvtpk(a[4], a[5]); w.w = cvtpk(a[6], a[7]);
                *(u32x4*)(O + (size_t)row * FF + col0) = w; }
    }
};
__device__ __forceinline__ void rope8(float (&v)[8], const float* cs_row  , int fq) {
    const int f0 = 8 * (fq & 1);
#pragma unroll
    for (int e = 0; e < 8; ++e) { const float other = __shfl_xor(v[e], 32); const float c = cs_row[2 * (f0 + e)], s = cs_row[2 * (f0 + e) + 1];
        v[e] = (fq < 2) ? (v[e] * c - other * s) : (other * s + v[e] * c); }
}
struct EpiMlaIn {
    bf16* P; const float* ss; float* ssq; float* sskv; bf16* KF; const float* cs;
    __device__ __forceinline__ void operator()(const Acc& acc, const Unit& u, int wr, int wc, int fr, int fq) const {
        const int row0 = u.pm * BM + wr * 64 + fr, col0 = u.pn * BM + wc * 32 + 8 * fq;
#pragma unroll
        for (int ai = 0; ai < 2; ++ai)
#pragma unroll
            for (int m = 0; m < 4; ++m) { const int row = row0 + ai * HALF + m * 16; const float rs = __builtin_amdgcn_rsqf(ss[row] * (1.0f / D) + RMS_EPS);
                bf16* rowp = P + (size_t)row * NIN1P + col0;
                if (u.pn < 2) {
                    float sq[2];
#pragma unroll
                    for (int bj = 0; bj < 2; ++bj) { const f32x4 v0 = acc[ai][bj][m][0] * rs, v1 = acc[ai][bj][m][1] * rs;
                        u32x4 w; w.x = cvtpk(v0[0], v0[1]); w.y = cvtpk(v0[2], v0[3]); w.z = cvtpk(v1[0], v1[1]); w.w = cvtpk(v1[2], v1[3]);
                        *(u32x4*)(rowp + bj * HALF) = w;
                        sq[bj] = (v0[0] * v0[0] + v0[1] * v0[1]) + (v0[2] * v0[2] + v0[3] * v0[3]) + (v1[0] * v1[0] + v1[1] * v1[1]) + (v1[2] * v1[2] + v1[3] * v1[3]); }
                    float sa = (u.pn == 0) ? sq[0] + sq[1] : sq[0], sb = (u.pn == 0) ? 0.f : sq[1];
                    sa += __shfl_xor(sa, 16); sa += __shfl_xor(sa, 32); sb += __shfl_xor(sb, 16); sb += __shfl_xor(sb, 32);
                    if (fq == 0) { atomicAdd(ssq + row, sa); if (u.pn == 1) atomicAdd(sskv + row, sb); }
                } else {
                    const u32x4 z = {0u, 0u, 0u, 0u};
                    *(u32x4*)(rowp) = z; *(u32x4*)(rowp + HALF) = z;
                    if (wc == 0) {
                        float v[8];
#pragma unroll
                        for (int n = 0; n < 2; ++n)
#pragma unroll
                            for (int e = 0; e < 4; ++e) v[4 * n + e] = acc[ai][0][m][n][e] * rs;
                        rope8(v, cs + (size_t)row * 32, fq);
                        u32x4 w; w.x = cvtpk(v[0], v[1]); w.y = cvtpk(v[2], v[3]); w.z = cvtpk(v[4], v[5]); w.w = cvtpk(v[6], v[7]);
                        bf16* kp = KF + (size_t)row * KPITCH + 64 + 8 * fq;
#pragma unroll
                        for (int h = 0; h < 16; ++h) *(u32x4*)(kp + h * 96) = w;
                    }
                } }
    }
};
struct EpiMlaQ {
    bf16* Q; const float* ssq; const float* cs;
    __device__ __forceinline__ void operator()(const Acc& acc, const Unit& u, int wr, int wc, int fr, int fq) const {
        const int row0 = u.pm * BM + wr * 64 + fr;
#pragma unroll
        for (int ai = 0; ai < 2; ++ai)
#pragma unroll
            for (int m = 0; m < 4; ++m) { const int row = row0 + ai * HALF + m * 16; const float rs = __builtin_amdgcn_rsqf(ssq[row] * (1.0f / QL) + RMS_EPS);
#pragma unroll
                for (int bj = 0; bj < 2; ++bj) { const int g0 = u.pn * BM + bj * HALF + wc * 32;
                    float v[8];
#pragma unroll
                    for (int n = 0; n < 2; ++n)
#pragma unroll
                        for (int e = 0; e < 4; ++e) v[4 * n + e] = acc[ai][bj][m][n][e] * rs;
                    if ((g0 % 96) == 64) rope8(v, cs + (size_t)row * 32, fq);
                    u32x4 w; w.x = cvtpk(v[0] * C2_MLA, v[1] * C2_MLA); w.y = cvtpk(v[2] * C2_MLA, v[3] * C2_MLA); w.z = cvtpk(v[4] * C2_MLA, v[5] * C2_MLA); w.w = cvtpk(v[6] * C2_MLA, v[7] * C2_MLA);
                    *(u32x4*)(Q + (size_t)row * NQ1 + g0 + 8 * fq) = w; } }
    }
};
struct EpiMlaKV {
    bf16* KF; bf16* V; const float* sskv;
    __device__ __forceinline__ void operator()(const Acc& acc, const Unit& u, int wr, int wc, int fr, int fq) const {
        const int row0 = u.pm * BM + wr * 64 + fr;
#pragma unroll
        for (int ai = 0; ai < 2; ++ai)
#pragma unroll
            for (int m = 0; m < 4; ++m) { const int row = row0 + ai * HALF + m * 16; const float rs = __builtin_amdgcn_rsqf(sskv[row] * (1.0f / KVL) + RMS_EPS);
#pragma unroll
                for (int bj = 0; bj < 2; ++bj) { const int col = u.pn * BM + bj * HALF + wc * 32 + 8 * fq;
                    const f32x4 v0 = acc[ai][bj][m][0] * rs, v1 = acc[ai][bj][m][1] * rs;
                    u32x4 w; w.x = cvtpk(v0[0], v0[1]); w.y = cvtpk(v0[2], v0[3]); w.z = cvtpk(v1[0], v1[1]); w.w = cvtpk(v1[2], v1[3]);
                    bf16* dst = (col < 1024) ? KF + (size_t)row * KPITCH + (col >> 6) * 96 + (col & 63) : V + (size_t)row * D + (col - 1024);
                    *(u32x4*)dst = w; } }
    }
};

template <class Epi, bool ALIGN_EPI>
__device__ __forceinline__ void gemm_phase(LAS unsigned char* lds, const Gemm g, const StaticOrder& S, const Epi& E) {
    const int tid = threadIdx.x, wid = __builtin_amdgcn_readfirstlane(tid >> 6), lane = tid & 63, wr = wid >> 2, wc = wid & 3, fr = lane & 15, fq = lane >> 4;
    const int K = g.K, nt = K / BK, lda = g.lda;
    unsigned voffA[2], voffB[2];
#pragma unroll
    for (int i = 0; i < 2; ++i) { int R, C; stage_rc(tid * 16 + i * 8192, R, C); const int Rb = (R & ~31) + perm32(R & 31);
        voffA[i] = (unsigned)(R * lda + C) * 2u; voffB[i] = (unsigned)(Rb * K + C) * 2u; }
    const size_t kstep = (size_t)(BK * 2);
    const size_t hsA = (size_t)HALF * lda * 2, hsB = (size_t)HALF * K * 2, tsA = 2 * hsA, tsB = 2 * hsB;
    const unsigned ldsw = (unsigned)wid * 1024u;
    const int aoff = lds_byte(wr * 64 + fr, fq * 8), boff = lds_byte(wc * 32 + fr, fq * 8);
#define PG8_SA(b, h) (((b) * 2 + (h)) * HTB)
#define PG8_SB(b, h) ((4 + (b) * 2 + (h)) * HTB)
#define PG8_STAGE(bufoff, gbase, voff) do { _Pragma("unroll") for (int _i = 0; _i < 2; ++_i) \
        __builtin_amdgcn_global_load_lds((const unsigned*)((const char*)(gbase) + (voff)[_i]), (LAS unsigned*)(lds + (bufoff) + ldsw + _i * 8192), 16, 0, 0); } while (0)
#define PG8_LDA(dst, b, h) do { _Pragma("unroll") for (int m = 0; m < 4; ++m) _Pragma("unroll") for (int k = 0; k < 2; ++k) dst[m][k] = *(const LAS bf16x8*)(lds + PG8_SA(b, h) + aoff + m * 2048 + k * 1024); } while (0)
#define PG8_LDB(dst, b, h) do { _Pragma("unroll") for (int n = 0; n < 2; ++n) _Pragma("unroll") for (int k = 0; k < 2; ++k) dst[n][k] = *(const LAS bf16x8*)(lds + PG8_SB(b, h) + boff + n * 2048 + k * 1024); } while (0)
#define PG8_MMA(ai, bj, At, Bt) do { __builtin_amdgcn_s_setprio(1); _Pragma("unroll") for (int m = 0; m < 4; ++m) _Pragma("unroll") for (int n = 0; n < 2; ++n) _Pragma("unroll") for (int k = 0; k < 2; ++k) \
        acc[ai][bj][m][n] = __builtin_amdgcn_mfma_f32_16x16x32_bf16(Bt[n][k], At[m][k], acc[ai][bj][m][n], 0, 0, 0); __builtin_amdgcn_s_setprio(0); } while (0)
#define PG8_WAIT_V(n) asm volatile("s_waitcnt vmcnt(" #n ")" ::: "memory")
#define PG8_WAIT_L(n) asm volatile("s_waitcnt lgkmcnt(" #n ")" ::: "memory")
#define PG8_BAR __builtin_amdgcn_s_barrier()
#define PG8_SCHED __builtin_amdgcn_sched_barrier(0)
    Unit cur, nxt; int ui = 0;
    if (!S.next(0, cur)) return;
    Acc acc;
#pragma unroll
    for (int a = 0; a < 2; ++a)
#pragma unroll
        for (int b = 0; b < 2; ++b)
#pragma unroll
            for (int m = 0; m < 4; ++m)
#pragma unroll
                for (int n = 0; n < 2; ++n) acc[a][b][m][n] = (f32x4){0.f, 0.f, 0.f, 0.f};
    bf16x8 At[4][2], B0[2][2], B1[2][2];
    const char* cA = (const char*)g.A + (size_t)cur.pm * tsA; const char* cB = (const char*)g.Bt + (size_t)cur.pn * tsB;
    PG8_STAGE(PG8_SB(0, 0), cB, voffB); PG8_STAGE(PG8_SB(0, 1), cB + hsB, voffB); PG8_STAGE(PG8_SA(0, 0), cA, voffA); PG8_STAGE(PG8_SA(0, 1), cA + hsA, voffA);
    if (wr == 1) PG8_BAR;
    PG8_WAIT_V(2); PG8_BAR;
    PG8_STAGE(PG8_SB(1, 0), cB + kstep, voffB); PG8_STAGE(PG8_SA(1, 0), cA + kstep, voffA); PG8_STAGE(PG8_SB(1, 1), cB + hsB + kstep, voffB);
    PG8_WAIT_V(6); PG8_BAR;
    for (;;) {
        const bool has_next = S.next(ui + 1, nxt);
        const char* nA = has_next ? (const char*)g.A + (size_t)nxt.pm * tsA : cA; const char* nB = has_next ? (const char*)g.Bt + (size_t)nxt.pn * tsB : cB;
#pragma unroll 1
        for (int t = 0; t < nt; t += 2) {
            const bool last = (t == nt - 2);
            const char* a1 = cA + (size_t)(t + 1) * kstep;
            const char* a2 = last ? nA : cA + (size_t)(t + 2) * kstep; const char* b2 = last ? nB : cB + (size_t)(t + 2) * kstep;
            const char* a3 = a2 + kstep; const char* b3 = b2 + kstep;
            PG8_LDB(B0, 0, 0); PG8_LDB(B1, 0, 1); PG8_SCHED; PG8_LDA(At, 0, 0); PG8_STAGE(PG8_SA(1, 1), a1 + hsA, voffA);
            PG8_WAIT_V(8); PG8_WAIT_L(0); PG8_BAR; PG8_MMA(0, 0, At, B0); PG8_MMA(0, 1, At, B1); PG8_BAR; PG8_SCHED;
            PG8_LDA(At, 0, 1); PG8_STAGE(PG8_SB(0, 0), b2, voffB); PG8_STAGE(PG8_SB(0, 1), b2 + hsB, voffB); PG8_STAGE(PG8_SA(0, 0), a2, voffA);
            PG8_WAIT_V(8); PG8_WAIT_L(0); PG8_BAR; PG8_MMA(1, 0, At, B0); PG8_MMA(1, 1, At, B1); PG8_BAR; PG8_SCHED;
            PG8_LDB(B0, 1, 0); PG8_LDB(B1, 1, 1); PG8_SCHED; PG8_LDA(At, 1, 0); PG8_STAGE(PG8_SA(0, 1), a2 + hsA, voffA);
            PG8_WAIT_V(8); PG8_WAIT_L(0); PG8_BAR; PG8_MMA(0, 0, At, B0); PG8_MMA(0, 1, At, B1); PG8_BAR; PG8_SCHED;
            PG8_LDA(At, 1, 1); PG8_STAGE(PG8_SB(1, 0), b3, voffB); PG8_STAGE(PG8_SB(1, 1), b3 + hsB, voffB); PG8_STAGE(PG8_SA(1, 0), a3, voffA);
            PG8_WAIT_V(8); PG8_WAIT_L(0); PG8_BAR; PG8_MMA(1, 0, At, B0); PG8_MMA(1, 1, At, B1); PG8_BAR; PG8_SCHED;
        }
        if constexpr (ALIGN_EPI) { if (wr == 0) PG8_BAR; }
        E(acc, cur, wr, wc, fr, fq);
        if (!has_next) break;
#pragma unroll
        for (int a = 0; a < 2; ++a)
#pragma unroll
            for (int b = 0; b < 2; ++b)
#pragma unroll
                for (int m = 0; m < 4; ++m)
#pragma unroll
                    for (int n = 0; n < 2; ++n) acc[a][b][m][n] = (f32x4){0.f, 0.f, 0.f, 0.f};
        cur = nxt; cA = nA; cB = nB; ++ui;
        if constexpr (ALIGN_EPI) { if (wr == 1) PG8_BAR; }
    }
    PG8_WAIT_V(0);
    if constexpr (!ALIGN_EPI) { if (wr == 0) PG8_BAR; }
    PG8_BAR;
#undef PG8_SA
#undef PG8_SB
#undef PG8_STAGE
#undef PG8_LDA
#undef PG8_LDB
#undef PG8_MMA
#undef PG8_WAIT_V
#undef PG8_WAIT_L
#undef PG8_BAR
#undef PG8_SCHED
}
}

typedef GAS unsigned gu32;
#define RLX_AGENT __ATOMIC_RELAXED, __HIP_MEMORY_SCOPE_AGENT
#define LDS_WAIT() asm volatile("s_waitcnt lgkmcnt(0)" ::: "memory")
#define VM_WAIT() asm volatile("s_waitcnt vmcnt(0)" ::: "memory")
#define XB_TMO      128
#define XB_XCNT(j)  (256  + 64 * (j))
#define XB_XSUB(j)  (1280 + 64 * (j))
#define XB_XGEN(j)  (2304 + 64 * (j))
#define XB_TOP      3328
#define XB_TOPGEN   3392
#define XCD_BAR_WORDS 3456
#define XB_SPIN_CAP (1u << 18)
__device__ __forceinline__ unsigned xb_ld(unsigned* p)              { return __hip_atomic_load(p, __ATOMIC_RELAXED, __HIP_MEMORY_SCOPE_AGENT); }
__device__ __forceinline__ unsigned xb_add(unsigned* p, unsigned v) { return __hip_atomic_fetch_add(p, v, __ATOMIC_RELAXED, __HIP_MEMORY_SCOPE_AGENT); }
__device__ __forceinline__ unsigned xb_xcc_id() { return (unsigned)__builtin_amdgcn_s_getreg((3 << 11) | 20) & 0xFu; }
#define XB_SPIN(cond, bar) do { unsigned _sp = 0; while (cond) { __builtin_amdgcn_s_sleep(1); \
    if ((++_sp & 255u) == 0u) { if (xb_ld(&(bar)[XB_TMO])) break; if (_sp > XB_SPIN_CAP) { atomicAdd(&(bar)[XB_TMO], 1u); break; } } } } while (0)
struct XcdBarrier { unsigned* bar; unsigned x; volatile LAS unsigned* st; };
__device__ __forceinline__ XcdBarrier xcd_barrier_post(unsigned* bar, volatile LAS unsigned* st) {
    XcdBarrier b; b.bar = bar; b.x = xb_xcc_id(); b.st = st;
    if (threadIdx.x == 0) (void)xb_add(&bar[XB_XCNT(b.x)], 1u);
    return b;
}
__device__ __forceinline__ void xcd_barrier_complete(unsigned* bar, unsigned x, unsigned& nloc, unsigned& nx) {
    const unsigned G = gridDim.x * gridDim.y * gridDim.z;
    unsigned sum, cnt, mine, sp = 0u;
    for (;;) {
        sum = 0u; cnt = 0u; mine = 0u;
#pragma unroll
        for (unsigned j = 0; j < 16; ++j) { const unsigned c = xb_ld(&bar[XB_XCNT(j)]); sum += c; cnt += (c > 0u) ? 1u : 0u; mine = (j == x) ? c : mine; }
        if (sum == G) break;
        __builtin_amdgcn_s_sleep(1);
        if ((++sp & 255u) == 0u) { if (xb_ld(&bar[XB_TMO])) break; if (sp > XB_SPIN_CAP) { atomicAdd(&bar[XB_TMO], 1u); break; } }
    }
    nloc = mine > 0u ? mine : 1u; nx = cnt > 0u ? cnt : 1u;
}
__device__ __forceinline__ void xcd_barrier(const XcdBarrier& b) {
    asm volatile("s_waitcnt vmcnt(0)" ::: "memory");
    __syncthreads();
    if (threadIdx.x == 0) {
        unsigned* bar = b.bar;
        __builtin_amdgcn_s_waitcnt(0);
        unsigned nloc = b.st[0], nx = b.st[1];
        if (nloc == 0u) { xcd_barrier_complete(bar, b.x, nloc, nx); b.st[0] = nloc; b.st[1] = nx; }
        const unsigned old = xb_add(&bar[XB_XSUB(b.x)], 1u);
        const unsigned gen = old / nloc;
        if (old + 1u == (gen + 1u) * nloc) {
            __builtin_amdgcn_fence(__ATOMIC_RELEASE, "agent");
            asm volatile("s_waitcnt vmcnt(0)" ::: "memory");
            const unsigned og = xb_add(&bar[XB_TOP], 1u);
            const unsigned tg = og / nx;
            if (og + 1u == (tg + 1u) * nx) xb_add(&bar[XB_TOPGEN], 1u);
            else XB_SPIN(xb_ld(&bar[XB_TOPGEN]) == tg, bar);
            __builtin_amdgcn_fence(__ATOMIC_ACQUIRE, "agent");
            xb_add(&bar[XB_XGEN(b.x)], 1u);
            asm volatile("s_waitcnt vmcnt(0)" ::: "memory");
        } else {
            XB_SPIN(xb_ld(&bar[XB_XGEN(b.x)]) == gen, bar);
            __builtin_amdgcn_fence(__ATOMIC_ACQUIRE, "agent");
            asm volatile("s_waitcnt vmcnt(0)" ::: "memory");
        }
    }
    __syncthreads();
}

__device__ __forceinline__ int t5_bucket(int rel) {
    const int n = rel < 0 ? -rel : rel;
    const float nf = (float)(n > 8 ? n : 8);
    int large = 8 + (int)(__logf(nf / 8.0f) / 4.852030263919617f * 8.0f);
    large = large < 15 ? large : 15;
    return (rel > 0 ? 16 : 0) + (n < 8 ? n : large);
}
__device__ __forceinline__ int t5_bucket_precise(int rel) {
    const int n = rel < 0 ? -rel : rel;
    const float nf = (float)(n > 8 ? n : 8);
    int large = 8 + (int)(logf(nf / 8.0f) / 4.852030263919617f * 8.0f);
    large = large < 15 ? large : 15;
    return (rel > 0 ? 16 : 0) + (n < 8 ? n : large);
}

struct Args {
    const float* in[18];
    float* out; unsigned char* ws;
    int ph_lo, ph_hi;
};
enum { I_X = 0, I_T5, I_ANORM, I_FNORM, I_EWIN, I_RPB, I_EWOUT, I_OWIN, I_QNORM, I_WUQ, I_KVNORM, I_WUK, I_WUV, I_OWOUT, I_WG, I_WU, I_WD, I_FINAL };
constexpr int NPH = 13;

__device__ __forceinline__ void p0_transpose_item(const float* W, int N, const float* gain, bf16* WT, int ldk, int dst_row0, int k0, int n0, LAS float* scr, int lane) {
#pragma unroll 8
    for (int i = 0; i < 32; ++i) { const int kk = 2 * i + (lane >> 5); const float gk = gain ? gain[k0 + kk] : 1.0f; scr[kk * 33 + (lane & 31)] = W[(size_t)(k0 + kk) * N + n0 + (lane & 31)] * gk; }
    LDS_WAIT(); asm volatile("" ::: "memory");
    const int c = lane & 7;
#pragma unroll
    for (int j = 0; j < 4; ++j) { const int n = (lane >> 3) + 8 * j; const LAS float* s = scr + (8 * c) * 33 + n;
        u32x4 o; o.x = cvtpk(s[0 * 33], s[1 * 33]); o.y = cvtpk(s[2 * 33], s[3 * 33]); o.z = cvtpk(s[4 * 33], s[5 * 33]); o.w = cvtpk(s[6 * 33], s[7 * 33]);
        *(u32x4*)(WT + (size_t)(dst_row0 + n) * ldk + k0 + 8 * c) = o; }
    LDS_WAIT(); asm volatile("" ::: "memory");
}
template <int MODE>
__device__ __forceinline__ bool p0_matrix(int& r, const float* W, int K, int N, const float* gain, bf16* WT, int ldk, int row_off, LAS float* scr, int lane) {
    const int nblk = N / 32, items = (K / 64) * nblk;
    if (r >= items) { r -= items; return false; }
    const int kb = r / nblk, nb = r % nblk, n0 = 32 * nb;
    int dr = row_off + n0;
    if (MODE != 0) dr = (n0 >> 7) * 256 + (n0 & 127) + (MODE == 2 ? 128 : 0);
    p0_transpose_item(W, N, gain, WT, ldk, dr, 64 * kb, n0, scr, lane);
    return true;
}

namespace wattn {
__device__ __forceinline__ int crow(int r, int hi) { return (r & 3) + 8 * (r >> 2) + 4 * hi; }
typedef short v4i16_t __attribute__((ext_vector_type(4)));
__device__ __forceinline__ s16x4 vtr(const LAS unsigned char* p) { return __builtin_bit_cast(s16x4, __builtin_amdgcn_ds_read_tr16_b64_v4i16((LAS v4i16_t*)p)); }
constexpr int WREG = 10240;

template <int DQ, class F>
__device__ __forceinline__ void run_unit(const F& f, const bf16* __restrict__ Qrow  , const bf16* __restrict__ Kb, int kpitch,
                                         const bf16* __restrict__ Vb, int vpitch, float c2, bf16* __restrict__ Orow  ,
                                         LAS unsigned char* wl, int lane) {
    constexpr int ND = DQ / 16;
    const int r32 = lane & 31, hi = lane >> 5;
    bf16x8 qf[ND];
#pragma unroll
    for (int d0 = 0; d0 < ND; ++d0) qf[d0] = *(const bf16x8*)(Qrow + 16 * d0 + 8 * hi);
    float m = NEGB, l = 0.f; f32x16 ot[2];
#pragma unroll
    for (int r = 0; r < 16; ++r) { ot[0][r] = 0.f; ot[1][r] = 0.f; }
    u32x4 kr[ND], vr[4];
    const int nt = f.ntiles();
    auto load_tile = [&](int t) {
        const bf16* kp = Kb + (size_t)f.tok(t, r32) * kpitch + (lane >> 5) * 8;
#pragma unroll
        for (int i = 0; i < ND; ++i) kr[i] = *(const u32x4*)(kp + 16 * i);
        const bf16* v0 = Vb + (size_t)f.tok(t, lane >> 2) * vpitch + (lane & 3) * 8;
        const bf16* v1 = Vb + (size_t)f.tok(t, (lane >> 2) + 16) * vpitch + (lane & 3) * 8;
        vr[0] = *(const u32x4*)(v0); vr[1] = *(const u32x4*)(v1); vr[2] = *(const u32x4*)(v0 + 32); vr[3] = *(const u32x4*)(v1 + 32);
    };
    const LAS unsigned char* vbase = wl + 6144 + (4 * hi + ((lane & 15) >> 2)) * 64 + ((lane >> 4) & 1) * 32 + (lane & 3) * 8;
    load_tile(0);
    for (int t = 0; t < nt; ++t) {
#pragma unroll
        for (int i = 0; i < ND; ++i) *(LAS u32x4*)(wl + i * 1024 + lane * 16) = kr[i];
#pragma unroll
        for (int i = 0; i < 4; ++i) *(LAS u32x4*)(wl + 6144 + (i >> 1) * 2048 + (i & 1) * 1024 + lane * 16) = vr[i];
        if (t + 1 < nt) load_tile(t + 1);
        f32x16 s;
#pragma unroll
        for (int r = 0; r < 16; ++r) s[r] = 0.f;
#pragma unroll
        for (int d0 = 0; d0 < ND; ++d0) { const bf16x8 kf = *(const LAS bf16x8*)(wl + d0 * 1024 + lane * 16); s = __builtin_amdgcn_mfma_f32_32x32x16_bf16(kf, qf[d0], s, 0, 0, 0); }
        float mx = NEGB;
#pragma unroll
        for (int r = 0; r < 16; ++r) { s[r] = s[r] * c2 + f.bias(t, r, hi, r32); mx = fmaxf(mx, s[r]); }
        mx = fmaxf(mx, __shfl_xor(mx, 32));
        const float mnew = fmaxf(m, mx), alpha = __builtin_amdgcn_exp2f(m - mnew);
        m = mnew;
        float ps = 0.f;
#pragma unroll
        for (int r = 0; r < 16; ++r) { s[r] = __builtin_amdgcn_exp2f(s[r] - mnew); ps += s[r]; }
        l = l * alpha + ps;
#pragma unroll
        for (int r = 0; r < 16; ++r) { ot[0][r] *= alpha; ot[1][r] *= alpha; }
        u32x4 pw[2];
#pragma unroll
        for (int ks = 0; ks < 2; ++ks) { pw[ks].x = cvtpk(s[8 * ks + 0], s[8 * ks + 1]); pw[ks].y = cvtpk(s[8 * ks + 2], s[8 * ks + 3]); pw[ks].z = cvtpk(s[8 * ks + 4], s[8 * ks + 5]); pw[ks].w = cvtpk(s[8 * ks + 6], s[8 * ks + 7]); }
#pragma unroll
        for (int db = 0; db < 2; ++db)
#pragma unroll
            for (int ks = 0; ks < 2; ++ks) {
                const s16x4 lo = vtr(vbase + db * 2048 + ks * 1024), hh = vtr(vbase + db * 2048 + ks * 1024 + 512);
                const bf16x8 vf = (bf16x8){lo[0], lo[1], lo[2], lo[3], hh[0], hh[1], hh[2], hh[3]};
                ot[db] = __builtin_amdgcn_mfma_f32_32x32x16_bf16(vf, __builtin_bit_cast(bf16x8, pw[ks]), ot[db], 0, 0, 0);
            }
    }
    l += __shfl_xor(l, 32);
    const float inv = 1.0f / l;
#pragma unroll
    for (int db = 0; db < 2; ++db)
#pragma unroll
        for (int g = 0; g < 4; ++g) { u32x2 w; w.x = cvtpk(ot[db][4 * g] * inv, ot[db][4 * g + 1] * inv); w.y = cvtpk(ot[db][4 * g + 2] * inv, ot[db][4 * g + 3] * inv);
            *(u32x2*)(Orow + 32 * db + 8 * g + 4 * hi) = w; }
}

struct DilF {
    int t0, w; bool edge; const LAS float* tbl;
    __device__ __forceinline__ int ntiles() const { return 23; }
    __device__ __forceinline__ int tok_raw(int t, int j) const {
        if (t < 8) return t0 - 64 + 32 * t + j;
        const int ii = (t - 8) * 32 + j, e = ii < 240 ? ii - 256 : ii - 192;
        return t0 + w + 4 * e;
    }
    __device__ __forceinline__ int tok(int t, int j) const { int u = tok_raw(t, j); u = u < 0 ? 0 : u; return u > S - 1 ? S - 1 : u; }
    __device__ __forceinline__ float bias(int t, int r, int hi, int r32) const {
        const int u = tok_raw(t, crow(r, hi)), d = u - (t0 + w + 4 * r32);
        float b = tbl[d + 1152];
        if (edge && (u < 0 || u >= S)) b = NEGB;
        return b;
    }
};
struct NaF {
    int r0, gr, jw; const LAS float* rpb;
    __device__ __forceinline__ int ntiles() const { return 16; }
    __device__ __forceinline__ int tok(int t, int j) const { return (r0 + (t >> 1)) * 64 + 32 * (t & 1) + j; }
    __device__ __forceinline__ float bias(int t, int r, int hi, int r32) const {
        const int kc = 32 * (t & 1) + crow(r, hi), c = 32 * jw + r32;
        int c0 = c - 8; c0 = c0 < 0 ? 0 : (c0 > 48 ? 48 : c0);
        const bool ok = (unsigned)(kc - c0) < 16u;
        const int idx = (r0 + (t >> 1) - gr + 7) * 31 + (kc - c + 15);
        return ok ? rpb[idx] : NEGB;
    }
};
struct MlaF {
    int tq0; const LAS float* tbl;
    __device__ __forceinline__ int ntiles() const { return S / 32; }
    __device__ __forceinline__ int tok(int t, int j) const { return 32 * t + j; }
    __device__ __forceinline__ float bias(int t, int r, int hi, int r32) const {
        int d = 32 * t + crow(r, hi) - (tq0 + r32); d = d < -600 ? -600 : (d > 600 ? 600 : d);
        return tbl[d + 600];
    }
};
}

constexpr int NWAVES = 8;
__global__ void __launch_bounds__(NWAVES * 64, 2) fwd_kernel(Args args) {
    extern __shared__ __attribute__((aligned(16))) unsigned char lds_raw[];
    LAS unsigned char* lds = (LAS unsigned char*)lds_raw;
    volatile LAS unsigned* MISC = (volatile LAS unsigned*)(lds + MISC_OFF);
    const int tid = threadIdx.x, lane = tid & 63, wave = __builtin_amdgcn_readfirstlane(tid >> 6);
    const int G = gridDim.x; const int bx = blockIdx.x;
    const int vcu = (G % 8 == 0) ? (bx % 8) * (G / 8) + bx / 8 : bx;
    unsigned char* ws = args.ws;
    float* const out = args.out;
    const int lo = args.ph_lo, hi_ph = args.ph_hi;
    for (int u = tid; u < (LDS_BYTES - LDSCTL_OFF) / 4; u += NWAVES * 64) ((LAS unsigned*)(lds + LDSCTL_OFF))[u] = 0u;
    __syncthreads();
    const bool multi = (hi_ph - lo) > 1;
    XcdBarrier bar; bar.bar = (unsigned*)(ws + CTL_BAR); bar.x = 0; bar.st = nullptr;
    if (multi) bar = xcd_barrier_post((unsigned*)(ws + CTL_BAR), MISC + 8);
#ifndef PHASE_MASK
#define PHASE_MASK 0x1fff
#endif
#define IN(k) ((((PHASE_MASK) >> (k)) & 1) && lo <= (k) && (k) < hi_ph)
#define SEAM(k) do { if (IN(k) && IN((k) + 1)) xcd_barrier(bar); } while (0)

    float* const SS = (float*)(ws + CTL_SS);
    float* const SS0 = SS, * const SS1 = SS + S, * const SS2 = SS + 2 * S, * const SS3 = SS + 3 * S, * const SS4 = SS + 4 * S, * const SSQ = SS + 5 * S, * const SSKV = SS + 6 * S;
    bf16* const XB = (bf16*)(ws + WS_XB); bf16* const OB = (bf16*)(ws + WS_O); bf16* const BIG = (bf16*)(ws + WS_BIG);
    bf16* const Q1 = (bf16*)(ws + WS_Q1); bf16* const K1 = (bf16*)(ws + WS_K1); bf16* const V1 = (bf16*)(ws + WS_V1);
    const float* const ROPE = (const float*)(ws + WS_ROPE);
    const int gw = vcu * NWAVES + wave, NGW = G * NWAVES;

    if (IN(0)) {
        LAS float* scr = (LAS float*)(lds + wave * 16384);
        const float* an0 = args.in[I_ANORM], * an1 = args.in[I_ANORM] + D, * fn0 = args.in[I_FNORM], * fn1 = args.in[I_FNORM] + D;
        constexpr int NITEMS = 1536 + 512 + 1408 * 3 + 272 + 288 + 64 + 64 + 512 + 1408 * 3;
        for (int it = gw; it < NITEMS; it += NGW) {
            int r = it;
            if (p0_matrix<0>(r, args.in[I_EWIN], D, NQKV, an0, (bf16*)(ws + W_IN0), D, 0, scr, lane)) continue;
            if (p0_matrix<0>(r, args.in[I_EWOUT], D, D, nullptr, (bf16*)(ws + W_OUT0), D, 0, scr, lane)) continue;
            if (p0_matrix<1>(r, args.in[I_WG], D, FF, fn0, (bf16*)(ws + W_GU0), D, 0, scr, lane)) continue;
            if (p0_matrix<2>(r, args.in[I_WU], D, FF, fn0, (bf16*)(ws + W_GU0), D, 0, scr, lane)) continue;
            if (p0_matrix<0>(r, args.in[I_WD], FF, D, nullptr, (bf16*)(ws + W_D0), FF, 0, scr, lane)) continue;
            if (p0_matrix<0>(r, args.in[I_OWIN], D, NIN1, an1, (bf16*)(ws + W_IN1), D, 0, scr, lane)) continue;
            if (p0_matrix<0>(r, args.in[I_WUQ], QL, NQ1, args.in[I_QNORM], (bf16*)(ws + W_UQ), QL, 0, scr, lane)) continue;
            if (p0_matrix<0>(r, args.in[I_WUK], KVL, D, args.in[I_KVNORM], (bf16*)(ws + W_UKV), KVLP, 0, scr, lane)) continue;
            if (p0_matrix<0>(r, args.in[I_WUV], KVL, D, args.in[I_KVNORM], (bf16*)(ws + W_UKV), KVLP, 1024, scr, lane)) continue;
            if (p0_matrix<0>(r, args.in[I_OWOUT], D, D, nullptr, (bf16*)(ws + W_OUT1), D, 0, scr, lane)) continue;
            if (p0_matrix<1>(r, args.in[I_WG] + (size_t)D * FF, D, FF, fn1, (bf16*)(ws + W_GU1), D, 0, scr, lane)) continue;
            if (p0_matrix<2>(r, args.in[I_WU] + (size_t)D * FF, D, FF, fn1, (bf16*)(ws + W_GU1), D, 0, scr, lane)) continue;
            p0_matrix<0>(r, args.in[I_WD] + (size_t)FF * D, FF, D, nullptr, (bf16*)(ws + W_D1), FF, 0, scr, lane);
        }
        const int gt = vcu * (NWAVES * 64) + tid, NGT = G * NWAVES * 64;
        for (int i = gt; i < (NIN1P - NIN1) * D / 8; i += NGT) ((u32x4*)(ws + W_IN1 + (size_t)NIN1 * D * 2))[i] = (u32x4){0u, 0u, 0u, 0u};
        for (int i = gt; i < NKV1 * 16; i += NGT) { const int row = i >> 4, c = i & 15; *(u32x4*)(ws + W_UKV + ((size_t)row * KVLP + KVL + c * 8) * 2) = (u32x4){0u, 0u, 0u, 0u}; }
        for (int mrow = gw; mrow < S; mrow += NGW) {
            const f32x4* xr = (const f32x4*)(args.in[I_X] + (size_t)mrow * D) + lane; float s2 = 0.f;
            unsigned long long* o8 = (unsigned long long*)(XB + (size_t)mrow * D) + lane;
#pragma unroll
            for (int j = 0; j < 4; ++j) { const f32x4 v = xr[64 * j]; s2 += (v.x * v.x + v.y * v.y) + (v.z * v.z + v.w * v.w);
                o8[64 * j] = (unsigned long long)cvtpk(v.x, v.y) | ((unsigned long long)cvtpk(v.z, v.w) << 32); }
            s2 = wave_sum(s2);
            if (lane == 0) SS0[mrow] = s2;
        }
        float* rope = (float*)(ws + WS_ROPE);
        for (int i = gt; i < S * 16; i += NGT) { const int pos = i >> 4, fi = i & 15; const float fr = powf(10000.0f, -(float)fi / 16.0f), ang = (float)pos * fr;
            rope[2 * i] = cosf(ang); rope[2 * i + 1] = sinf(ang); }
        const float* t5 = args.in[I_T5];
        float* tdil = (float*)(ws + WS_TDIL);
        for (int i = gt; i < 8 * 2368; i += NGT) { const int h = i / 2368, d = i % 2368 - 1152, n = d < 0 ? -d : d; int mult = 0;
            if (n <= 64) ++mult; if ((d & 3) == 0 && n <= 256) ++mult; if ((d & 15) == 0 && n <= 1024) ++mult;
            tdil[i] = mult ? (t5[t5_bucket_precise(d) * 16 + h] + logf((float)mult)) * LOG2E : NEGB; }
        float* tmla = (float*)(ws + WS_TMLA);
        for (int i = gt; i < 16 * 1216; i += NGT) { const int h = i / 1216; int d = i % 1216 - 600; d = d > 600 ? 600 : d; tmla[i] = t5[t5_bucket_precise(d) * 16 + h] * LOG2E; }
        float* trpb = (float*)(ws + WS_TRPB);
        for (int i = gt; i < 8 * 465; i += NGT) trpb[i] = args.in[I_RPB][i] * LOG2E;
    }
    SEAM(0);

    if (IN(1)) {
        pg8::Gemm g{XB, (const bf16*)(ws + W_IN0), S, NQKV, D, D}; pg8::StaticOrder So; So.init(S, NQKV, G, bx);
        pg8::EpiRowScale E{BIG, NQKV, SS0, 1.0f / D};
        pg8::gemm_phase<pg8::EpiRowScale, true>(lds, g, So, E);
    }
    SEAM(1);

    if (IN(2)) {
        const int hd = vcu >> 5;
        LAS float* tdl = (LAS float*)(lds + 81920); LAS float* trp = (LAS float*)(lds + 81920 + 9472);
        for (int i = tid; i < 2368; i += NWAVES * 64) tdl[i] = ((const float*)(ws + WS_TDIL))[hd * 2368 + i];
        for (int i = tid; i < 465; i += NWAVES * 64) trp[i] = ((const float*)(ws + WS_TRPB))[hd * 465 + i];
        __syncthreads();
        LAS unsigned char* wl = lds + wave * wattn::WREG;
        const int r32 = lane & 31;
        for (int rd = 0; rd < 2; ++rd) {
            const int ud = vcu * 4 + 2 * rd + (wave >> 2), blk = ud & 127, t0 = blk * 128, w = wave & 3;
            wattn::DilF f{t0, w, (t0 < 1152) || (t0 + 128 + 1152 > S), tdl};
            const int tq = t0 + w + 4 * r32;
            wattn::run_unit<64>(f, BIG + (size_t)tq * NQKV + hd * 64, BIG + 512 + hd * 64, NQKV, BIG + 1024 + hd * 64, NQKV, C2_LOCAL, OB + (size_t)tq * D + hd * 64, wl, lane);
        }
        for (int rn = 0; rn < 2; ++rn) {
            const int un = vcu * 8 + 4 * rn + (wave >> 1), gr = un & 255, jw = wave & 1;
            int r0 = gr - 4; r0 = r0 < 0 ? 0 : (r0 > 248 ? 248 : r0);
            wattn::NaF f{r0, gr, jw, trp};
            const int tq = gr * 64 + 32 * jw + r32;
            wattn::run_unit<64>(f, BIG + (size_t)tq * NQKV + 1536 + hd * 64, BIG + 2048 + hd * 64, NQKV, BIG + 2560 + hd * 64, NQKV, C2_LOCAL, OB + (size_t)tq * D + 512 + hd * 64, wl, lane);
        }
        __syncthreads();
    }
    SEAM(2);

    if (IN(3)) {
        pg8::Gemm g{OB, (const bf16*)(ws + W_OUT0), S, D, D, D}; pg8::StaticOrder So; So.init(S, D, G, bx);
        pg8::EpiResid E{args.in[I_X], out, XB, SS1};
        pg8::gemm_phase<pg8::EpiResid, true>(lds, g, So, E);
    }
    SEAM(3);
    if (IN(4)) {
        pg8::Gemm g{XB, (const bf16*)(ws + W_GU0), S, 2 * FF, D, D}; pg8::StaticOrder So; So.init(S, 2 * FF, G, bx);
        pg8::EpiSwiGLU E{BIG, SS1};
        pg8::gemm_phase<pg8::EpiSwiGLU, true>(lds, g, So, E);
    }
    SEAM(4);
    if (IN(5)) {
        pg8::Gemm g{BIG, (const bf16*)(ws + W_D0), S, D, FF, FF}; pg8::StaticOrder So; So.init(S, D, G, bx);
        pg8::EpiResid E{out, out, XB, SS2};
        pg8::gemm_phase<pg8::EpiResid, true>(lds, g, So, E);
    }
    SEAM(5);
    if (IN(6)) {
        pg8::Gemm g{XB, (const bf16*)(ws + W_IN1), S, NIN1P, D, D}; pg8::StaticOrder So; So.init(S, NIN1P, G, bx);
        pg8::EpiMlaIn E{OB, SS2, SSQ, SSKV, K1, ROPE};
        pg8::gemm_phase<pg8::EpiMlaIn, true>(lds, g, So, E);
    }
    SEAM(6);
    if (IN(7)) {
        { pg8::Gemm g{OB, (const bf16*)(ws + W_UQ), S, NQ1, QL, NIN1P}; pg8::StaticOrder So; So.init(S, NQ1, G, bx);
          pg8::EpiMlaQ E{Q1, SSQ, ROPE};
          pg8::gemm_phase<pg8::EpiMlaQ, true>(lds, g, So, E); }
        { pg8::Gemm g{OB + QL, (const bf16*)(ws + W_UKV), S, NKV1, KVLP, NIN1P}; pg8::StaticOrder So; So.init(S, NKV1, G, bx);
          pg8::EpiMlaKV E{K1, V1, SSKV};
          pg8::gemm_phase<pg8::EpiMlaKV, true>(lds, g, So, E); }
    }
    SEAM(7);
    if (IN(8)) {
        const int hm = vcu >> 4;
        LAS float* tml = (LAS float*)(lds + 81920);
        for (int i = tid; i < 1216; i += NWAVES * 64) tml[i] = ((const float*)(ws + WS_TMLA))[hm * 1216 + i];
        __syncthreads();
        LAS unsigned char* wl = lds + wave * wattn::WREG;
        const int r32 = lane & 31;
        for (int rd = 0; rd < 4; ++rd) {
            const int grp = (vcu & 15) * 32 + rd * 8 + wave, tq0 = grp * 32;
            wattn::MlaF f{tq0, tml};
            wattn::run_unit<96>(f, Q1 + (size_t)(tq0 + r32) * NQ1 + hm * 96, K1 + hm * 96, KPITCH, V1 + hm * 64, D, 1.0f, OB + (size_t)(tq0 + r32) * D + hm * 64, wl, lane);
        }
        __syncthreads();
    }
    SEAM(8);
    if (IN(9)) {
        pg8::Gemm g{OB, (const bf16*)(ws + W_OUT1), S, D, D, D}; pg8::StaticOrder So; So.init(S, D, G, bx);
        pg8::EpiResid E{out, out, XB, SS3};
        pg8::gemm_phase<pg8::EpiResid, true>(lds, g, So, E);
    }
    SEAM(9);
    if (IN(10)) {
        pg8::Gemm g{XB, (const bf16*)(ws + W_GU1), S, 2 * FF, D, D}; pg8::StaticOrder So; So.init(S, 2 * FF, G, bx);
        pg8::EpiSwiGLU E{BIG, SS3};
        pg8::gemm_phase<pg8::EpiSwiGLU, true>(lds, g, So, E);
    }
    SEAM(10);
    if (IN(11)) {
        pg8::Gemm g{BIG, (const bf16*)(ws + W_D1), S, D, FF, FF}; pg8::StaticOrder So; So.init(S, D, G, bx);
        pg8::EpiResid E{out, out, XB, SS4};
        pg8::gemm_phase<pg8::EpiResid, true>(lds, g, So, E);
    }
    SEAM(11);
    if (IN(12)) {
        const f32x4* gf = (const f32x4*)args.in[I_FINAL] + lane;
        for (int mrow = gw; mrow < S; mrow += NGW) {
            f32x4* xr = (f32x4*)(out + (size_t)mrow * D) + lane; f32x4 v[4]; float s2 = 0.f;
#pragma unroll
            for (int j = 0; j < 4; ++j) { v[j] = xr[64 * j]; s2 += (v[j].x * v[j].x + v[j].y * v[j].y) + (v[j].z * v[j].z + v[j].w * v[j].w); }
            const float rs = 1.0f / sqrtf(wave_sum(s2) * (1.0f / D) + RMS_EPS);
#pragma unroll
            for (int j = 0; j < 4; ++j) xr[64 * j] = v[j] * rs * gf[64 * j];
        }
    }
#undef IN
#undef SEAM
}

#if DBG_CHECK
namespace dbg {
constexpr int NSAMP = 1024;
__device__ __forceinline__ int srow(int i) { return 16 * i + ((i * 5) & 15); }
__device__ __forceinline__ void accum(float err, float ref, float* stats, int slot) {
    __shared__ float se[8], sr[8];
    err = wave_sum(err); ref = wave_sum(ref);
    const int w = threadIdx.x >> 6;
    if ((threadIdx.x & 63) == 0) { se[w] = err; sr[w] = ref; }
    __syncthreads();
    if (threadIdx.x == 0) { float e = 0.f, r = 0.f; for (int i = 0; i < (int)(blockDim.x >> 6); ++i) { e += se[i]; r += sr[i]; } atomicAdd(stats + 2 * slot, e); atomicAdd(stats + 2 * slot + 1, r); }
    __syncthreads();
}
__global__ void k_rowrstd(const float* src, int ld, int ncols, int compact, float* outv) {
    const int i = blockIdx.x, m = compact ? i : srow(i); float s = 0.f;
    for (int k = threadIdx.x; k < ncols; k += 64) { const float v = src[(size_t)m * ld + k]; s += v * v; }
    s = wave_sum(s);
    if (threadIdx.x == 0) outv[i] = 1.0f / sqrtf(s / ncols + RMS_EPS);
}
__global__ void k_rowrstd_bf(const bf16* src, int ld, int ncols, float* outv) {
    const int i = blockIdx.x, m = srow(i); float s = 0.f;
    for (int k = threadIdx.x; k < ncols; k += 64) { const float v = bf2f(src[(size_t)m * ld + k]); s += v * v; }
    s = wave_sum(s);
    if (threadIdx.x == 0) outv[i] = 1.0f / sqrtf(s / ncols + RMS_EPS);
}
__global__ void k_save_rows(const float* src, float* dst) {
    const int i = blockIdx.x, m = srow(i);
    for (int k = threadIdx.x; k < D; k += blockDim.x) dst[(size_t)i * D + k] = src[(size_t)m * D + k];
}
template <int ABF, int GOTBF>
__global__ void k_chk_lin(const void* A, int lda, int acomp, const float* rs, const float* gain, const float* W, int ldw, int K, int N,
                          const float* resid, int ldr, int rcomp, const void* got, int ldg, float gscale, float* stats, int slot) {
    const int i = blockIdx.y, m = srow(i), n = blockIdx.x * 256 + threadIdx.x;
    float err = 0.f, ref2 = 0.f;
    if (n < N) {
        const size_t arow = (size_t)(acomp ? i : m) * lda; float acc = 0.f;
        for (int k = 0; k < K; ++k) { const float a = ABF ? bf2f(((const bf16*)A)[arow + k]) : ((const float*)A)[arow + k]; acc += a * (gain ? gain[k] : 1.0f) * W[(size_t)k * ldw + n]; }
        float ref = acc * (rs ? rs[i] : 1.0f);
        if (resid) ref += resid[(size_t)(rcomp ? i : m) * ldr + n];
        const float g = (GOTBF ? bf2f(((const bf16*)got)[(size_t)m * ldg + n]) : ((const float*)got)[(size_t)m * ldg + n]) * gscale;
        err = (g - ref) * (g - ref); ref2 = ref * ref;
    }
    accum(err, ref2, stats, slot);
}
__global__ void k_chk_swiglu(const float* X, const float* rs, const float* gain, const float* Wg, const float* Wu, const bf16* got, float* stats, int slot) {
    const int i = blockIdx.y, m = srow(i), n = blockIdx.x * 256 + threadIdx.x;
    float a = 0.f, b = 0.f;
    for (int k = 0; k < D; ++k) { const float h = X[(size_t)m * D + k] * gain[k]; a += h * Wg[(size_t)k * FF + n]; b += h * Wu[(size_t)k * FF + n]; }
    a *= rs[i]; b *= rs[i];
    const float ref = a / (1.0f + expf(-a)) * b, g = bf2f(got[(size_t)m * FF + n]);
    accum((g - ref) * (g - ref), ref * ref, stats, slot);
}
__global__ void k_chk_krope(const float* X, const float* rs, const float* gain, const float* Win1, const bf16* K1, float* stats, int slot) {
    const int si = blockIdx.x, m = srow(si), i = threadIdx.x & 31, f = i & 15;
    float x1 = 0.f, x2 = 0.f;
    for (int k = 0; k < D; ++k) { const float h = X[(size_t)m * D + k] * gain[k]; x1 += h * Win1[(size_t)k * NIN1 + 512 + f]; x2 += h * Win1[(size_t)k * NIN1 + 528 + f]; }
    x1 *= rs[si]; x2 *= rs[si];
    const float fr = powf(10000.0f, -(float)f / 16.0f), ang = (float)m * fr, c = cosf(ang), sn = sinf(ang);
    const float ref = (i < 16) ? (x1 * c - x2 * sn) : (x1 * sn + x2 * c);
    float err = 0.f, r2 = 0.f;
    for (int h = (threadIdx.x >> 5) * 8; h < (threadIdx.x >> 5) * 8 + 8; ++h) { const float g = bf2f(K1[(size_t)m * KPITCH + h * 96 + 64 + i]); err += (g - ref) * (g - ref); r2 += ref * ref; }
    accum(err, r2, stats, slot);
}
__global__ void k_chk_q(const bf16* P, const float* rsq, const float* qnorm, const float* Wuq, const bf16* Q1, float* stats, int slot) {
    const int si = blockIdx.y, m = srow(si), n = blockIdx.x * 256 + threadIdx.x, off = n % 96;
    const bool rope = off >= 64; const int f = (off - 64) & 15; const int n1 = n - off + 64 + f, n2 = n1 + 16;
    float a = 0.f, b = 0.f;
    for (int k = 0; k < QL; ++k) { const float c = bf2f(P[(size_t)m * NIN1P + k]) * qnorm[k];
        if (rope) { a += c * Wuq[(size_t)k * NQ1 + n1]; b += c * Wuq[(size_t)k * NQ1 + n2]; } else a += c * Wuq[(size_t)k * NQ1 + n]; }
    a *= rsq[si]; b *= rsq[si];
    float ref = a;
    if (rope) { const float fr = powf(10000.0f, -(float)f / 16.0f), ang = (float)m * fr, c = cosf(ang), sn = sinf(ang); ref = (off < 80) ? (a * c - b * sn) : (a * sn + b * c); }
    const float g = bf2f(Q1[(size_t)m * NQ1 + n]) / C2_MLA;
    accum((g - ref) * (g - ref), ref * ref, stats, slot);
}
__global__ void k_chk_kv(const bf16* P, const float* rskv, const float* kvnorm, const float* W, const bf16* got, int iskf, float* stats, int slot) {
    const int si = blockIdx.y, m = srow(si), n = blockIdx.x * 256 + threadIdx.x;
    float a = 0.f;
    for (int k = 0; k < KVL; ++k) a += bf2f(P[(size_t)m * NIN1P + QL + k]) * kvnorm[k] * W[(size_t)k * D + n];
    a *= rskv[si];
    const float g = iskf ? bf2f(got[(size_t)m * KPITCH + (n >> 6) * 96 + (n & 63)]) : bf2f(got[(size_t)m * D + n]);
    accum((g - a) * (g - a), a * a, stats, slot);
}
__device__ __forceinline__ int ltok(int i) { if (i < 4) return i; if (i < 8) return S - 1 - (i - 4); return 32 * i + ((i * 13) & 31); }
__global__ void __launch_bounds__(64) k_chk_local(const bf16* QKV, const float* t5, const float* rpb, const bf16* O, float* stats, int slot) {
    const int idx = blockIdx.x * 64 + threadIdx.x, i = idx >> 4, h = idx & 15, t = ltok(i);
    float q[64], o[64];
    float err = 0.f, r2 = 0.f;
    if (h < 8) {
        const bf16* qp = QKV + (size_t)t * NQKV + h * 64;
        _Pragma("unroll") for (int d = 0; d < 64; ++d) { q[d] = bf2f(qp[d]); o[d] = 0.f; }
        float mb[3], denb[3];
        _Pragma("unroll") for (int b = 0; b < 3; ++b) { const int dil = b == 0 ? 1 : (b == 1 ? 4 : 16); float mx = -3e38f;
            for (int j = -64; j <= 64; ++j) { const int u = t + dil * j; if (u < 0 || u >= S) continue;
                const bf16* kp = QKV + (size_t)u * NQKV + 512 + h * 64; float sc = 0.f; _Pragma("unroll") for (int d = 0; d < 64; ++d) sc += q[d] * bf2f(kp[d]);
                sc = sc * 0.125f + t5[t5_bucket_precise(dil * j) * 16 + h]; mx = fmaxf(mx, sc); }
            float den = 0.f;
            for (int j = -64; j <= 64; ++j) { const int u = t + dil * j; if (u < 0 || u >= S) continue;
                const bf16* kp = QKV + (size_t)u * NQKV + 512 + h * 64; float sc = 0.f; _Pragma("unroll") for (int d = 0; d < 64; ++d) sc += q[d] * bf2f(kp[d]);
                sc = sc * 0.125f + t5[t5_bucket_precise(dil * j) * 16 + h]; den += expf(sc - mx); }
            mb[b] = mx; denb[b] = den; }
        float lse[3], M = -3e38f; _Pragma("unroll") for (int b = 0; b < 3; ++b) { lse[b] = mb[b] + logf(denb[b]); M = fmaxf(M, lse[b]); }
        float wsum = 0.f, wb[3]; _Pragma("unroll") for (int b = 0; b < 3; ++b) { wb[b] = expf(lse[b] - M); wsum += wb[b]; }
        _Pragma("unroll") for (int b = 0; b < 3; ++b) { const int dil = b == 0 ? 1 : (b == 1 ? 4 : 16); const float coef = wb[b] / wsum / denb[b];
            for (int j = -64; j <= 64; ++j) { const int u = t + dil * j; if (u < 0 || u >= S) continue;
                const bf16* kp = QKV + (size_t)u * NQKV + 512 + h * 64; const bf16* vp = QKV + (size_t)u * NQKV + 1024 + h * 64; float sc = 0.f; _Pragma("unroll") for (int d = 0; d < 64; ++d) sc += q[d] * bf2f(kp[d]);
                sc = sc * 0.125f + t5[t5_bucket_precise(dil * j) * 16 + h]; const float p = expf(sc - mb[b]) * coef;
                _Pragma("unroll") for (int d = 0; d < 64; ++d) o[d] += p * bf2f(vp[d]); } }
        const bf16* op = O + (size_t)t * D + h * 64;
        _Pragma("unroll") for (int d = 0; d < 64; ++d) { const float g = bf2f(op[d]); err += (g - o[d]) * (g - o[d]); r2 += o[d] * o[d]; }
    } else {
        const int hb = h - 8, r = t >> 6, c = t & 63;
        int r0 = r - 4; r0 = r0 < 0 ? 0 : (r0 > 248 ? 248 : r0); int c0 = c - 8; c0 = c0 < 0 ? 0 : (c0 > 48 ? 48 : c0);
        const bf16* qp = QKV + (size_t)t * NQKV + 1536 + hb * 64;
        _Pragma("unroll") for (int d = 0; d < 64; ++d) { q[d] = bf2f(qp[d]); o[d] = 0.f; }
        float mx = -3e38f;
        for (int kr = 0; kr < 8; ++kr) for (int kc = c0; kc < c0 + 16; ++kc) { const int u = (r0 + kr) * 64 + kc;
            const bf16* kp = QKV + (size_t)u * NQKV + 2048 + hb * 64; float sc = 0.f; _Pragma("unroll") for (int d = 0; d < 64; ++d) sc += q[d] * bf2f(kp[d]);
            sc = sc * 0.125f + rpb[(hb * 15 + (r0 + kr - r + 7)) * 31 + (kc - c + 15)]; mx = fmaxf(mx, sc); }
        float den = 0.f;
        for (int kr = 0; kr < 8; ++kr) for (int kc = c0; kc < c0 + 16; ++kc) { const int u = (r0 + kr) * 64 + kc;
            const bf16* kp = QKV + (size_t)u * NQKV + 2048 + hb * 64; const bf16* vp = QKV + (size_t)u * NQKV + 2560 + hb * 64; float sc = 0.f; _Pragma("unroll") for (int d = 0; d < 64; ++d) sc += q[d] * bf2f(kp[d]);
            sc = sc * 0.125f + rpb[(hb * 15 + (r0 + kr - r + 7)) * 31 + (kc - c + 15)]; const float p = expf(sc - mx); den += p;
            _Pragma("unroll") for (int d = 0; d < 64; ++d) o[d] += p * bf2f(vp[d]); }
        const bf16* op = O + (size_t)t * D + 512 + hb * 64;
        _Pragma("unroll") for (int d = 0; d < 64; ++d) { const float g = bf2f(op[d]); const float rf = o[d] / den; err += (g - rf) * (g - rf); r2 += rf * rf; }
    }
    accum(err, r2, stats, slot);
}
__global__ void __launch_bounds__(256) k_chk_mla(const bf16* Q1, const bf16* K1, const bf16* V1, const float* t5, const bf16* O, float* stats, int slot) {
    const int i = blockIdx.x >> 4, h = blockIdx.x & 15, t = 256 * i + ((i * 37) & 255), tid = threadIdx.x;
    __shared__ float qs[96], red[8], so[64];
    if (tid < 96) qs[tid] = bf2f(Q1[(size_t)t * NQ1 + h * 96 + tid]);
    if (tid < 64) so[tid] = 0.f;
    __syncthreads();
    float mx = -3e38f;
    for (int k = tid; k < S; k += 256) { const bf16* kp = K1 + (size_t)k * KPITCH + h * 96; float sc = 0.f; _Pragma("unroll") for (int d = 0; d < 96; ++d) sc += qs[d] * bf2f(kp[d]);
        sc += t5[t5_bucket_precise(k - t) * 16 + h] * LOG2E; mx = fmaxf(mx, sc); }
    for (int o = 1; o < 64; o <<= 1) mx = fmaxf(mx, __shfl_xor(mx, o));
    if ((tid & 63) == 0) red[tid >> 6] = mx;
    __syncthreads();
    mx = fmaxf(fmaxf(red[0], red[1]), fmaxf(red[2], red[3]));
    __syncthreads();
    float den = 0.f, o[64];
    _Pragma("unroll") for (int d = 0; d < 64; ++d) o[d] = 0.f;
    for (int k = tid; k < S; k += 256) { const bf16* kp = K1 + (size_t)k * KPITCH + h * 96; const bf16* vp = V1 + (size_t)k * D + h * 64; float sc = 0.f; _Pragma("unroll") for (int d = 0; d < 96; ++d) sc += qs[d] * bf2f(kp[d]);
        sc += t5[t5_bucket_precise(k - t) * 16 + h] * LOG2E; const float p = exp2f(sc - mx); den += p;
        _Pragma("unroll") for (int d = 0; d < 64; ++d) o[d] += p * bf2f(vp[d]); }
    den = wave_sum(den);
    if ((tid & 63) == 0) red[4 + (tid >> 6)] = den;
    _Pragma("unroll") for (int d = 0; d < 64; ++d) { const float v = wave_sum(o[d]); if ((tid & 63) == 0) atomicAdd(&so[d], v); }
    __syncthreads();
    den = red[4] + red[5] + red[6] + red[7];
    float err = 0.f, r2 = 0.f;
    if (tid < 64) { const float rf = so[tid] / den, g = bf2f(O[(size_t)t * D + h * 64 + tid]); err = (g - rf) * (g - rf); r2 = rf * rf; }
    accum(err, r2, stats, slot);
}
__global__ void k_chk_final(const float* save, const float* rs, const float* gf, const float* outp, float* stats, int slot) {
    const int i = blockIdx.x, m = srow(i); float err = 0.f, r2 = 0.f;
    for (int k = threadIdx.x; k < D; k += 256) { const float ref = save[(size_t)i * D + k] * rs[i] * gf[k], g = outp[(size_t)m * D + k]; err += (g - ref) * (g - ref); r2 += ref * ref; }
    accum(err, r2, stats, slot);
}
__global__ void k_finalize(const float* stats, float* outp, float tol, int magslot) {
    if (threadIdx.x != 0 || blockIdx.x != 0) return;
    int fail = 0; float relf = 0.f;
    for (int s = 1; s <= 16; ++s) { const float e = stats[2 * s], r = stats[2 * s + 1]; const float rel = sqrtf(e / fmaxf(r, 1e-30f)); const bool bad = !(rel <= tol) || !(r > 0.f);
        if (bad && !fail) { fail = s; relf = rel; } }
    if (magslot > 0) { const float e = stats[2 * magslot], r = stats[2 * magslot + 1]; outp[0] += 1.0e4f * fminf(sqrtf(e / fmaxf(r, 1e-30f)), 10.f) + 1.0f; }
    else if (fail) outp[0] += 100.0f + 10.0f * fail;
}
}

#endif

extern "C" void kernel_launch(void* const* d_in, const int* in_sizes, int n_in, void* d_out, int out_size, void* d_ws, size_t ws_size, hipStream_t stream) {
    static int grid = 0;
    if (grid == 0) {
        if (n_in != 18 || in_sizes[0] != S * D || out_size != S * D || ws_size < WS_END) { fprintf(stderr, "kernel_launch: unexpected shapes (n_in %d, in0 %d, out %d, ws %zu)\n", n_in, n_in > 0 ? in_sizes[0] : -1, out_size, ws_size); grid = -1; return; }
        int dev = 0, cus = 0, per_cu = 0;
        if (hipGetDevice(&dev) != hipSuccess || hipDeviceGetAttribute(&cus, hipDeviceAttributeMultiprocessorCount, dev) != hipSuccess) { grid = -1; return; }
        if (hipFuncSetAttribute((const void*)fwd_kernel, hipFuncAttributeMaxDynamicSharedMemorySize, LDS_BYTES) != hipSuccess) { fprintf(stderr, "kernel_launch: hipFuncSetAttribute failed\n"); grid = -1; return; }
        if (hipOccupancyMaxActiveBlocksPerMultiprocessor(&per_cu, (const void*)fwd_kernel, NWAVES * 64, LDS_BYTES) != hipSuccess || per_cu < 1) fprintf(stderr, "kernel_launch: occupancy query reports %d\n", per_cu);
        (void)hipGetLastError();
        grid = cus;
        if (grid != 256) fprintf(stderr, "kernel_launch: %d CUs; this kernel's unit maps assume 256\n", grid);
    }
    if (grid < 0) return;
    (void)hipMemsetAsync((char*)d_ws + WS_CTL, 0, CTL_ZERO_BYTES, stream);
    Args a{};
    for (int i = 0; i < 18; ++i) a.in[i] = (const float*)d_in[i];
    a.out = (float*)d_out; a.ws = (unsigned char*)d_ws;
#if DBG_CHECK
    {
        using namespace dbg;
        unsigned char* ws = (unsigned char*)d_ws; float* outp = (float*)d_out;
        float* stats = (float*)(ws + CTL_STATS); float* rstd = (float*)(ws + CTL_RSTD); float* rstd2 = rstd + 1024; float* save = (float*)(ws + WS_SAVE);
        bf16* XBp = (bf16*)(ws + WS_XB); bf16* OBp = (bf16*)(ws + WS_O); bf16* BIGp = (bf16*)(ws + WS_BIG); bf16* Q1p = (bf16*)(ws + WS_Q1); bf16* K1p = (bf16*)(ws + WS_K1); bf16* V1p = (bf16*)(ws + WS_V1);
        const float* x = a.in[I_X];
        for (int ph = 0; ph < NPH; ++ph) {
            if (ph == 5 || ph == 9 || ph == 11 || ph == 12) hipLaunchKernelGGL(k_save_rows, dim3(NSAMP), dim3(256), 0, stream, (const float*)outp, save);
            a.ph_lo = ph; a.ph_hi = ph + 1;
            hipLaunchKernelGGL(fwd_kernel, dim3(grid), dim3(NWAVES * 64), LDS_BYTES, stream, a);
            switch (ph) {
            case 1: hipLaunchKernelGGL(k_rowrstd, dim3(NSAMP), dim3(64), 0, stream, x, D, D, 0, rstd);
                hipLaunchKernelGGL((k_chk_lin<0, 1>), dim3(12, NSAMP), dim3(256), 0, stream, (const void*)x, D, 0, (const float*)rstd, a.in[I_ANORM], a.in[I_EWIN], NQKV, D, NQKV, (const float*)nullptr, 0, 0, (const void*)BIGp, NQKV, 1.0f, stats, 1); break;
            case 2: hipLaunchKernelGGL(k_chk_local, dim3(512 * 16 / 64), dim3(64), 0, stream, (const bf16*)BIGp, a.in[I_T5], a.in[I_RPB], (const bf16*)OBp, stats, 2); break;
            case 3: hipLaunchKernelGGL((k_chk_lin<1, 0>), dim3(4, NSAMP), dim3(256), 0, stream, (const void*)OBp, D, 0, (const float*)nullptr, (const float*)nullptr, a.in[I_EWOUT], D, D, D, x, D, 0, (const void*)outp, D, 1.0f, stats, 3);
                hipLaunchKernelGGL((k_chk_lin<1, 1>), dim3(4, NSAMP), dim3(256), 0, stream, (const void*)OBp, D, 0, (const float*)nullptr, (const float*)nullptr, a.in[I_EWOUT], D, D, D, x, D, 0, (const void*)XBp, D, 1.0f, stats, 16); break;
            case 4: hipLaunchKernelGGL(k_rowrstd, dim3(NSAMP), dim3(64), 0, stream, (const float*)outp, D, D, 0, rstd);
                hipLaunchKernelGGL(k_chk_swiglu, dim3(11, NSAMP), dim3(256), 0, stream, (const float*)outp, (const float*)rstd, a.in[I_FNORM], a.in[I_WG], a.in[I_WU], (const bf16*)BIGp, stats, 4); break;
            case 5: hipLaunchKernelGGL((k_chk_lin<1, 0>), dim3(4, NSAMP), dim3(256), 0, stream, (const void*)BIGp, FF, 0, (const float*)nullptr, (const float*)nullptr, a.in[I_WD], D, FF, D, (const float*)save, D, 1, (const void*)outp, D, 1.0f, stats, 5); break;
            case 6: hipLaunchKernelGGL(k_rowrstd, dim3(NSAMP), dim3(64), 0, stream, (const float*)outp, D, D, 0, rstd);
                hipLaunchKernelGGL((k_chk_lin<0, 1>), dim3(2, NSAMP), dim3(256), 0, stream, (const void*)outp, D, 0, (const float*)rstd, a.in[I_ANORM] + D, a.in[I_OWIN], NIN1, D, 512, (const float*)nullptr, 0, 0, (const void*)OBp, NIN1P, 1.0f, stats, 6);
                hipLaunchKernelGGL(k_chk_krope, dim3(NSAMP), dim3(64), 0, stream, (const float*)outp, (const float*)rstd, a.in[I_ANORM] + D, a.in[I_OWIN], (const bf16*)K1p, stats, 7); break;
            case 7: hipLaunchKernelGGL(k_rowrstd_bf, dim3(NSAMP), dim3(64), 0, stream, (const bf16*)OBp, NIN1P, QL, rstd);
                hipLaunchKernelGGL(k_rowrstd_bf, dim3(NSAMP), dim3(64), 0, stream, (const bf16*)OBp + QL, NIN1P, KVL, rstd2);
                hipLaunchKernelGGL(k_chk_q, dim3(6, NSAMP), dim3(256), 0, stream, (const bf16*)OBp, (const float*)rstd, a.in[I_QNORM], a.in[I_WUQ], (const bf16*)Q1p, stats, 8);
                hipLaunchKernelGGL(k_chk_kv, dim3(4, NSAMP), dim3(256), 0, stream, (const bf16*)OBp, (const float*)rstd2, a.in[I_KVNORM], a.in[I_WUK], (const bf16*)K1p, 1, stats, 9);
                hipLaunchKernelGGL(k_chk_kv, dim3(4, NSAMP), dim3(256), 0, stream, (const bf16*)OBp, (const float*)rstd2, a.in[I_KVNORM], a.in[I_WUV], (const bf16*)V1p, 0, stats, 10); break;
            case 8: hipLaunchKernelGGL(k_chk_mla, dim3(64 * 16), dim3(256), 0, stream, (const bf16*)Q1p, (const bf16*)K1p, (const bf16*)V1p, a.in[I_T5], (const bf16*)OBp, stats, 11); break;
            case 9: hipLaunchKernelGGL((k_chk_lin<1, 0>), dim3(4, NSAMP), dim3(256), 0, stream, (const void*)OBp, D, 0, (const float*)nullptr, (const float*)nullptr, a.in[I_OWOUT], D, D, D, (const float*)save, D, 1, (const void*)outp, D, 1.0f, stats, 12); break;
            case 10: hipLaunchKernelGGL(k_rowrstd, dim3(NSAMP), dim3(64), 0, stream, (const float*)outp, D, D, 0, rstd);
                hipLaunchKernelGGL(k_chk_swiglu, dim3(11, NSAMP), dim3(256), 0, stream, (const float*)outp, (const float*)rstd, a.in[I_FNORM] + D, a.in[I_WG] + (size_t)D * FF, a.in[I_WU] + (size_t)D * FF, (const bf16*)BIGp, stats, 13); break;
            case 11: hipLaunchKernelGGL((k_chk_lin<1, 0>), dim3(4, NSAMP), dim3(256), 0, stream, (const void*)BIGp, FF, 0, (const float*)nullptr, (const float*)nullptr, a.in[I_WD] + (size_t)FF * D, D, FF, D, (const float*)save, D, 1, (const void*)outp, D, 1.0f, stats, 14); break;
            case 12: hipLaunchKernelGGL(k_rowrstd, dim3(NSAMP), dim3(64), 0, stream, (const float*)save, D, D, 1, rstd);
                hipLaunchKernelGGL(k_chk_final, dim3(NSAMP), dim3(256), 0, stream, (const float*)save, (const float*)rstd, a.in[I_FINAL], (const float*)outp, stats, 15); break;
            default: break;
            }
        }
        hipLaunchKernelGGL(k_finalize, dim3(1), dim3(64), 0, stream, (const float*)stats, outp, DBG_TOL, DBG_MAGSLOT);
    }
#else
    a.ph_lo = 0; a.ph_hi = NPH;
    hipLaunchKernelGGL(fwd_kernel, dim3(grid), dim3(NWAVES * 64), LDS_BYTES, stream, a);
#endif
}
```

```cpp
#include <hip/hip_runtime.h>
#include <cstdio>
#include <cstdint>

#ifndef DBG_CHECK
#define DBG_CHECK 0
#endif
#ifndef DBG_TOL
#define DBG_TOL 0.03f
#endif
#ifndef DBG_MAGSLOT
#define DBG_MAGSLOT 0
#endif

#define LAS __attribute__((address_space(3)))
#define GAS __attribute__((address_space(1)))
typedef unsigned short bf16;
typedef short bf16x8 __attribute__((ext_vector_type(8)));
typedef short s16x4 __attribute__((ext_vector_type(4)));
typedef float f32x4 __attribute__((ext_vector_type(4)));
typedef float f32x16 __attribute__((ext_vector_type(16)));
typedef unsigned u32x4 __attribute__((ext_vector_type(4)));
typedef unsigned u32x2 __attribute__((ext_vector_type(2)));
typedef float f32x2_t __attribute__((ext_vector_type(2)));
typedef __bf16 bf16x2_t __attribute__((ext_vector_type(2)));

constexpr int S = 16384, D = 1024, FF = 2816, NQKV = 3072;
constexpr int NIN1 = 544, NIN1P = 768, QL = 384, KVL = 128, KVLP = 256, NQ1 = 1536, NKV1 = 2048, KPITCH = 1536  ;
constexpr float RMS_EPS = 1e-6f, LOG2E = 1.4426950408889634f;
constexpr float C2_LOCAL = 0.125f * LOG2E;
constexpr float C2_MLA = 0.10206207261596577f * LOG2E;
constexpr float NEGB = -1e30f;

constexpr size_t MiB = 1u << 20;
constexpr size_t WS_CTL = 0, CTL_ZERO_BYTES = 1 * MiB;
constexpr size_t CTL_BAR = 16384;
constexpr size_t CTL_SS = 128 * 1024;
constexpr size_t CTL_STATS = 600 * 1024;
constexpr size_t CTL_RSTD = 640 * 1024;
constexpr size_t WS_ROPE = 1 * MiB;
constexpr size_t WS_TDIL = 3 * MiB;
constexpr size_t WS_TMLA = 3 * MiB + 128 * 1024;
constexpr size_t WS_TRPB = 3 * MiB + 256 * 1024;
constexpr size_t WS_W = 8 * MiB;
constexpr size_t W_IN0 = WS_W, W_OUT0 = W_IN0 + 6 * MiB, W_GU0 = W_OUT0 + 2 * MiB, W_D0 = W_GU0 + 11 * MiB, W_IN1 = W_D0 + 6 * MiB,
                 W_UQ = W_IN1 + 2 * MiB, W_UKV = W_UQ + 2 * MiB, W_OUT1 = W_UKV + 1 * MiB, W_GU1 = W_OUT1 + 2 * MiB, W_D1 = W_GU1 + 11 * MiB, W_END = W_D1 + 6 * MiB;
constexpr size_t WS_XB = 57 * MiB;
constexpr size_t WS_O = 89 * MiB;
constexpr size_t WS_BIG = 121 * MiB;
constexpr size_t WS_Q1 = WS_BIG, WS_K1 = WS_BIG + 48 * MiB, WS_V1 = 217 * MiB;
constexpr size_t WS_SAVE = 252 * MiB, WS_END = 256 * MiB;
static_assert(W_END <= WS_XB && WS_V1 + 32 * MiB <= WS_SAVE, "d_ws map");

constexpr int LDS_BYTES = 147456;
constexpr int MISC_OFF = 131072 + 320;
constexpr int LDSCTL_OFF = 131072;

__device__ __forceinline__ float bf2f(unsigned short b) { return __builtin_bit_cast(float, (unsigned)b << 16); }
__device__ __forceinline__ unsigned cvtpk(float lo, float hi) { f32x2_t v = {lo, hi}; bf16x2_t b = __builtin_convertvector(v, bf16x2_t); return __builtin_bit_cast(unsigned, b); }
__device__ __forceinline__ float wave_sum(float v) {
#pragma unroll
    for (int o = 1; o < 64; o <<= 1) v += __shfl_xor(v, o);
    return v;
}

namespace pg8 {
constexpr int BM = 256, BK = 64, HALF = 128, HTB = HALF * BK * 2, STAGE_BYTES = 8 * HTB, NXCD = 8, WGM = 8;
__host__ __device__ __forceinline__ int lds_byte(int r, int c) { const int st = (r >> 4) * 2 + (c >> 5), rr = r & 15, cc = c & 31, ob = rr * 64 + cc * 2; return st * 1024 + (ob ^ (((ob >> 9) & 1) << 5)); }
__host__ __device__ __forceinline__ void stage_rc(int b, int& R, int& C) { const int st = b / 1024, sb = b % 1024, swz = sb ^ (((sb >> 9) & 1) << 5); R = (st >> 1) * 16 + swz / 64; C = (st & 1) * 32 + (swz % 64) / 2; }
__host__ __device__ __forceinline__ int perm32(int rho) { const int n = rho >> 4, i = rho & 15; return 8 * (i >> 2) + 4 * n + (i & 3); }

struct Unit { int pm, pn; };
struct Gemm { const bf16* A; const bf16* Bt; int M, N, K, lda; };

struct StaticOrder {
    int nM, nN, nwg, G, c;
    __device__ void init(int M, int N, int G_, int c_) { nM = M / BM; nN = N / BM; nwg = nM * nN; G = G_; c = c_; }
    __device__ bool next(int i, Unit& u) const {
        const long L = (long)i * G + c; if (L >= nwg) return false;
        int wgid = (int)L; { const int q = nwg / NXCD, r = nwg % NXCD, xcd = wgid % NXCD, off = wgid / NXCD; wgid = (xcd < r ? xcd * (q + 1) : r * (q + 1) + (xcd - r) * q) + off; }
        const int nig = WGM * nN, gid = wgid / nig, fm = gid * WGM, gsz = (nM - fm) < WGM ? (nM - fm) : WGM;
        u.pm = fm + ((wgid % nig) % gsz); u.pn = (wgid % nig) / gsz; return true;
    }
};

typedef f32x4 Acc[2][2][4][2];

struct EpiRowScale {
    bf16* O; int ldc; const float* ss; float invk;
    __device__ __forceinline__ void operator()(const Acc& acc, const Unit& u, int wr, int wc, int fr, int fq) const {
        const int row0 = u.pm * BM + wr * 64 + fr, col0 = u.pn * BM + wc * 32 + 8 * fq;
#pragma unroll
        for (int ai = 0; ai < 2; ++ai)
#pragma unroll
            for (int m = 0; m < 4; ++m) { const int row = row0 + ai * HALF + m * 16; const float rs = __builtin_amdgcn_rsqf(ss[row] * invk + RMS_EPS);
                bf16* rowp = O + (size_t)row * ldc + col0;
#pragma unroll
                for (int bj = 0; bj < 2; ++bj) { const f32x4 v0 = acc[ai][bj][m][0] * rs, v1 = acc[ai][bj][m][1] * rs;
                    u32x4 w; w.x = cvtpk(v0[0], v0[1]); w.y = cvtpk(v0[2], v0[3]); w.z = cvtpk(v1[0], v1[1]); w.w = cvtpk(v1[2], v1[3]);
                    *(u32x4*)(rowp + bj * HALF) = w; } }
    }
};
struct EpiResid {
    const float* R; float* X; bf16* XB; float* ssout;
    __device__ __forceinline__ void operator()(const Acc& acc, const Unit& u, int wr, int wc, int fr, int fq) const {
        const int row0 = u.pm * BM + wr * 64 + fr, col0 = u.pn * BM + wc * 32 + 8 * fq;
#pragma unroll
        for (int ai = 0; ai < 2; ++ai)
#pragma unroll
            for (int m = 0; m < 4; ++m) { const int row = row0 + ai * HALF + m * 16; const size_t off = (size_t)row * D + col0; float sq = 0.f;
#pragma unroll
                for (int bj = 0; bj < 2; ++bj) { const f32x4 r0 = *(const f32x4*)(R + off + bj * HALF), r1 = *(const f32x4*)(R + off + bj * HALF + 4);
                    const f32x4 v0 = acc[ai][bj][m][0] + r0, v1 = acc[ai][bj][m][1] + r1;
                    *(f32x4*)(X + off + bj * HALF) = v0; *(f32x4*)(X + off + bj * HALF + 4) = v1;
                    u32x4 w; w.x = cvtpk(v0[0], v0[1]); w.y = cvtpk(v0[2], v0[3]); w.z = cvtpk(v1[0], v1[1]); w.w = cvtpk(v1[2], v1[3]);
                    *(u32x4*)(XB + off + bj * HALF) = w;
                    sq += (v0[0] * v0[0] + v0[1] * v0[1]) + (v0[2] * v0[2] + v0[3] * v0[3]) + (v1[0] * v1[0] + v1[1] * v1[1]) + (v1[2] * v1[2] + v1[3] * v1[3]); }
                sq += __shfl_xor(sq, 16); sq += __shfl_xor(sq, 32);
                if (fq == 0) atomicAdd(ssout + row, sq); }
    }
};
struct EpiSwiGLU {
    bf16* O; const float* ss;
    __device__ __forceinline__ void operator()(const Acc& acc, const Unit& u, int wr, int wc, int fr, int fq) const {
        const int row0 = u.pm * BM + wr * 64 + fr, col0 = u.pn * HALF + wc * 32 + 8 * fq;
#pragma unroll
        for (int ai = 0; ai < 2; ++ai)
#pragma unroll
            for (int m = 0; m < 4; ++m) { const int row = row0 + ai * HALF + m * 16; const float rs = __builtin_amdgcn_rsqf(ss[row] * (1.0f / D) + RMS_EPS);
                float a[8];
#pragma unroll
                for (int n = 0; n < 2; ++n)
#pragma unroll
                    for (int e = 0; e < 4; ++e) { const float g = acc[ai][0][m][n][e] * rs, up = acc[ai][1][m][n][e] * rs;
                        a[4 * n + e] = g * __builtin_amdgcn_rcpf(1.0f + __builtin_amdgcn_exp2f(-LOG2E * g)) * up; }
                u32x4 w; w.x = cvtpk(a[0], a[1]); w.y = cvtpk(a[2], a[3]); w.z = cvtpk(a[4], a[5]); w.w = cvtpk(a[6], a[7]);
                *(u32x4*)(O + (size_t)row * FF + col0) = w; }
    }
};
__device__ __forceinline__ void rope8(float (&v)[8], const float* cs_row  , int fq) {
    const int f0 = 8 * (fq & 1);
#pragma unroll
    for (int e = 0; e < 8; ++e) { const float other = __shfl_xor(v[e], 32); const float c = cs_row[2 * (f0 + e)], s = cs_row[2 * (f0 + e) + 1];
        v[e] = (fq < 2) ? (v[e] * c - other * s) : (other * s + v[e] * c); }
}
struct EpiMlaIn {
    bf16* P; const float* ss; float* ssq; float* sskv; bf16* KF; const float* cs;
    __device__ __forceinline__ void operator()(const Acc& acc, const Unit& u, int wr, int wc, int fr, int fq) const {
        const int row0 = u.pm * BM + wr * 64 + fr, col0 = u.pn * BM + wc * 32 + 8 * fq;
#pragma unroll
        for (int ai = 0; ai < 2; ++ai)
#pragma unroll
            for (int m = 0; m < 4; ++m) { const int row = row0 + ai * HALF + m * 16; const float rs = __builtin_amdgcn_rsqf(ss[row] * (1.0f / D) + RMS_EPS);
                bf16* rowp = P + (size_t)row * NIN1P + col0;
                if (u.pn < 2) {
                    float sq[2];
#pragma unroll
                    for (int bj = 0; bj < 2; ++bj) { const f32x4 v0 = acc[ai][bj][m][0] * rs, v1 = acc[ai][bj][m][1] * rs;
                        u32x4 w; w.x = cvtpk(v0[0], v0[1]); w.y = cvtpk(v0[2], v0[3]); w.z = cvtpk(v1[0], v1[1]); w.w = cvtpk(v1[2], v1[3]);
                        *(u32x4*)(rowp + bj * HALF) = w;
                        sq[bj] = (v0[0] * v0[0] + v0[1] * v0[1]) + (v0[2] * v0[2] + v0[3] * v0[3]) + (v1[0] * v1[0] + v1[1] * v1[1]) + (v1[2] * v1[2] + v1[3] * v1[3]); }
                    float sa = (u.pn == 0) ? sq[0] + sq[1] : sq[0], sb = (u.pn == 0) ? 0.f : sq[1];
                    sa += __shfl_xor(sa, 16); sa += __shfl_xor(sa, 32); sb += __shfl_xor(sb, 16); sb += __shfl_xor(sb, 32);
                    if (fq == 0) { atomicAdd(ssq + row, sa); if (u.pn == 1) atomicAdd(sskv + row, sb); }
                } else {
                    const u32x4 z = {0u, 0u, 0u, 0u};
                    *(u32x4*)(rowp) = z; *(u32x4*)(rowp + HALF) = z;
                    if (wc == 0) {
                        float v[8];
#pragma unroll
                        for (int n = 0; n < 2; ++n)
#pragma unroll
                            for (int e = 0; e < 4; ++e) v[4 * n + e] = acc[ai][0][m][n][e] * rs;
                        rope8(v, cs + (size_t)row * 32, fq);
                        u32x4 w; w.x = cvtpk(v[0], v[1]); w.y = cvtpk(v[2], v[3]); w.z = cvtpk(v[4], v[5]); w.w = cvtpk(v[6], v[7]);
                        bf16* kp = KF + (size_t)row * KPITCH + 64 + 8 * fq;
#pragma unroll
                        for (int h = 0; h < 16; ++h) *(u32x4*)(kp + h * 96) = w;
                    }
                } }
    }
};
struct EpiMlaQ {
    bf16* Q; const float* ssq; const float* cs;
    __device__ __forceinline__ void operator()(const Acc& acc, const Unit& u, int wr, int wc, int fr, int fq) const {
        const int row0 = u.pm * BM + wr * 64 + fr;
#pragma unroll
        for (int ai = 0; ai < 2; ++ai)
#pragma unroll
            for (int m = 0; m < 4; ++m) { const int row = row0 + ai * HALF + m * 16; const float rs = __builtin_amdgcn_rsqf(ssq[row] * (1.0f / QL) + RMS_EPS);
#pragma unroll
                for (int bj = 0; bj < 2; ++bj) { const int g0 = u.pn * BM + bj * HALF + wc * 32;
                    float v[8];
#pragma unroll
                    for (int n = 0; n < 2; ++n)
#pragma unroll
                        for (int e = 0; e < 4; ++e) v[4 * n + e] = acc[ai][bj][m][n][e] * rs;
                    if ((g0 % 96) == 64) rope8(v, cs + (size_t)row * 32, fq);
                    u32x4 w; w.x = cvtpk(v[0] * C2_MLA, v[1] * C2_MLA); w.y = cvtpk(v[2] * C2_MLA, v[3] * C2_MLA); w.z = cvtpk(v[4] * C2_MLA, v[5] * C2_MLA); w.w = cvtpk(v[6] * C2_MLA, v[7] * C2_MLA);
                    *(u32x4*)(Q + (size_t)row * NQ1 + g0 + 8 * fq) = w; } }
    }
};
struct EpiMlaKV {
    bf16* KF; bf16* V; const float* sskv;
    __device__ __forceinline__ void operator()(const Acc& acc, const Unit& u, int wr, int wc, int fr, int fq) const {
        const int row0 = u.pm * BM + wr * 64 + fr;
#pragma unroll
        for (int ai = 0; ai < 2; ++ai)
#pragma unroll
            for (int m = 0; m < 4; ++m) { const int row = row0 + ai * HALF + m * 16; const float rs = __builtin_amdgcn_rsqf(sskv[row] * (1.0f / KVL) + RMS_EPS);
#pragma unroll
                for (int bj = 0; bj < 2; ++bj) { const int col = u.pn * BM + bj * HALF + wc * 32 + 8 * fq;
                    const f32x4 v0 = acc[ai][bj][m][0] * rs, v1 = acc[ai][bj][m][1] * rs;
                    u32x4 w; w.x = cvtpk(v0[0], v0[1]); w.y = cvtpk(v0[2], v0[3]); w.z = cvtpk(v1[0], v1[1]); w.w = cvtpk(v1[2], v1[3]);
                    bf16* dst = (col < 1024) ? KF + (size_t)row * KPITCH + (col >> 6) * 96 + (col & 63) : V + (size_t)row * D + (col - 1024);
                    *(u32x4*)dst = w; } }
    }
};

template <class Epi, bool ALIGN_EPI>
__device__ __forceinline__ void gemm_phase(LAS unsigned char* lds, const Gemm g, const StaticOrder& S, const Epi& E) {
    const int tid = threadIdx.x, wid = __builtin_amdgcn_readfirstlane(tid >> 6), lane = tid & 63, wr = wid >> 2, wc = wid & 3, fr = lane & 15, fq = lane >> 4;
    const int K = g.K, nt = K / BK, lda = g.lda;
    unsigned voffA[2], voffB[2];
#pragma unroll
    for (int i = 0; i < 2; ++i) { int R, C; stage_rc(tid * 16 + i * 8192, R, C); const int Rb = (R & ~31) + perm32(R & 31);
        voffA[i] = (unsigned)(R * lda + C) * 2u; voffB[i] = (unsigned)(Rb * K + C) * 2u; }
    const size_t kstep = (size_t)(BK * 2);
    const size_t hsA = (size_t)HALF * lda * 2, hsB = (size_t)HALF * K * 2, tsA = 2 * hsA, tsB = 2 * hsB;
    const unsigned ldsw = (unsigned)wid * 1024u;
    const int aoff = lds_byte(wr * 64 + fr, fq * 8), boff = lds_byte(wc * 32 + fr, fq * 8);
#define PG8_SA(b, h) (((b) * 2 + (h)) * HTB)
#define PG8_SB(b, h) ((4 + (b) * 2 + (h)) * HTB)
#define PG8_STAGE(bufoff, gbase, voff) do { _Pragma("unroll") for (int _i = 0; _i < 2; ++_i) \
        __builtin_amdgcn_global_load_lds((const unsigned*)((const char*)(gbase) + (voff)[_i]), (LAS unsigned*)(lds + (bufoff) + ldsw + _i * 8192), 16, 0, 0); } while (0)
#define PG8_LDA(dst, b, h) do { _Pragma("unroll") for (int m = 0; m < 4; ++m) _Pragma("unroll") for (int k = 0; k < 2; ++k) dst[m][k] = *(const LAS bf16x8*)(lds + PG8_SA(b, h) + aoff + m * 2048 + k * 1024); } while (0)
#define PG8_LDB(dst, b, h) do { _Pragma("unroll") for (int n = 0; n < 2; ++n) _Pragma("unroll") for (int k = 0; k < 2; ++k) dst[n][k] = *(const LAS bf16x8*)(lds + PG8_SB(b, h) + boff + n * 2048 + k * 1024); } while (0)
#define PG8_MMA(ai, bj, At, Bt) do { __builtin_amdgcn_s_setprio(1); _Pragma("unroll") for (int m = 0; m < 4; ++m) _Pragma("unroll") for (int n = 0; n < 2; ++n) _Pragma("unroll") for (int k = 0; k < 2; ++k) \
        acc[ai][bj][m][n] = __builtin_amdgcn_mfma_f32_16x16x32_bf16(Bt[n][k], At[m][k], acc[ai][bj][m][n], 0, 0, 0); __builtin_amdgcn_s_setprio(0); } while (0)
#define PG8_WAIT_V(n) asm volatile("s_waitcnt vmcnt(" #n ")" ::: "memory")
#define PG8_WAIT_L(n) asm volatile("s_waitcnt lgkmcnt(" #n ")" ::: "memory")
#define PG8_BAR __builtin_amdgcn_s_barrier()
#define PG8_SCHED __builtin_amdgcn_sched_barrier(0)
    Unit cur, nxt; int ui = 0;
    if (!S.next(0, cur)) return;
    Acc acc;
#pragma unroll
    for (int a = 0; a < 2; ++a)
#pragma unroll
        for (int b = 0; b < 2; ++b)
#pragma unroll
            for (int m = 0; m < 4; ++m)
#pragma unroll
                for (int n = 0; n < 2; ++n) acc[a][b][m][n] = (f32x4){0.f, 0.f, 0.f, 0.f};
    bf16x8 At[4][2], B0[2][2], B1[2][2];
    const char* cA = (const char*)g.A + (size_t)cur.pm * tsA; const char* cB = (const char*)g.Bt + (size_t)cur.pn * tsB;
    PG8_STAGE(PG8_SB(0, 0), cB, voffB); PG8_STAGE(PG8_SB(0, 1), cB + hsB, voffB); PG8_STAGE(PG8_SA(0, 0), cA, voffA); PG8_STAGE(PG8_SA(0, 1), cA + hsA, voffA);
    if (wr == 1) PG8_BAR;
    PG8_WAIT_V(2); PG8_BAR;
    PG8_STAGE(PG8_SB(1, 0), cB + kstep, voffB); PG8_STAGE(PG8_SA(1, 0), cA + kstep, voffA); PG8_STAGE(PG8_SB(1, 1), cB + hsB + kstep, voffB);
    PG8_WAIT_V(6); PG8_BAR;
    for (;;) {
        const bool has_next = S.next(ui + 1, nxt);
        const char* nA = has_next ? (const char*)g.A + (size_t)nxt.pm * tsA : cA; const char* nB = has_next ? (const char*)g.Bt + (size_t)nxt.pn * tsB : cB;
#pragma unroll 1
        for (int t = 0; t < nt; t += 2) {
            const bool last = (t == nt - 2);
            const char* a1 = cA + (size_t)(t + 1) * kstep;
            const char* a2 = last ? nA : cA + (size_t)(t + 2) * kstep; const char* b2 = last ? nB : cB + (size_t)(t + 2) * kstep;
            const char* a3 = a2 + kstep; const char* b3 = b2 + kstep;
            PG8_LDB(B0, 0, 0); PG8_LDB(B1, 0, 1); PG8_SCHED; PG8_LDA(At, 0, 0); PG8_STAGE(PG8_SA(1, 1), a1 + hsA, voffA);
            PG8_WAIT_V(8); PG8_WAIT_L(0); PG8_BAR; PG8_MMA(0, 0, At, B0); PG8_MMA(0, 1, At, B1); PG8_BAR; PG8_SCHED;
            PG8_LDA(At, 0, 1); PG8_STAGE(PG8_SB(0, 0), b2, voffB); PG8_STAGE(PG8_SB(0, 1), b2 + hsB, voffB); PG8_STAGE(PG8_SA(0, 0), a2, voffA);
            PG8_WAIT_V(8); PG8_WAIT_L(0); PG8_BAR; PG8_MMA(1, 0, At, B0); PG8_MMA(1, 1, At, B1); PG8_BAR; PG8_SCHED;
            PG8_LDB(B0, 1, 0); PG8_LDB(B1, 1, 1); PG8_SCHED; PG8_LDA(At, 1, 0); PG8_STAGE(PG8_SA(0, 1), a2 + hsA, voffA);
            PG8_WAIT_V(8); PG8_WAIT_L(0); PG8_BAR; PG8_MMA(0, 0, At, B0); PG8_MMA(0, 1, At, B1); PG8_BAR; PG8_SCHED;
            PG8_LDA(At, 1, 1); PG8_STAGE(PG8_SB(1, 0), b3, voffB); PG8_STAGE(PG8_SB(1, 1), b3 + hsB, voffB); PG8_STAGE(PG8_SA(1, 0), a3, voffA);
            PG8_WAIT_V(8); PG8_WAIT_L(0); PG8_BAR; PG8_MMA(1, 0, At, B0); PG8_MMA(1, 1, At, B1); PG8_BAR; PG8_SCHED;
        }
        if constexpr (ALIGN_EPI) { if (wr == 0) PG8_BAR; }
        E(acc, cur, wr, wc, fr, fq);
        if (!has_next) break;
#pragma unroll
        for (int a = 0; a < 2; ++a)
#pragma unroll
            for (int b = 0; b < 2; ++b)
#pragma unroll
                for (int m = 0; m < 4; ++m)
#pragma unroll
                    for (int n = 0; n < 2; ++n) acc[a][b][m][n] = (f32x4){0.f, 0.f, 0.f, 0.f};
        cur = nxt; cA = nA; cB = nB; ++ui;
        if constexpr (ALIGN_EPI) { if (wr == 1) PG8_BAR; }
    }
    PG8_WAIT_V(0);
    if constexpr (!ALIGN_EPI) { if (wr == 0) PG8_BAR; }
    PG8_BAR;
#undef PG8_SA
#undef PG8_SB
#undef PG8_STAGE
#undef PG8_LDA
#undef PG8_LDB
#undef PG8_MMA
#undef PG8_WAIT_V
#undef PG8_WAIT_L
#undef PG8_BAR
#undef PG8_SCHED
}
}

typedef GAS unsigned gu32;
#define RLX_AGENT __ATOMIC_RELAXED, __HIP_MEMORY_SCOPE_AGENT
#define LDS_WAIT() asm volatile("s_waitcnt lgkmcnt(0)" ::: "memory")
#define VM_WAIT() asm volatile("s_waitcnt vmcnt(0)" ::: "memory")
#define XB_TMO      128
#define XB_XCNT(j)  (256  + 64 * (j))
#define XB_XSUB(j)  (1280 + 64 * (j))
#define XB_XGEN(j)  (2304 + 64 * (j))
#define XB_TOP      3328
#define XB_TOPGEN   3392
#define XCD_BAR_WORDS 3456
#define XB_SPIN_CAP (1u << 18)
__device__ __forceinline__ unsigned xb_ld(unsigned* p)              { return __hip_atomic_load(p, __ATOMIC_RELAXED, __HIP_MEMORY_SCOPE_AGENT); }
__device__ __forceinline__ unsigned xb_add(unsigned* p, unsigned v) { return __hip_atomic_fetch_add(p, v, __ATOMIC_RELAXED, __HIP_MEMORY_SCOPE_AGENT); }
__device__ __forceinline__ unsigned xb_xcc_id() { return (unsigned)__builtin_amdgcn_s_getreg((3 << 11) | 20) & 0xFu; }
#define XB_SPIN(cond, bar) do { unsigned _sp = 0; while (cond) { __builtin_amdgcn_s_sleep(1); \
    if ((++_sp & 255u) == 0u) { if (xb_ld(&(bar)[XB_TMO])) break; if (_sp > XB_SPIN_CAP) { atomicAdd(&(bar)[XB_TMO], 1u); break; } } } } while (0)
struct XcdBarrier { unsigned* bar; unsigned x; volatile LAS unsigned* st; };
__device__ __forceinline__ XcdBarrier xcd_barrier_post(unsigned* bar, volatile LAS unsigned* st) {
    XcdBarrier b; b.bar = bar; b.x = xb_xcc_id(); b.st = st;
    if (threadIdx.x == 0) (void)xb_add(&bar[XB_XCNT(b.x)], 1u);
    return b;
}
__device__ __forceinline__ void xcd_barrier_complete(unsigned* bar, unsigned x, unsigned& nloc, unsigned& nx) {
    const unsigned G = gridDim.x * gridDim.y * gridDim.z;
    unsigned sum, cnt, mine, sp = 0u;
    for (;;) {
        sum = 0u; cnt = 0u; mine = 0u;
#pragma unroll
        for (unsigned j = 0; j < 16; ++j) { const unsigned c = xb_ld(&bar[XB_XCNT(j)]); sum += c; cnt += (c > 0u) ? 1u : 0u; mine = (j == x) ? c : mine; }
        if (sum == G) break;
        __builtin_amdgcn_s_sleep(1);
        if ((++sp & 255u) == 0u) { if (xb_ld(&bar[XB_TMO])) break; if (sp > XB_SPIN_CAP) { atomicAdd(&bar[XB_TMO], 1u); break; } }
    }
    nloc = mine > 0u ? mine : 1u; nx = cnt > 0u ? cnt : 1u;
}
__device__ __forceinline__ void xcd_barrier(const XcdBarrier& b) {
    asm volatile("s_waitcnt vmcnt(0)" ::: "memory");
    __syncthreads();
    if (threadIdx.x == 0) {
        unsigned* bar = b.bar;
        __builtin_amdgcn_s_waitcnt(0);
        unsigned nloc = b.st[0], nx = b.st[1];
        if (nloc == 0u) { xcd_barrier_complete(bar, b.x, nloc, nx); b.st[0] = nloc; b.st[1] = nx; }
        const unsigned old = xb_add(&bar[XB_XSUB(b.x)], 1u);
        const unsigned gen = old / nloc;
        if (old + 1u == (gen + 1u) * nloc) {
            __builtin_amdgcn_fence(__ATOMIC_RELEASE, "agent");
            asm volatile("s_waitcnt vmcnt(0)" ::: "memory");
            const unsigned og = xb_add(&bar[XB_TOP], 1u);
            const unsigned tg = og / nx;
            if (og + 1u == (tg + 1u) * nx) xb_add(&bar[XB_TOPGEN], 1u);
            else XB_SPIN(xb_ld(&bar[XB_TOPGEN]) == tg, bar);
            __builtin_amdgcn_fence(__ATOMIC_ACQUIRE, "agent");
            xb_add(&bar[XB_XGEN(b.x)], 1u);
            asm volatile("s_waitcnt vmcnt(0)" ::: "memory");
        } else {
            XB_SPIN(xb_ld(&bar[XB_XGEN(b.x)]) == gen, bar);
            __builtin_amdgcn_fence(__ATOMIC_ACQUIRE, "agent");
            asm volatile("s_waitcnt vmcnt(0)" ::: "memory");
        }
    }
    __syncthreads();
}

__device__ __forceinline__ int t5_bucket(int rel) {
    const int n = rel < 0 ? -rel : rel;
    const float nf = (float)(n > 8 ? n : 8);
    int large = 8 + (int)(__logf(nf / 8.0f) / 4.852030263919617f * 8.0f);
    large = large < 15 ? large : 15;
    return (rel > 0 ? 16 : 0) + (n < 8 ? n : large);
}
__device__ __forceinline__ int t5_bucket_precise(int rel) {
    const int n = rel < 0 ? -rel : rel;
    const float nf = (float)(n > 8 ? n : 8);
    int large = 8 + (int)(logf(nf / 8.0f) / 4.852030263919617f * 8.0f);
    large = large < 15 ? large : 15;
    return (rel > 0 ? 16 : 0) + (n < 8 ? n : large);
}

struct Args {
    const float* in[18];
    float* out; unsigned char* ws;
    int ph_lo, ph_hi;
};
enum { I_X = 0, I_T5, I_ANORM, I_FNORM, I_EWIN, I_RPB, I_EWOUT, I_OWIN, I_QNORM, I_WUQ, I_KVNORM, I_WUK, I_WUV, I_OWOUT, I_WG, I_WU, I_WD, I_FINAL };
constexpr int NPH = 13;

__device__ __forceinline__ void p0_transpose_item(const float* W, int N, const float* gain, bf16* WT, int ldk, int dst_row0, int k0, int n0, LAS float* scr, int lane) {
#pragma unroll 8
    for (int i = 0; i < 32; ++i) { const int kk = 2 * i + (lane >> 5); const float gk = gain ? gain[k0 + kk] : 1.0f; scr[kk * 33 + (lane & 31)] = W[(size_t)(k0 + kk) * N + n0 + (lane & 31)] * gk; }
    LDS_WAIT(); asm volatile("" ::: "memory");
    const int c = lane & 7;
#pragma unroll
    for (int j = 0; j < 4; ++j) { const int n = (lane >> 3) + 8 * j; const LAS float* s = scr + (8 * c) * 33 + n;
        u32x4 o; o.x = cvtpk(s[0 * 33], s[1 * 33]); o.y = cvtpk(s[2 * 33], s[3 * 33]); o.z = cvtpk(s[4 * 33], s[5 * 33]); o.w = cvtpk(s[6 * 33], s[7 * 33]);
        *(u32x4*)(WT + (size_t)(dst_row0 + n) * ldk + k0 + 8 * c) = o; }
    LDS_WAIT(); asm volatile("" ::: "memory");
}
template <int MODE>
__device__ __forceinline__ bool p0_matrix(int& r, const float* W, int K, int N, const float* gain, bf16* WT, int ldk, int row_off, LAS float* scr, int lane) {
    const int nblk = N / 32, items = (K / 64) * nblk;
    if (r >= items) { r -= items; return false; }
    const int kb = r / nblk, nb = r % nblk, n0 = 32 * nb;
    int dr = row_off + n0;
    if (MODE != 0) dr = (n0 >> 7) * 256 + (n0 & 127) + (MODE == 2 ? 128 : 0);
    p0_transpose_item(W, N, gain, WT, ldk, dr, 64 * kb, n0, scr, lane);
    return true;
}

namespace wattn {
__device__ __forceinline__ int crow(int r, int hi) { return (r & 3) + 8 * (r >> 2) + 4 * hi; }
typedef short v4i16_t __attribute__((ext_vector_type(4)));
__device__ __forceinline__ s16x4 vtr(const LAS unsigned char* p) { return __builtin_bit_cast(s16x4, __builtin_amdgcn_ds_read_tr16_b64_v4i16((LAS v4i16_t*)p)); }
constexpr int WREG = 10240;

template <int DQ, class F>
__device__ __forceinline__ void run_unit(const F& f, const bf16* __restrict__ Qrow  , const bf16* __restrict__ Kb, int kpitch,
                                         const bf16* __restrict__ Vb, int vpitch, float c2, bf16* __restrict__ Orow  ,
                                         LAS unsigned char* wl, int lane) {
    constexpr int ND = DQ / 16;
    const int r32 = lane & 31, hi = lane >> 5;
    bf16x8 qf[ND];
#pragma unroll
    for (int d0 = 0; d0 < ND; ++d0) qf[d0] = *(const bf16x8*)(Qrow + 16 * d0 + 8 * hi);
    float m = NEGB, l = 0.f; f32x16 ot[2];
#pragma unroll
    for (int r = 0; r < 16; ++r) { ot[0][r] = 0.f; ot[1][r] = 0.f; }
    u32x4 kr[ND], vr[4];
    const int nt = f.ntiles();
    auto load_tile = [&](int t) {
        const bf16* kp = Kb + (size_t)f.tok(t, r32) * kpitch + (lane >> 5) * 8;
#pragma unroll
        for (int i = 0; i < ND; ++i) kr[i] = *(const u32x4*)(kp + 16 * i);
        const bf16* v0 = Vb + (size_t)f.tok(t, lane >> 2) * vpitch + (lane & 3) * 8;
        const bf16* v1 = Vb + (size_t)f.tok(t, (lane >> 2) + 16) * vpitch + (lane & 3) * 8;
        vr[0] = *(const u32x4*)(v0); vr[1] = *(const u32x4*)(v1); vr[2] = *(const u32x4*)(v0 + 32); vr[3] = *(const u32x4*)(v1 + 32);
    };
    const LAS unsigned char* vbase = wl + 6144 + (4 * hi + ((lane & 15) >> 2)) * 64 + ((lane >> 4) & 1) * 32 + (lane & 3) * 8;
    load_tile(0);
    for (int t = 0; t < nt; ++t) {
#pragma unroll
        for (int i = 0; i < ND; ++i) *(LAS u32x4*)(wl + i * 1024 + lane * 16) = kr[i];
#pragma unroll
        for (int i = 0; i < 4; ++i) *(LAS u32x4*)(wl + 6144 + (i >> 1) * 2048 + (i & 1) * 1024 + lane * 16) = vr[i];
        if (t + 1 < nt) load_tile(t + 1);
        f32x16 s;
#pragma unroll
        for (int r = 0; r < 16; ++r) s[r] = 0.f;
#pragma unroll
        for (int d0 = 0; d0 < ND; ++d0) { const bf16x8 kf = *(const LAS bf16x8*)(wl + d0 * 1024 + lane * 16); s = __builtin_amdgcn_mfma_f32_32x32x16_bf16(kf, qf[d0], s, 0, 0, 0); }
        float mx = NEGB;
#pragma unroll
        for (int r = 0; r < 16; ++r) { s[r] = s[r] * c2 + f.bias(t, r, hi, r32); mx = fmaxf(mx, s[r]); }
        mx = fmaxf(mx, __shfl_xor(mx, 32));
        const float mnew = fmaxf(m, mx), alpha = __builtin_amdgcn_exp2f(m - mnew);
        m = mnew;
        float ps = 0.f;
#pragma unroll
        for (int r = 0; r < 16; ++r) { s[r] = __builtin_amdgcn_exp2f(s[r] - mnew); ps += s[r]; }
        l = l * alpha + ps;
#pragma unroll
        for (int r = 0; r < 16; ++r) { ot[0][r] *= alpha; ot[1][r] *= alpha; }
        u32x4 pw[2];
#pragma unroll
        for (int ks = 0; ks < 2; ++ks) { pw[ks].x = cvtpk(s[8 * ks + 0], s[8 * ks + 1]); pw[ks].y = cvtpk(s[8 * ks + 2], s[8 * ks + 3]); pw[ks].z = cvtpk(s[8 * ks + 4], s[8 * ks + 5]); pw[ks].w = cvtpk(s[8 * ks + 6], s[8 * ks + 7]); }
#pragma unroll
        for (int db = 0; db < 2; ++db)
#pragma unroll
            for (int ks = 0; ks < 2; ++ks) {
                const s16x4 lo = vtr(vbase + db * 2048 + ks * 1024), hh = vtr(vbase + db * 2048 + ks * 1024 + 512);
                const bf16x8 vf = (bf16x8){lo[0], lo[1], lo[2], lo[3], hh[0], hh[1], hh[2], hh[3]};
                ot[db] = __builtin_amdgcn_mfma_f32_32x32x16_bf16(vf, __builtin_bit_cast(bf16x8, pw[ks]), ot[db], 0, 0, 0);
            }
    }
    l += __shfl_xor(l, 32);
    const float inv = 1.0f / l;
#pragma unroll
    for (int db = 0; db < 2; ++db)
#pragma unroll
        for (int g = 0; g < 4; ++g) { u32x2 w; w.x = cvtpk(ot[db][4 * g] * inv, ot[db][4 * g + 1] * inv); w.y = cvtpk(ot[db][4 * g + 2] * inv, ot[db][4 * g + 3] * inv);
            *(u32x2*)(Orow + 32 * db + 8 * g + 4 * hi) = w; }
}

struct DilF {
    int t0, w; bool edge; const LAS float* tbl;
    __device__ __forceinline__ int ntiles() const { return 23; }
    __device__ __forceinline__ int tok_raw(int t, int j) const {
        if (t < 8) return t0 - 64 + 32 * t + j;
        const int ii = (t - 8) * 32 + j, e = ii < 240 ? ii - 256 : ii - 192;
        return t0 + w + 4 * e;
    }
    __device__ __forceinline__ int tok(int t, int j) const { int u = tok_raw(t, j); u = u < 0 ? 0 : u; return u > S - 1 ? S - 1 : u; }
    __device__ __forceinline__ float bias(int t, int r, int hi, int r32) const {
        const int u = tok_raw(t, crow(r, hi)), d = u - (t0 + w + 4 * r32);
        float b = tbl[d + 1152];
        if (edge && (u < 0 || u >= S)) b = NEGB;
        return b;
    }
};
struct NaF {
    int r0, gr, jw; const LAS float* rpb;
    __device__ __forceinline__ int ntiles() const { return 16; }
    __device__ __forceinline__ int tok(int t, int j) const { return (r0 + (t >> 1)) * 64 + 32 * (t & 1) + j; }
    __device__ __forceinline__ float bias(int t, int r, int hi, int r32) const {
        const int kc = 32 * (t & 1) + crow(r, hi), c = 32 * jw + r32;
        int c0 = c - 8; c0 = c0 < 0 ? 0 : (c0 > 48 ? 48 : c0);
        const bool ok = (unsigned)(kc - c0) < 16u;
        const int idx = (r0 + (t >> 1) - gr + 7) * 31 + (kc - c + 15);
        return ok ? rpb[idx] : NEGB;
    }
};
struct MlaF {
    int tq0; const LAS float* tbl;
    __device__ __forceinline__ int ntiles() const { return S / 32; }
    __device__ __forceinline__ int tok(int t, int j) const { return 32 * t + j; }
    __device__ __forceinline__ float bias(int t, int r, int hi, int r32) const {
        int d = 32 * t + crow(r, hi) - (tq0 + r32); d = d < -600 ? -600 : (d > 600 ? 600 : d);
        return tbl[d + 600];
    }
};
}


namespace mla {
using wattn::crow; using wattn::vtr;
constexpr int KSLOT = 12288, VSLOT = 8192, L_K = 0, L_V = 2 * KSLOT, L_TBL = L_V + 2 * VSLOT, L_OST = L_TBL + 5120, L_END = L_OST + 8 * 4096;
constexpr int NT = S / 64;
constexpr float THR = 8.0f;
#define MLA_WAITBAR() do { asm volatile("s_waitcnt vmcnt(0) lgkmcnt(0)" ::: "memory"); __builtin_amdgcn_s_barrier(); asm volatile("" ::: "memory"); } while (0)
__device__ __forceinline__ float max3f(float a, float b, float c) { return fmaxf(fmaxf(a, b), c); }

__device__ __forceinline__ void unit(int h, int q0, const bf16* __restrict__ Q1, const bf16* __restrict__ K1, const bf16* __restrict__ V1, bf16* __restrict__ O,
                                     LAS unsigned char* lds, const float clo, const float chi, int wave, int lane) {
    const int r32 = lane & 31, hi = lane >> 5;
    const LAS float* tbl = (const LAS float*)(lds + L_TBL);
    const int qrow = q0 + 32 * wave + r32;
    const bf16* ksrc0 = K1 + (size_t)lane * KPITCH + h * 96 + wave * 8;
    const bf16* ksrc1 = K1 + (size_t)lane * KPITCH + h * 96 + (8 + (wave & 3)) * 8;
    const bf16* vsrc = V1 + (size_t)(16 * (wave & 3) + (lane >> 2)) * D + h * 64 + (wave >> 2) * 32 + (lane & 3) * 8;
#define MLA_DMA_K(t, slot) do { __builtin_amdgcn_global_load_lds((const unsigned*)(ksrc0 + (size_t)(t) * 64 * KPITCH), (LAS unsigned*)(lds + L_K + (slot) * KSLOT + wave * 1024), 16, 0, 0); \
        if (wave < 4) __builtin_amdgcn_global_load_lds((const unsigned*)(ksrc1 + (size_t)(t) * 64 * KPITCH), (LAS unsigned*)(lds + L_K + (slot) * KSLOT + (8 + wave) * 1024), 16, 0, 0); } while (0)
#define MLA_DMA_V(t, slot) __builtin_amdgcn_global_load_lds((const unsigned*)(vsrc + (size_t)(t) * 64 * D), (LAS unsigned*)(lds + L_V + (slot) * VSLOT + wave * 1024), 16, 0, 0)
    MLA_DMA_K(0, 0); MLA_DMA_V(0, 0); MLA_DMA_K(1, 1);
    bf16x8 qf[6];
    { const bf16* qp = Q1 + (size_t)qrow * NQ1 + h * 96 + 8 * hi;
#pragma unroll
      for (int d0 = 0; d0 < 6; ++d0) qf[d0] = *(const bf16x8*)(qp + 16 * d0); }
    float m = NEGB, l = 0.f; f32x16 ot[2];
#pragma unroll
    for (int r = 0; r < 16; ++r) { ot[0][r] = 0.f; ot[1][r] = 0.f; }
    const LAS unsigned char* kfb = lds + L_K + hi * 1024 + r32 * 16;
    const LAS unsigned char* vfb = lds + L_V + (4 * hi + ((lane & 15) >> 2)) * 64 + ((lane >> 4) & 1) * 32 + (lane & 3) * 8;
    auto qk = [&](f32x16& c0, f32x16& c1, int slot) {
        const LAS unsigned char* kb = kfb + slot * KSLOT;
#pragma unroll
        for (int r = 0; r < 16; ++r) { c0[r] = 0.f; c1[r] = 0.f; }
#pragma unroll
        for (int d0 = 0; d0 < 6; ++d0) { const bf16x8 a0 = *(const LAS bf16x8*)(kb + d0 * 2048), a1 = *(const LAS bf16x8*)(kb + d0 * 2048 + 512);
            c0 = __builtin_amdgcn_mfma_f32_32x32x16_bf16(a0, qf[d0], c0, 0, 0, 0); c1 = __builtin_amdgcn_mfma_f32_32x32x16_bf16(a1, qf[d0], c1, 0, 0, 0); }
    };
    const int tl_end = (q0 - 622 >= 0) ? (q0 - 622) / 64 + 1 : 0;
    const int tr_beg = (q0 + 814 + 63) / 64;
    f32x16 sc0, sc1, sn0, sn1;
    MLA_WAITBAR();
    qk(sc0, sc1, 0);
    MLA_WAITBAR();
    for (int t = 0; t < NT; ++t) {
        if (t + 2 < NT) MLA_DMA_K(t + 2, t & 1);
        if (t + 1 < NT) MLA_DMA_V(t + 1, (t + 1) & 1);
        if (t + 1 < NT) qk(sn0, sn1, (t + 1) & 1);
        float cb;
        if (t < tl_end) cb = clo; else if (t >= tr_beg) cb = chi;
        else { cb = 0.f; const int dbase = 64 * t + 4 * hi - qrow + 600;
#pragma unroll
            for (int r = 0; r < 16; ++r) { int d0i = dbase + (r & 3) + 8 * (r >> 2), d1i = d0i + 32;
                d0i = d0i < 0 ? 0 : (d0i > 1200 ? 1200 : d0i); d1i = d1i < 0 ? 0 : (d1i > 1200 ? 1200 : d1i);
                sc0[r] += tbl[d0i]; sc1[r] += tbl[d1i]; } }
        float a = max3f(sc0[0], sc0[1], sc1[0]), b = max3f(sc0[2], sc0[3], sc1[1]); a = max3f(a, sc1[2], sc1[3]);
#pragma unroll
        for (int r = 4; r < 16; r += 4) { a = max3f(a, sc0[r], sc0[r + 1]); b = max3f(b, sc0[r + 2], sc0[r + 3]); a = max3f(a, sc1[r], sc1[r + 1]); b = max3f(b, sc1[r + 2], sc1[r + 3]); }
        float mx = fmaxf(a, b); mx = fmaxf(mx, __shfl_xor(mx, 32)) + cb;
        if (__any(mx > m + THR)) { const float mnew = fmaxf(m, mx), alpha = __builtin_amdgcn_exp2f(m - mnew); m = mnew; l *= alpha;
#pragma unroll
            for (int r = 0; r < 16; ++r) { ot[0][r] *= alpha; ot[1][r] *= alpha; } }
        const float sh = m - cb; float ps = 0.f;
#pragma unroll
        for (int r = 0; r < 16; ++r) { sc0[r] = __builtin_amdgcn_exp2f(sc0[r] - sh); sc1[r] = __builtin_amdgcn_exp2f(sc1[r] - sh); ps += sc0[r] + sc1[r]; }
        l += ps;
        u32x4 pw[4];
#pragma unroll
        for (int ks = 0; ks < 2; ++ks) { pw[ks].x = cvtpk(sc0[8 * ks + 0], sc0[8 * ks + 1]); pw[ks].y = cvtpk(sc0[8 * ks + 2], sc0[8 * ks + 3]); pw[ks].z = cvtpk(sc0[8 * ks + 4], sc0[8 * ks + 5]); pw[ks].w = cvtpk(sc0[8 * ks + 6], sc0[8 * ks + 7]);
            pw[2 + ks].x = cvtpk(sc1[8 * ks + 0], sc1[8 * ks + 1]); pw[2 + ks].y = cvtpk(sc1[8 * ks + 2], sc1[8 * ks + 3]); pw[2 + ks].z = cvtpk(sc1[8 * ks + 4], sc1[8 * ks + 5]); pw[2 + ks].w = cvtpk(sc1[8 * ks + 6], sc1[8 * ks + 7]); }
        const LAS unsigned char* vb = vfb + (t & 1) * VSLOT;
#pragma unroll
        for (int ks = 0; ks < 4; ++ks)
#pragma unroll
            for (int db = 0; db < 2; ++db) { const s16x4 lo = vtr(vb + db * 4096 + ks * 1024), hh = vtr(vb + db * 4096 + ks * 1024 + 512);
                const bf16x8 vf = (bf16x8){lo[0], lo[1], lo[2], lo[3], hh[0], hh[1], hh[2], hh[3]};
                ot[db] = __builtin_amdgcn_mfma_f32_32x32x16_bf16(vf, __builtin_bit_cast(bf16x8, pw[ks]), ot[db], 0, 0, 0); }
        sc0 = sn0; sc1 = sn1;
        MLA_WAITBAR();
    }
    l += __shfl_xor(l, 32);
    const float inv = 1.0f / l;
    LAS bf16* stg = (LAS bf16*)(lds + L_OST) + wave * 2048;
#pragma unroll
    for (int db = 0; db < 2; ++db)
#pragma unroll
        for (int g = 0; g < 4; ++g) { u32x2 w; w.x = cvtpk(ot[db][4 * g] * inv, ot[db][4 * g + 1] * inv); w.y = cvtpk(ot[db][4 * g + 2] * inv, ot[db][4 * g + 3] * inv);
            *(LAS u32x2*)(stg + r32 * 64 + 32 * db + 8 * g + 4 * hi) = w; }
    asm volatile("s_waitcnt lgkmcnt(0)" ::: "memory");
    bf16* Ow = O + (size_t)(q0 + 32 * wave) * D + h * 64;
#pragma unroll
    for (int i = 0; i < 4; ++i) { const int row = i * 8 + (lane >> 3), ch = lane & 7; const u32x4 v = *(const LAS u32x4*)(stg + row * 64 + ch * 8); *(u32x4*)(Ow + (size_t)row * D + ch * 8) = v; }
    MLA_WAITBAR();
#undef MLA_DMA_K
#undef MLA_DMA_V
}
}

constexpr int NWAVES = 8;
__global__ void __launch_bounds__(NWAVES * 64, 2) fwd_kernel(Args args) {
    extern __shared__ __attribute__((aligned(16))) unsigned char lds_raw[];
    LAS unsigned char* lds = (LAS unsigned char*)lds_raw;
    volatile LAS unsigned* MISC = (volatile LAS unsigned*)(lds + MISC_OFF);
    const int tid = threadIdx.x, lane = tid & 63, wave = __builtin_amdgcn_readfirstlane(tid >> 6);
    const int G = gridDim.x; const int bx = blockIdx.x;
    const int vcu = (G % 8 == 0) ? (bx % 8) * (G / 8) + bx / 8 : bx;
    unsigned char* ws = args.ws;
    float* const out = args.out;
    const int lo = args.ph_lo, hi_ph = args.ph_hi;
    for (int u = tid; u < (LDS_BYTES - LDSCTL_OFF) / 4; u += NWAVES * 64) ((LAS unsigned*)(lds + LDSCTL_OFF))[u] = 0u;
    __syncthreads();
    const bool multi = (hi_ph - lo) > 1;
    XcdBarrier bar; bar.bar = (unsigned*)(ws + CTL_BAR); bar.x = 0; bar.st = nullptr;
    if (multi) bar = xcd_barrier_post((unsigned*)(ws + CTL_BAR), MISC + 8);
#ifndef PHASE_MASK
#define PHASE_MASK 0x1fff
#endif
#define IN(k) ((((PHASE_MASK) >> (k)) & 1) && lo <= (k) && (k) < hi_ph)
#define SEAM(k) do { if (IN(k) && IN((k) + 1)) xcd_barrier(bar); } while (0)

    float* const SS = (float*)(ws + CTL_SS);
    float* const SS0 = SS, * const SS1 = SS + S, * const SS2 = SS + 2 * S, * const SS3 = SS + 3 * S, * const SS4 = SS + 4 * S, * const SSQ = SS + 5 * S, * const SSKV = SS + 6 * S;
    bf16* const XB = (bf16*)(ws + WS_XB); bf16* const OB = (bf16*)(ws + WS_O); bf16* const BIG = (bf16*)(ws + WS_BIG);
    bf16* const Q1 = (bf16*)(ws + WS_Q1); bf16* const K1 = (bf16*)(ws + WS_K1); bf16* const V1 = (bf16*)(ws + WS_V1);
    const float* const ROPE = (const float*)(ws + WS_ROPE);
    const int gw = vcu * NWAVES + wave, NGW = G * NWAVES;

    if (IN(0)) {
        LAS float* scr = (LAS float*)(lds + wave * 16384);
        const float* an0 = args.in[I_ANORM], * an1 = args.in[I_ANORM] + D, * fn0 = args.in[I_FNORM], * fn1 = args.in[I_FNORM] + D;
        constexpr int NITEMS = 1536 + 512 + 1408 * 3 + 272 + 288 + 64 + 64 + 512 + 1408 * 3;
        for (int it = gw; it < NITEMS; it += NGW) {
            int r = it;
            if (p0_matrix<0>(r, args.in[I_EWIN], D, NQKV, an0, (bf16*)(ws + W_IN0), D, 0, scr, lane)) continue;
            if (p0_matrix<0>(r, args.in[I_EWOUT], D, D, nullptr, (bf16*)(ws + W_OUT0), D, 0, scr, lane)) continue;
            if (p0_matrix<1>(r, args.in[I_WG], D, FF, fn0, (bf16*)(ws + W_GU0), D, 0, scr, lane)) continue;
            if (p0_matrix<2>(r, args.in[I_WU], D, FF, fn0, (bf16*)(ws + W_GU0), D, 0, scr, lane)) continue;
            if (p0_matrix<0>(r, args.in[I_WD], FF, D, nullptr, (bf16*)(ws + W_D0), FF, 0, scr, lane)) continue;
            if (p0_matrix<0>(r, args.in[I_OWIN], D, NIN1, an1, (bf16*)(ws + W_IN1), D, 0, scr, lane)) continue;
            if (p0_matrix<0>(r, args.in[I_WUQ], QL, NQ1, args.in[I_QNORM], (bf16*)(ws + W_UQ), QL, 0, scr, lane)) continue;
            if (p0_matrix<0>(r, args.in[I_WUK], KVL, D, args.in[I_KVNORM], (bf16*)(ws + W_UKV), KVLP, 0, scr, lane)) continue;
            if (p0_matrix<0>(r, args.in[I_WUV], KVL, D, args.in[I_KVNORM], (bf16*)(ws + W_UKV), KVLP, 1024, scr, lane)) continue;
            if (p0_matrix<0>(r, args.in[I_OWOUT], D, D, nullptr, (bf16*)(ws + W_OUT1), D, 0, scr, lane)) continue;
            if (p0_matrix<1>(r, args.in[I_WG] + (size_t)D * FF, D, FF, fn1, (bf16*)(ws + W_GU1), D, 0, scr, lane)) continue;
            if (p0_matrix<2>(r, args.in[I_WU] + (size_t)D * FF, D, FF, fn1, (bf16*)(ws + W_GU1), D, 0, scr, lane)) continue;
            p0_matrix<0>(r, args.in[I_WD] + (size_t)FF * D, FF, D, nullptr, (bf16*)(ws + W_D1), FF, 0, scr, lane);
        }
        const int gt = vcu * (NWAVES * 64) + tid, NGT = G * NWAVES * 64;
        for (int i = gt; i < (NIN1P - NIN1) * D / 8; i += NGT) ((u32x4*)(ws + W_IN1 + (size_t)NIN1 * D * 2))[i] = (u32x4){0u, 0u, 0u, 0u};
        for (int i = gt; i < NKV1 * 16; i += NGT) { const int row = i >> 4, c = i & 15; *(u32x4*)(ws + W_UKV + ((size_t)row * KVLP + KVL + c * 8) * 2) = (u32x4){0u, 0u, 0u, 0u}; }
        for (int mrow = gw; mrow < S; mrow += NGW) {
            const f32x4* xr = (const f32x4*)(args.in[I_X] + (size_t)mrow * D) + lane; float s2 = 0.f;
            unsigned long long* o8 = (unsigned long long*)(XB + (size_t)mrow * D) + lane;
#pragma unroll
            for (int j = 0; j < 4; ++j) { const f32x4 v = xr[64 * j]; s2 += (v.x * v.x + v.y * v.y) + (v.z * v.z + v.w * v.w);
                o8[64 * j] = (unsigned long long)cvtpk(v.x, v.y) | ((unsigned long long)cvtpk(v.z, v.w) << 32); }
            s2 = wave_sum(s2);
            if (lane == 0) SS0[mrow] = s2;
        }
        float* rope = (float*)(ws + WS_ROPE);
        for (int i = gt; i < S * 16; i += NGT) { const int pos = i >> 4, fi = i & 15; const float fr = powf(10000.0f, -(float)fi / 16.0f), ang = (float)pos * fr;
            rope[2 * i] = cosf(ang); rope[2 * i + 1] = sinf(ang); }
        const float* t5 = args.in[I_T5];
        float* tdil = (float*)(ws + WS_TDIL);
        for (int i = gt; i < 8 * 2368; i += NGT) { const int h = i / 2368, d = i % 2368 - 1152, n = d < 0 ? -d : d; int mult = 0;
            if (n <= 64) ++mult; if ((d & 3) == 0 && n <= 256) ++mult; if ((d & 15) == 0 && n <= 1024) ++mult;
            tdil[i] = mult ? (t5[t5_bucket_precise(d) * 16 + h] + logf((float)mult)) * LOG2E : NEGB; }
        float* tmla = (float*)(ws + WS_TMLA);
        for (int i = gt; i < 16 * 1216; i += NGT) { const int h = i / 1216; int d = i % 1216 - 600; d = d > 600 ? 600 : d; tmla[i] = t5[t5_bucket_precise(d) * 16 + h] * LOG2E; }
        float* trpb = (float*)(ws + WS_TRPB);
        for (int i = gt; i < 8 * 465; i += NGT) trpb[i] = args.in[I_RPB][i] * LOG2E;
    }
    SEAM(0);

    if (IN(1)) {
        pg8::Gemm g{XB, (const bf16*)(ws + W_IN0), S, NQKV, D, D}; pg8::StaticOrder So; So.init(S, NQKV, G, bx);
        pg8::EpiRowScale E{BIG, NQKV, SS0, 1.0f / D};
        pg8::gemm_phase<pg8::EpiRowScale, true>(lds, g, So, E);
    }
    SEAM(1);

    if (IN(2)) {
        const int hd = vcu >> 5;
        LAS float* tdl = (LAS float*)(lds + 81920); LAS float* trp = (LAS float*)(lds + 81920 + 9472);
        for (int i = tid; i < 2368; i += NWAVES * 64) tdl[i] = ((const float*)(ws + WS_TDIL))[hd * 2368 + i];
        for (int i = tid; i < 465; i += NWAVES * 64) trp[i] = ((const float*)(ws + WS_TRPB))[hd * 465 + i];
        __syncthreads();
        LAS unsigned char* wl = lds + wave * wattn::WREG;
        const int r32 = lane & 31;
        for (int rd = 0; rd < 2; ++rd) {
            const int ud = vcu * 4 + 2 * rd + (wave >> 2), blk = ud & 127, t0 = blk * 128, w = wave & 3;
            wattn::DilF f{t0, w, (t0 < 1152) || (t0 + 128 + 1152 > S), tdl};
            const int tq = t0 + w + 4 * r32;
            wattn::run_unit<64>(f, BIG + (size_t)tq * NQKV + hd * 64, BIG + 512 + hd * 64, NQKV, BIG + 1024 + hd * 64, NQKV, C2_LOCAL, OB + (size_t)tq * D + hd * 64, wl, lane);
        }
        for (int rn = 0; rn < 2; ++rn) {
            const int un = vcu * 8 + 4 * rn + (wave >> 1), gr = un & 255, jw = wave & 1;
            int r0 = gr - 4; r0 = r0 < 0 ? 0 : (r0 > 248 ? 248 : r0);
            wattn::NaF f{r0, gr, jw, trp};
            const int tq = gr * 64 + 32 * jw + r32;
            wattn::run_unit<64>(f, BIG + (size_t)tq * NQKV + 1536 + hd * 64, BIG + 2048 + hd * 64, NQKV, BIG + 2560 + hd * 64, NQKV, C2_LOCAL, OB + (size_t)tq * D + 512 + hd * 64, wl, lane);
        }
        __syncthreads();
    }
    SEAM(2);

    if (IN(3)) {
        pg8::Gemm g{OB, (const bf16*)(ws + W_OUT0), S, D, D, D}; pg8::StaticOrder So; So.init(S, D, G, bx);
        pg8::EpiResid E{args.in[I_X], out, XB, SS1};
        pg8::gemm_phase<pg8::EpiResid, true>(lds, g, So, E);
    }
    SEAM(3);
    if (IN(4)) {
        pg8::Gemm g{XB, (const bf16*)(ws + W_GU0), S, 2 * FF, D, D}; pg8::StaticOrder So; So.init(S, 2 * FF, G, bx);
        pg8::EpiSwiGLU E{BIG, SS1};
        pg8::gemm_phase<pg8::EpiSwiGLU, true>(lds, g, So, E);
    }
    SEAM(4);
    if (IN(5)) {
        pg8::Gemm g{BIG, (const bf16*)(ws + W_D0), S, D, FF, FF}; pg8::StaticOrder So; So.init(S, D, G, bx);
        pg8::EpiResid E{out, out, XB, SS2};
        pg8::gemm_phase<pg8::EpiResid, true>(lds, g, So, E);
    }
    SEAM(5);
    if (IN(6)) {
        pg8::Gemm g{XB, (const bf16*)(ws + W_IN1), S, NIN1P, D, D}; pg8::StaticOrder So; So.init(S, NIN1P, G, bx);
        pg8::EpiMlaIn E{OB, SS2, SSQ, SSKV, K1, ROPE};
        pg8::gemm_phase<pg8::EpiMlaIn, true>(lds, g, So, E);
    }
    SEAM(6);
    if (IN(7)) {
        { pg8::Gemm g{OB, (const bf16*)(ws + W_UQ), S, NQ1, QL, NIN1P}; pg8::StaticOrder So; So.init(S, NQ1, G, bx);
          pg8::EpiMlaQ E{Q1, SSQ, ROPE};
          pg8::gemm_phase<pg8::EpiMlaQ, true>(lds, g, So, E); }
        { pg8::Gemm g{OB + QL, (const bf16*)(ws + W_UKV), S, NKV1, KVLP, NIN1P}; pg8::StaticOrder So; So.init(S, NKV1, G, bx);
          pg8::EpiMlaKV E{K1, V1, SSKV};
          pg8::gemm_phase<pg8::EpiMlaKV, true>(lds, g, So, E); }
    }
    SEAM(7);
    if (IN(8)) {
        const int hm = vcu >> 4;
        LAS float* tml = (LAS float*)(lds + mla::L_TBL);
        const float* tg = (const float*)(ws + WS_TMLA) + hm * 1216;
        for (int i = tid; i < 1216; i += NWAVES * 64) tml[i] = tg[i];
        const float clo = tg[0], chi = tg[1200];
        __syncthreads();
        for (int rd = 0; rd < 4; ++rd) mla::unit(hm, ((vcu & 15) * 4 + rd) * 256, Q1, K1, V1, OB, lds, clo, chi, wave, lane);
        __syncthreads();
    }
    SEAM(8);
    if (IN(9)) {
        pg8::Gemm g{OB, (const bf16*)(ws + W_OUT1), S, D, D, D}; pg8::StaticOrder So; So.init(S, D, G, bx);
        pg8::EpiResid E{out, out, XB, SS3};
        pg8::gemm_phase<pg8::EpiResid, true>(lds, g, So, E);
    }
    SEAM(9);
    if (IN(10)) {
        pg8::Gemm g{XB, (const bf16*)(ws + W_GU1), S, 2 * FF, D, D}; pg8::StaticOrder So; So.init(S, 2 * FF, G, bx);
        pg8::EpiSwiGLU E{BIG, SS3};
        pg8::gemm_phase<pg8::EpiSwiGLU, true>(lds, g, So, E);
    }
    SEAM(10);
    if (IN(11)) {
        pg8::Gemm g{BIG, (const bf16*)(ws + W_D1), S, D, FF, FF}; pg8::StaticOrder So; So.init(S, D, G, bx);
        pg8::EpiResid E{out, out, XB, SS4};
        pg8::gemm_phase<pg8::EpiResid, true>(lds, g, So, E);
    }
    SEAM(11);
    if (IN(12)) {
        const f32x4* gf = (const f32x4*)args.in[I_FINAL] + lane;
        for (int mrow = gw; mrow < S; mrow += NGW) {
            f32x4* xr = (f32x4*)(out + (size_t)mrow * D) + lane; f32x4 v[4]; float s2 = 0.f;
#pragma unroll
            for (int j = 0; j < 4; ++j) { v[j] = xr[64 * j]; s2 += (v[j].x * v[j].x + v[j].y * v[j].y) + (v[j].z * v[j].z + v[j].w * v[j].w); }
            const float rs = 1.0f / sqrtf(wave_sum(s2) * (1.0f / D) + RMS_EPS);
#pragma unroll
            for (int j = 0; j < 4; ++j) xr[64 * j] = v[j] * rs * gf[64 * j];
        }
    }
#undef IN
#undef SEAM
}

#if DBG_CHECK
namespace dbg {
constexpr int NSAMP = 1024;
__device__ __forceinline__ int srow(int i) { return 16 * i + ((i * 5) & 15); }
__device__ __forceinline__ void accum(float err, float ref, float* stats, int slot) {
    __shared__ float se[8], sr[8];
    err = wave_sum(err); ref = wave_sum(ref);
    const int w = threadIdx.x >> 6;
    if ((threadIdx.x & 63) == 0) { se[w] = err; sr[w] = ref; }
    __syncthreads();
    if (threadIdx.x == 0) { float e = 0.f, r = 0.f; for (int i = 0; i < (int)(blockDim.x >> 6); ++i) { e += se[i]; r += sr[i]; } atomicAdd(stats + 2 * slot, e); atomicAdd(stats + 2 * slot + 1, r); }
    __syncthreads();
}
__global__ void k_rowrstd(const float* src, int ld, int ncols, int compact, float* outv) {
    const int i = blockIdx.x, m = compact ? i : srow(i); float s = 0.f;
    for (int k = threadIdx.x; k < ncols; k += 64) { const float v = src[(size_t)m * ld + k]; s += v * v; }
    s = wave_sum(s);
    if (threadIdx.x == 0) outv[i] = 1.0f / sqrtf(s / ncols + RMS_EPS);
}
__global__ void k_rowrstd_bf(const bf16* src, int ld, int ncols, float* outv) {
    const int i = blockIdx.x, m = srow(i); float s = 0.f;
    for (int k = threadIdx.x; k < ncols; k += 64) { const float v = bf2f(src[(size_t)m * ld + k]); s += v * v; }
    s = wave_sum(s);
    if (threadIdx.x == 0) outv[i] = 1.0f / sqrtf(s / ncols + RMS_EPS);
}
__global__ void k_save_rows(const float* src, float* dst) {
    const int i = blockIdx.x, m = srow(i);
    for (int k = threadIdx.x; k < D; k += blockDim.x) dst[(size_t)i * D + k] = src[(size_t)m * D + k];
}
template <int ABF, int GOTBF>
__global__ void k_chk_lin(const void* A, int lda, int acomp, const float* rs, const float* gain, const float* W, int ldw, int K, int N,
                          const float* resid, int ldr, int rcomp, const void* got, int ldg, float gscale, float* stats, int slot) {
    const int i = blockIdx.y, m = srow(i), n = blockIdx.x * 256 + threadIdx.x;
    float err = 0.f, ref2 = 0.f;
    if (n < N) {
        const size_t arow = (size_t)(acomp ? i : m) * lda; float acc = 0.f;
        for (int k = 0; k < K; ++k) { const float a = ABF ? bf2f(((const bf16*)A)[arow + k]) : ((const float*)A)[arow + k]; acc += a * (gain ? gain[k] : 1.0f) * W[(size_t)k * ldw + n]; }
        float ref = acc * (rs ? rs[i] : 1.0f);
        if (resid) ref += resid[(size_t)(rcomp ? i : m) * ldr + n];
        const float g = (GOTBF ? bf2f(((const bf16*)got)[(size_t)m * ldg + n]) : ((const float*)got)[(size_t)m * ldg + n]) * gscale;
        err = (g - ref) * (g - ref); ref2 = ref * ref;
    }
    accum(err, ref2, stats, slot);
}
__global__ void k_chk_swiglu(const float* X, const float* rs, const float* gain, const float* Wg, const float* Wu, const bf16* got, float* stats, int slot) {
    const int i = blockIdx.y, m = srow(i), n = blockIdx.x * 256 + threadIdx.x;
    float a = 0.f, b = 0.f;
    for (int k = 0; k < D; ++k) { const float h = X[(size_t)m * D + k] * gain[k]; a += h * Wg[(size_t)k * FF + n]; b += h * Wu[(size_t)k * FF + n]; }
    a *= rs[i]; b *= rs[i];
    const float ref = a / (1.0f + expf(-a)) * b, g = bf2f(got[(size_t)m * FF + n]);
    accum((g - ref) * (g - ref), ref * ref, stats, slot);
}
__global__ void k_chk_krope(const float* X, const float* rs, const float* gain, const float* Win1, const bf16* K1, float* stats, int slot) {
    const int si = blockIdx.x, m = srow(si), i = threadIdx.x & 31, f = i & 15;
    float x1 = 0.f, x2 = 0.f;
    for (int k = 0; k < D; ++k) { const float h = X[(size_t)m * D + k] * gain[k]; x1 += h * Win1[(size_t)k * NIN1 + 512 + f]; x2 += h * Win1[(size_t)k * NIN1 + 528 + f]; }
    x1 *= rs[si]; x2 *= rs[si];
    const float fr = powf(10000.0f, -(float)f / 16.0f), ang = (float)m * fr, c = cosf(ang), sn = sinf(ang);
    const float ref = (i < 16) ? (x1 * c - x2 * sn) : (x1 * sn + x2 * c);
    float err = 0.f, r2 = 0.f;
    for (int h = (threadIdx.x >> 5) * 8; h < (threadIdx.x >> 5) * 8 + 8; ++h) { const float g = bf2f(K1[(size_t)m * KPITCH + h * 96 + 64 + i]); err += (g - ref) * (g - ref); r2 += ref * ref; }
    accum(err, r2, stats, slot);
}
__global__ void k_chk_q(const bf16* P, const float* rsq, const float* qnorm, const float* Wuq, const bf16* Q1, float* stats, int slot) {
    const int si = blockIdx.y, m = srow(si), n = blockIdx.x * 256 + threadIdx.x, off = n % 96;
    const bool rope = off >= 64; const int f = (off - 64) & 15; const int n1 = n - off + 64 + f, n2 = n1 + 16;
    float a = 0.f, b = 0.f;
    for (int k = 0; k < QL; ++k) { const float c = bf2f(P[(size_t)m * NIN1P + k]) * qnorm[k];
        if (rope) { a += c * Wuq[(size_t)k * NQ1 + n1]; b += c * Wuq[(size_t)k * NQ1 + n2]; } else a += c * Wuq[(size_t)k * NQ1 + n]; }
    a *= rsq[si]; b *= rsq[si];
    float ref = a;
    if (rope) { const float fr = powf(10000.0f, -(float)f / 16.0f), ang = (float)m * fr, c = cosf(ang), sn = sinf(ang); ref = (off < 80) ? (a * c - b * sn) : (a * sn + b * c); }
    const float g = bf2f(Q1[(size_t)m * NQ1 + n]) / C2_MLA;
    accum((g - ref) * (g - ref), ref * ref, stats, slot);
}
__global__ void k_chk_kv(const bf16* P, const float* rskv, const float* kvnorm, const float* W, const bf16* got, int iskf, float* stats, int slot) {
    const int si = blockIdx.y, m = srow(si), n = blockIdx.x * 256 + threadIdx.x;
    float a = 0.f;
    for (int k = 0; k < KVL; ++k) a += bf2f(P[(size_t)m * NIN1P + QL + k]) * kvnorm[k] * W[(size_t)k * D + n];
    a *= rskv[si];
    const float g = iskf ? bf2f(got[(size_t)m * KPITCH + (n >> 6) * 96 + (n & 63)]) : bf2f(got[(size_t)m * D + n]);
    accum((g - a) * (g - a), a * a, stats, slot);
}
__device__ __forceinline__ int ltok(int i) { if (i < 4) return i; if (i < 8) return S - 1 - (i - 4); return 32 * i + ((i * 13) & 31); }
__global__ void __launch_bounds__(64) k_chk_local(const bf16* QKV, const float* t5, const float* rpb, const bf16* O, float* stats, int slot) {
    const int idx = blockIdx.x * 64 + threadIdx.x, i = idx >> 4, h = idx & 15, t = ltok(i);
    float q[64], o[64];
    float err = 0.f, r2 = 0.f;
    if (h < 8) {
        const bf16* qp = QKV + (size_t)t * NQKV + h * 64;
        _Pragma("unroll") for (int d = 0; d < 64; ++d) { q[d] = bf2f(qp[d]); o[d] = 0.f; }
        float mb[3], denb[3];
        _Pragma("unroll") for (int b = 0; b < 3; ++b) { const int dil = b == 0 ? 1 : (b == 1 ? 4 : 16); float mx = -3e38f;
            for (int j = -64; j <= 64; ++j) { const int u = t + dil * j; if (u < 0 || u >= S) continue;
                const bf16* kp = QKV + (size_t)u * NQKV + 512 + h * 64; float sc = 0.f; _Pragma("unroll") for (int d = 0; d < 64; ++d) sc += q[d] * bf2f(kp[d]);
                sc = sc * 0.125f + t5[t5_bucket_precise(dil * j) * 16 + h]; mx = fmaxf(mx, sc); }
            float den = 0.f;
            for (int j = -64; j <= 64; ++j) { const int u = t + dil * j; if (u < 0 || u >= S) continue;
                const bf16* kp = QKV + (size_t)u * NQKV + 512 + h * 64; float sc = 0.f; _Pragma("unroll") for (int d = 0; d < 64; ++d) sc += q[d] * bf2f(kp[d]);
                sc = sc * 0.125f + t5[t5_bucket_precise(dil * j) * 16 + h]; den += expf(sc - mx); }
            mb[b] = mx; denb[b] = den; }
        float lse[3], M = -3e38f; _Pragma("unroll") for (int b = 0; b < 3; ++b) { lse[b] = mb[b] + logf(denb[b]); M = fmaxf(M, lse[b]); }
        float wsum = 0.f, wb[3]; _Pragma("unroll") for (int b = 0; b < 3; ++b) { wb[b] = expf(lse[b] - M); wsum += wb[b]; }
        _Pragma("unroll") for (int b = 0; b < 3; ++b) { const int dil = b == 0 ? 1 : (b == 1 ? 4 : 16); const float coef = wb[b] / wsum / denb[b];
            for (int j = -64; j <= 64; ++j) { const int u = t + dil * j; if (u < 0 || u >= S) continue;
                const bf16* kp = QKV + (size_t)u * NQKV + 512 + h * 64; const bf16* vp = QKV + (size_t)u * NQKV + 1024 + h * 64; float sc = 0.f; _Pragma("unroll") for (int d = 0; d < 64; ++d) sc += q[d] * bf2f(kp[d]);
                sc = sc * 0.125f + t5[t5_bucket_precise(dil * j) * 16 + h]; const float p = expf(sc - mb[b]) * coef;
                _Pragma("unroll") for (int d = 0; d < 64; ++d) o[d] += p * bf2f(vp[d]); } }
        const bf16* op = O + (size_t)t * D + h * 64;
        _Pragma("unroll") for (int d = 0; d < 64; ++d) { const float g = bf2f(op[d]); err += (g - o[d]) * (g - o[d]); r2 += o[d] * o[d]; }
    } else {
        const int hb = h - 8, r = t >> 6, c = t & 63;
        int r0 = r - 4; r0 = r0 < 0 ? 0 : (r0 > 248 ? 248 : r0); int c0 = c - 8; c0 = c0 < 0 ? 0 : (c0 > 48 ? 48 : c0);
        const bf16* qp = QKV + (size_t)t * NQKV + 1536 + hb * 64;
        _Pragma("unroll") for (int d = 0; d < 64; ++d) { q[d] = bf2f(qp[d]); o[d] = 0.f; }
        float mx = -3e38f;
        for (int kr = 0; kr < 8; ++kr) for (int kc = c0; kc < c0 + 16; ++kc) { const int u = (r0 + kr) * 64 + kc;
            const bf16* kp = QKV + (size_t)u * NQKV + 2048 + hb * 64; float sc = 0.f; _Pragma("unroll") for (int d = 0; d < 64; ++d) sc += q[d] * bf2f(kp[d]);
            sc = sc * 0.125f + rpb[(hb * 15 + (r0 + kr - r + 7)) * 31 + (kc - c + 15)]; mx = fmaxf(mx, sc); }
        float den = 0.f;
        for (int kr = 0; kr < 8; ++kr) for (int kc = c0; kc < c0 + 16; ++kc) { const int u = (r0 + kr) * 64 + kc;
            const bf16* kp = QKV + (size_t)u * NQKV + 2048 + hb * 64; const bf16* vp = QKV + (size_t)u * NQKV + 2560 + hb * 64; float sc = 0.f; _Pragma("unroll") for (int d = 0; d < 64; ++d) sc += q[d] * bf2f(kp[d]);
            sc = sc * 0.125f + rpb[(hb * 15 + (r0 + kr - r + 7)) * 31 + (kc - c + 15)]; const float p = expf(sc - mx); den += p;
            _Pragma("unroll") for (int d = 0; d < 64; ++d) o[d] += p * bf2f(vp[d]); }
        const bf16* op = O + (size_t)t * D + 512 + hb * 64;
        _Pragma("unroll") for (int d = 0; d < 64; ++d) { const float g = bf2f(op[d]); const float rf = o[d] / den; err += (g - rf) * (g - rf); r2 += rf * rf; }
    }
    accum(err, r2, stats, slot);
}
__global__ void __launch_bounds__(256) k_chk_mla(const bf16* Q1, const bf16* K1, const bf16* V1, const float* t5, const bf16* O, float* stats, int slot) {
    const int i = blockIdx.x >> 4, h = blockIdx.x & 15, t = 256 * i + ((i * 37) & 255), tid = threadIdx.x;
    __shared__ float qs[96], red[8], so[64];
    if (tid < 96) qs[tid] = bf2f(Q1[(size_t)t * NQ1 + h * 96 + tid]);
    if (tid < 64) so[tid] = 0.f;
    __syncthreads();
    float mx = -3e38f;
    for (int k = tid; k < S; k += 256) { const bf16* kp = K1 + (size_t)k * KPITCH + h * 96; float sc = 0.f; _Pragma("unroll") for (int d = 0; d < 96; ++d) sc += qs[d] * bf2f(kp[d]);
        sc += t5[t5_bucket_precise(k - t) * 16 + h] * LOG2E; mx = fmaxf(mx, sc); }
    for (int o = 1; o < 64; o <<= 1) mx = fmaxf(mx, __shfl_xor(mx, o));
    if ((tid & 63) == 0) red[tid >> 6] = mx;
    __syncthreads();
    mx = fmaxf(fmaxf(red[0], red[1]), fmaxf(red[2], red[3]));
    __syncthreads();
    float den = 0.f, o[64];
    _Pragma("unroll") for (int d = 0; d < 64; ++d) o[d] = 0.f;
    for (int k = tid; k < S; k += 256) { const bf16* kp = K1 + (size_t)k * KPITCH + h * 96; const bf16* vp = V1 + (size_t)k * D + h * 64; float sc = 0.f; _Pragma("unroll") for (int d = 0; d < 96; ++d) sc += qs[d] * bf2f(kp[d]);
        sc += t5[t5_bucket_precise(k - t) * 16 + h] * LOG2E; const float p = exp2f(sc - mx); den += p;
        _Pragma("unroll") for (int d = 0; d < 64; ++d) o[d] += p * bf2f(vp[d]); }
    den = wave_sum(den);
    if ((tid & 63) == 0) red[4 + (tid >> 6)] = den;
    _Pragma("unroll") for (int d = 0; d < 64; ++d) { const float v = wave_sum(o[d]); if ((tid & 63) == 0) atomicAdd(&so[d], v); }
    __syncthreads();
    den = red[4] + red[5] + red[6] + red[7];
    float err = 0.f, r2 = 0.f;
    if (tid < 64) { const float rf = so[tid] / den, g = bf2f(O[(size_t)t * D + h * 64 + tid]); err = (g - rf) * (g - rf); r2 = rf * rf; }
    accum(err, r2, stats, slot);
}
__global__ void k_chk_final(const float* save, const float* rs, const float* gf, const float* outp, float* stats, int slot) {
    const int i = blockIdx.x, m = srow(i); float err = 0.f, r2 = 0.f;
    for (int k = threadIdx.x; k < D; k += 256) { const float ref = save[(size_t)i * D + k] * rs[i] * gf[k], g = outp[(size_t)m * D + k]; err += (g - ref) * (g - ref); r2 += ref * ref; }
    accum(err, r2, stats, slot);
}
__global__ void k_finalize(const float* stats, float* outp, float tol, int magslot) {
    if (threadIdx.x != 0 || blockIdx.x != 0) return;
    int fail = 0; float relf = 0.f;
    for (int s = 1; s <= 16; ++s) { const float e = stats[2 * s], r = stats[2 * s + 1]; const float rel = sqrtf(e / fmaxf(r, 1e-30f)); const bool bad = !(rel <= tol) || !(r > 0.f);
        if (bad && !fail) { fail = s; relf = rel; } }
    if (magslot > 0) { const float e = stats[2 * magslot], r = stats[2 * magslot + 1]; outp[0] += 1.0e4f * fminf(sqrtf(e / fmaxf(r, 1e-30f)), 10.f) + 1.0f; }
    else if (fail) outp[0] += 100.0f + 10.0f * fail;
}
}

#endif

extern "C" void kernel_launch(void* const* d_in, const int* in_sizes, int n_in, void* d_out, int out_size, void* d_ws, size_t ws_size, hipStream_t stream) {
    static int grid = 0;
    if (grid == 0) {
        if (n_in != 18 || in_sizes[0] != S * D || out_size != S * D || ws_size < WS_END) { fprintf(stderr, "kernel_launch: unexpected shapes (n_in %d, in0 %d, out %d, ws %zu)\n", n_in, n_in > 0 ? in_sizes[0] : -1, out_size, ws_size); grid = -1; return; }
        int dev = 0, cus = 0, per_cu = 0;
        if (hipGetDevice(&dev) != hipSuccess || hipDeviceGetAttribute(&cus, hipDeviceAttributeMultiprocessorCount, dev) != hipSuccess) { grid = -1; return; }
        if (hipFuncSetAttribute((const void*)fwd_kernel, hipFuncAttributeMaxDynamicSharedMemorySize, LDS_BYTES) != hipSuccess) { fprintf(stderr, "kernel_launch: hipFuncSetAttribute failed\n"); grid = -1; return; }
        if (hipOccupancyMaxActiveBlocksPerMultiprocessor(&per_cu, (const void*)fwd_kernel, NWAVES * 64, LDS_BYTES) != hipSuccess || per_cu < 1) fprintf(stderr, "kernel_launch: occupancy query reports %d\n", per_cu);
        (void)hipGetLastError();
        grid = cus;
        if (grid != 256) fprintf(stderr, "kernel_launch: %d CUs; this kernel's unit maps assume 256\n", grid);
    }
    if (grid < 0) return;
    (void)hipMemsetAsync((char*)d_ws + WS_CTL, 0, CTL_ZERO_BYTES, stream);
    Args a{};
    for (int i = 0; i < 18; ++i) a.in[i] = (const float*)d_in[i];
    a.out = (float*)d_out; a.ws = (unsigned char*)d_ws;
#if DBG_CHECK
    {
        using namespace dbg;
        unsigned char* ws = (unsigned char*)d_ws; float* outp = (float*)d_out;
        float* stats = (float*)(ws + CTL_STATS); float* rstd = (float*)(ws + CTL_RSTD); float* rstd2 = rstd + 1024; float* save = (float*)(ws + WS_SAVE);
        bf16* XBp = (bf16*)(ws + WS_XB); bf16* OBp = (bf16*)(ws + WS_O); bf16* BIGp = (bf16*)(ws + WS_BIG); bf16* Q1p = (bf16*)(ws + WS_Q1); bf16* K1p = (bf16*)(ws + WS_K1); bf16* V1p = (bf16*)(ws + WS_V1);
        const float* x = a.in[I_X];
        for (int ph = 0; ph < NPH; ++ph) {
            if (ph == 5 || ph == 9 || ph == 11 || ph == 12) hipLaunchKernelGGL(k_save_rows, dim3(NSAMP), dim3(256), 0, stream, (const float*)outp, save);
            a.ph_lo = ph; a.ph_hi = ph + 1;
            hipLaunchKernelGGL(fwd_kernel, dim3(grid), dim3(NWAVES * 64), LDS_BYTES, stream, a);
            switch (ph) {
            case 1: hipLaunchKernelGGL(k_rowrstd, dim3(NSAMP), dim3(64), 0, stream, x, D, D, 0, rstd);
                hipLaunchKernelGGL((k_chk_lin<0, 1>), dim3(12, NSAMP), dim3(256), 0, stream, (const void*)x, D, 0, (const float*)rstd, a.in[I_ANORM], a.in[I_EWIN], NQKV, D, NQKV, (const float*)nullptr, 0, 0, (const void*)BIGp, NQKV, 1.0f, stats, 1); break;
            case 2: hipLaunchKernelGGL(k_chk_local, dim3(512 * 16 / 64), dim3(64), 0, stream, (const bf16*)BIGp, a.in[I_T5], a.in[I_RPB], (const bf16*)OBp, stats, 2); break;
            case 3: hipLaunchKernelGGL((k_chk_lin<1, 0>), dim3(4, NSAMP), dim3(256), 0, stream, (const void*)OBp, D, 0, (const float*)nullptr, (const float*)nullptr, a.in[I_EWOUT], D, D, D, x, D, 0, (const void*)outp, D, 1.0f, stats, 3);
                hipLaunchKernelGGL((k_chk_lin<1, 1>), dim3(4, NSAMP), dim3(256), 0, stream, (const void*)OBp, D, 0, (const float*)nullptr, (const float*)nullptr, a.in[I_EWOUT], D, D, D, x, D, 0, (const void*)XBp, D, 1.0f, stats, 16); break;
            case 4: hipLaunchKernelGGL(k_rowrstd, dim3(NSAMP), dim3(64), 0, stream, (const float*)outp, D, D, 0, rstd);
                hipLaunchKernelGGL(k_chk_swiglu, dim3(11, NSAMP), dim3(256), 0, stream, (const float*)outp, (const float*)rstd, a.in[I_FNORM], a.in[I_WG], a.in[I_WU], (const bf16*)BIGp, stats, 4); break;
            case 5: hipLaunchKernelGGL((k_chk_lin<1, 0>), dim3(4, NSAMP), dim3(256), 0, stream, (const void*)BIGp, FF, 0, (const float*)nullptr, (const float*)nullptr, a.in[I_WD], D, FF, D, (const float*)save, D, 1, (const void*)outp, D, 1.0f, stats, 5); break;
            case 6: hipLaunchKernelGGL(k_rowrstd, dim3(NSAMP), dim3(64), 0, stream, (const float*)outp, D, D, 0, rstd);
                hipLaunchKernelGGL((k_chk_lin<0, 1>), dim3(2, NSAMP), dim3(256), 0, stream, (const void*)outp, D, 0, (const float*)rstd, a.in[I_ANORM] + D, a.in[I_OWIN], NIN1, D, 512, (const float*)nullptr, 0, 0, (const void*)OBp, NIN1P, 1.0f, stats, 6);
                hipLaunchKernelGGL(k_chk_krope, dim3(NSAMP), dim3(64), 0, stream, (const float*)outp, (const float*)rstd, a.in[I_ANORM] + D, a.in[I_OWIN], (const bf16*)K1p, stats, 7); break;
            case 7: hipLaunchKernelGGL(k_rowrstd_bf, dim3(NSAMP), dim3(64), 0, stream, (const bf16*)OBp, NIN1P, QL, rstd);
                hipLaunchKernelGGL(k_rowrstd_bf, dim3(NSAMP), dim3(64), 0, stream, (const bf16*)OBp + QL, NIN1P, KVL, rstd2);
                hipLaunchKernelGGL(k_chk_q, dim3(6, NSAMP), dim3(256), 0, stream, (const bf16*)OBp, (const float*)rstd, a.in[I_QNORM], a.in[I_WUQ], (const bf16*)Q1p, stats, 8);
                hipLaunchKernelGGL(k_chk_kv, dim3(4, NSAMP), dim3(256), 0, stream, (const bf16*)OBp, (const float*)rstd2, a.in[I_KVNORM], a.in[I_WUK], (const bf16*)K1p, 1, stats, 9);
                hipLaunchKernelGGL(k_chk_kv, dim3(4, NSAMP), dim3(256), 0, stream, (const bf16*)OBp, (const float*)rstd2, a.in[I_KVNORM], a.in[I_WUV], (const bf16*)V1p, 0, stats, 10); break;
            case 8: hipLaunchKernelGGL(k_chk_mla, dim3(64 * 16), dim3(256), 0, stream, (const bf16*)Q1p, (const bf16*)K1p, (const bf16*)V1p, a.in[I_T5], (const bf16*)OBp, stats, 11); break;
            case 9: hipLaunchKernelGGL((k_chk_lin<1, 0>), dim3(4, NSAMP), dim3(256), 0, stream, (const void*)OBp, D, 0, (const float*)nullptr, (const float*)nullptr, a.in[I_OWOUT], D, D, D, (const float*)save, D, 1, (const void*)outp, D, 1.0f, stats, 12); break;
            case 10: hipLaunchKernelGGL(k_rowrstd, dim3(NSAMP), dim3(64), 0, stream, (const float*)outp, D, D, 0, rstd);
                hipLaunchKernelGGL(k_chk_swiglu, dim3(11, NSAMP), dim3(256), 0, stream, (const float*)outp, (const float*)rstd, a.in[I_FNORM] + D, a.in[I_WG] + (size_t)D * FF, a.in[I_WU] + (size_t)D * FF, (const bf16*)BIGp, stats, 13); break;
            case 11: hipLaunchKernelGGL((k_chk_lin<1, 0>), dim3(4, NSAMP), dim3(256), 0, stream, (const void*)BIGp, FF, 0, (const float*)nullptr, (const float*)nullptr, a.in[I_WD] + (size_t)FF * D, D, FF, D, (const float*)save, D, 1, (const void*)outp, D, 1.0f, stats, 14); break;
            case 12: hipLaunchKernelGGL(k_rowrstd, dim3(NSAMP), dim3(64), 0, stream, (const float*)save, D, D, 1, rstd);
                hipLaunchKernelGGL(k_chk_final, dim3(NSAMP), dim3(256), 0, stream, (const float*)save, (const float*)rstd, a.in[I_FINAL], (const float*)outp, stats, 15); break;
            default: break;
            }
        }
        hipLaunchKernelGGL(k_finalize, dim3(1), dim3(64), 0, stream, (const float*)stats, outp, DBG_TOL, DBG_MAGSLOT);
    }
#else
    a.ph_lo = 0; a.ph_hi = NPH;
    hipLaunchKernelGGL(fwd_kernel, dim3(grid), dim3(NWAVES * 64), LDS_BYTES, stream, a);
#endif
}
```

```cpp
#include <hip/hip_runtime.h>
#include <cstdio>
#include <cstdint>

#ifndef DBG_CHECK
#define DBG_CHECK 0
#endif
#ifndef DBG_CHECK_NOFUSE
#define FUSE_FINAL_NORM 1
#endif
#ifndef DBG_TOL
#define DBG_TOL 0.03f
#endif
#ifndef DBG_MAGSLOT
#define DBG_MAGSLOT 0
#endif

#define LAS __attribute__((address_space(3)))
#define GAS __attribute__((address_space(1)))
typedef unsigned short bf16;
typedef short bf16x8 __attribute__((ext_vector_type(8)));
typedef short s16x4 __attribute__((ext_vector_type(4)));
typedef float f32x4 __attribute__((ext_vector_type(4)));
typedef float f32x16 __attribute__((ext_vector_type(16)));
typedef unsigned u32x4 __attribute__((ext_vector_type(4)));
typedef unsigned u32x2 __attribute__((ext_vector_type(2)));
typedef float f32x2_t __attribute__((ext_vector_type(2)));
typedef __bf16 bf16x2_t __attribute__((ext_vector_type(2)));

constexpr int S = 16384, D = 1024, FF = 2816, NQKV = 3072;
constexpr int NIN1 = 544, NIN1P = 768, QL = 384, KVL = 128, KVLP = 256, NQ1 = 1536, NKV1 = 2048, KPITCH = 1536  ;
constexpr float RMS_EPS = 1e-6f, LOG2E = 1.4426950408889634f;
constexpr float C2_LOCAL = 0.125f * LOG2E;
constexpr float C2_MLA = 0.10206207261596577f * LOG2E;
constexpr float NEGB = -1e30f;

constexpr size_t MiB = 1u << 20;
constexpr size_t WS_CTL = 0, CTL_ZERO_BYTES = 1 * MiB;
constexpr size_t CTL_BAR = 16384;
constexpr size_t CTL_PANEL = 96 * 1024;
constexpr size_t CTL_SPLIT = 112 * 1024;
constexpr size_t CTL_SS = 128 * 1024;
constexpr size_t CTL_STATS = 600 * 1024;
constexpr size_t CTL_RSTD = 640 * 1024;
constexpr size_t WS_ROPE = 1 * MiB;
constexpr size_t WS_TDIL = 3 * MiB;
constexpr size_t WS_TMLA = 3 * MiB + 128 * 1024;
constexpr size_t WS_TRPB = 3 * MiB + 256 * 1024;
constexpr size_t WS_W = 8 * MiB;
constexpr size_t W_IN0 = WS_W, W_OUT0 = W_IN0 + 6 * MiB, W_GU0 = W_OUT0 + 2 * MiB, W_D0 = W_GU0 + 11 * MiB, W_IN1 = W_D0 + 6 * MiB,
                 W_UQ = W_IN1 + 2 * MiB, W_UKV = W_UQ + 2 * MiB, W_OUT1 = W_UKV + 1 * MiB, W_GU1 = W_OUT1 + 2 * MiB, W_D1 = W_GU1 + 11 * MiB, W_END = W_D1 + 6 * MiB;
constexpr size_t WS_XB = 57 * MiB;
constexpr size_t WS_O = 89 * MiB;
constexpr size_t WS_BIG = 121 * MiB;
constexpr size_t WS_Q1 = WS_BIG, WS_K1 = WS_BIG + 48 * MiB, WS_V1 = 217 * MiB;
constexpr size_t WS_SAVE = 252 * MiB, WS_END = 256 * MiB;
static_assert(W_END <= WS_XB && WS_V1 + 32 * MiB <= WS_SAVE, "d_ws map");

constexpr int LDS_BYTES = 147456;
constexpr int MISC_OFF = 131072 + 320;
constexpr int LDSCTL_OFF = 131072;

__device__ __forceinline__ float bf2f(unsigned short b) { return __builtin_bit_cast(float, (unsigned)b << 16); }
__device__ __forceinline__ unsigned cvtpk(float lo, float hi) { f32x2_t v = {lo, hi}; bf16x2_t b = __builtin_convertvector(v, bf16x2_t); return __builtin_bit_cast(unsigned, b); }
__device__ __forceinline__ float wave_sum(float v) {
#pragma unroll
    for (int o = 1; o < 64; o <<= 1) v += __shfl_xor(v, o);
    return v;
}

namespace pg8 {
constexpr int BM = 256, BK = 64, HALF = 128, HTB = HALF * BK * 2, STAGE_BYTES = 8 * HTB, NXCD = 8, WGM = 8;
__host__ __device__ __forceinline__ int lds_byte(int r, int c) { const int st = (r >> 4) * 2 + (c >> 5), rr = r & 15, cc = c & 31, ob = rr * 64 + cc * 2; return st * 1024 + (ob ^ (((ob >> 9) & 1) << 5)); }
__host__ __device__ __forceinline__ void stage_rc(int b, int& R, int& C) { const int st = b / 1024, sb = b % 1024, swz = sb ^ (((sb >> 9) & 1) << 5); R = (st >> 1) * 16 + swz / 64; C = (st & 1) * 32 + (swz % 64) / 2; }
__host__ __device__ __forceinline__ int perm32(int rho) { const int n = rho >> 4, i = rho & 15; return 8 * (i >> 2) + 4 * n + (i & 3); }

struct Unit { int pm, pn; };
struct Gemm { const bf16* A; const bf16* Bt; int M, N, K, lda; int ldb = 0; };

struct StaticOrder {
    int nM, nN, nwg, G, c, lo, hi;
    __device__ void init(int M, int N, int G_, int c_) { nM = M / BM; nN = N / BM; nwg = nM * nN; G = G_; c = c_; lo = 0; hi = nwg; }
    __device__ bool next(int i, Unit& u) const {
        const long L = (long)lo + (long)i * G + c; if (L >= hi) return false;
        int wgid = (int)L; { const int q = nwg / NXCD, r = nwg % NXCD, xcd = wgid % NXCD, off = wgid / NXCD; wgid = (xcd < r ? xcd * (q + 1) : r * (q + 1) + (xcd - r) * q) + off; }
        const int nig = WGM * nN, gid = wgid / nig, fm = gid * WGM, gsz = (nM - fm) < WGM ? (nM - fm) : WGM;
        u.pm = fm + ((wgid % nig) % gsz); u.pn = (wgid % nig) / gsz; return true;
    }
};

typedef f32x4 Acc[2][2][4][2];

struct EpiRowScale {
    bf16* O; int ldc; const float* ss; float invk; int qscale;
    __device__ __forceinline__ void operator()(const Acc& acc, const Unit& u, int wr, int wc, int fr, int fq) const {
        const int row0 = u.pm * BM + wr * 64 + fr, col0 = u.pn * BM + wc * 32 + 8 * fq;
#pragma unroll
        for (int ai = 0; ai < 2; ++ai)
#pragma unroll
            for (int m = 0; m < 4; ++m) { const int row = row0 + ai * HALF + m * 16; const float rs = __builtin_amdgcn_rsqf(ss[row] * invk + RMS_EPS) * ((qscale && (u.pn < 2 || (u.pn & ~1) == 6)) ? C2_LOCAL : 1.0f);
                bf16* rowp = O + (size_t)row * ldc + col0;
#pragma unroll
                for (int bj = 0; bj < 2; ++bj) { const f32x4 v0 = acc[ai][bj][m][0] * rs, v1 = acc[ai][bj][m][1] * rs;
                    u32x4 w; w.x = cvtpk(v0[0], v0[1]); w.y = cvtpk(v0[2], v0[3]); w.z = cvtpk(v1[0], v1[1]); w.w = cvtpk(v1[2], v1[3]);
                    *(u32x4*)(rowp + bj * HALF) = w; } }
    }
};
struct EpiResid {
    const float* R; const bf16* R16; float* X; bf16* XB; float* ssout;
    __device__ __forceinline__ void operator()(const Acc& acc, const Unit& u, int wr, int wc, int fr, int fq) const {
        const int row0 = u.pm * BM + wr * 64 + fr, col0 = u.pn * BM + wc * 32 + 8 * fq;
#pragma unroll
        for (int ai = 0; ai < 2; ++ai)
#pragma unroll
            for (int m = 0; m < 4; ++m) { const int row = row0 + ai * HALF + m * 16; const size_t off = (size_t)row * D + col0; float sq = 0.f;
#pragma unroll
                for (int bj = 0; bj < 2; ++bj) { f32x4 r0, r1;
                    if (R) { r0 = *(const f32x4*)(R + off + bj * HALF); r1 = *(const f32x4*)(R + off + bj * HALF + 4); }
                    else { const u32x4 rb = *(const u32x4*)(R16 + off + bj * HALF);
                        r0 = (f32x4){__builtin_bit_cast(float, rb.x << 16), __builtin_bit_cast(float, rb.x & 0xffff0000u), __builtin_bit_cast(float, rb.y << 16), __builtin_bit_cast(float, rb.y & 0xffff0000u)};
                        r1 = (f32x4){__builtin_bit_cast(float, rb.z << 16), __builtin_bit_cast(float, rb.z & 0xffff0000u), __builtin_bit_cast(float, rb.w << 16), __builtin_bit_cast(float, rb.w & 0xffff0000u)}; }
                    const f32x4 v0 = acc[ai][bj][m][0] + r0, v1 = acc[ai][bj][m][1] + r1;
                    if (X) { *(f32x4*)(X + off + bj * HALF) = v0; *(f32x4*)(X + off + bj * HALF + 4) = v1; }
                    u32x4 w; w.x = cvtpk(v0[0], v0[1]); w.y = cvtpk(v0[2], v0[3]); w.z = cvtpk(v1[0], v1[1]); w.w = cvtpk(v1[2], v1[3]);
                    *(u32x4*)(XB + off + bj * HALF) = w;
                    sq += (v0[0] * v0[0] + v0[1] * v0[1]) + (v0[2] * v0[2] + v0[3] * v0[3]) + (v1[0] * v1[0] + v1[1] * v1[1]) + (v1[2] * v1[2] + v1[3] * v1[3]); }
                sq += __shfl_xor(sq, 16); sq += __shfl_xor(sq, 32);
                if (fq == 0) atomicAdd(ssout + row, sq); }
    }
};
struct EpiFinal {
    const float* R; const bf16* R16; float* OUT; float* ss; unsigned* cnt; const float* gf;
    __device__ __forceinline__ void operator()(const Acc& acc, const Unit& u, int wr, int wc, int fr, int fq) const {
        const int row0 = u.pm * BM + wr * 64 + fr, col0 = u.pn * BM + wc * 32 + 8 * fq;
        f32x4 xv[2][2][4][2];
#pragma unroll
        for (int ai = 0; ai < 2; ++ai)
#pragma unroll
            for (int m = 0; m < 4; ++m) { const int row = row0 + ai * HALF + m * 16; const size_t off = (size_t)row * D + col0; float sq = 0.f;
#pragma unroll
                for (int bj = 0; bj < 2; ++bj) { f32x4 r0, r1;
                    if (R) { r0 = *(const f32x4*)(R + off + bj * HALF); r1 = *(const f32x4*)(R + off + bj * HALF + 4); }
                    else { const u32x4 rb = *(const u32x4*)(R16 + off + bj * HALF);
                        r0 = (f32x4){__builtin_bit_cast(float, rb.x << 16), __builtin_bit_cast(float, rb.x & 0xffff0000u), __builtin_bit_cast(float, rb.y << 16), __builtin_bit_cast(float, rb.y & 0xffff0000u)};
                        r1 = (f32x4){__builtin_bit_cast(float, rb.z << 16), __builtin_bit_cast(float, rb.z & 0xffff0000u), __builtin_bit_cast(float, rb.w << 16), __builtin_bit_cast(float, rb.w & 0xffff0000u)}; }
                    const f32x4 v0 = acc[ai][bj][m][0] + r0, v1 = acc[ai][bj][m][1] + r1; xv[ai][bj][m][0] = v0; xv[ai][bj][m][1] = v1;
                    sq += (v0[0] * v0[0] + v0[1] * v0[1]) + (v0[2] * v0[2] + v0[3] * v0[3]) + (v1[0] * v1[0] + v1[1] * v1[1]) + (v1[2] * v1[2] + v1[3] * v1[3]); }
                sq += __shfl_xor(sq, 16); sq += __shfl_xor(sq, 32);
                if (fq == 0) atomicAdd(ss + row, sq); }
        asm volatile("s_waitcnt vmcnt(0)" ::: "memory");
        __syncthreads();
        unsigned* c = cnt + 64 * u.pm;
        if (threadIdx.x == 0) {
            __builtin_amdgcn_fence(__ATOMIC_RELEASE, "agent");
            asm volatile("s_waitcnt vmcnt(0)" ::: "memory");
            __hip_atomic_fetch_add(c, 1u, __ATOMIC_RELAXED, __HIP_MEMORY_SCOPE_AGENT);
            unsigned sp = 0;
            while (__hip_atomic_load(c, __ATOMIC_RELAXED, __HIP_MEMORY_SCOPE_AGENT) < 4u) { __builtin_amdgcn_s_sleep(2); if (++sp > (1u << 22)) break; }
            __builtin_amdgcn_fence(__ATOMIC_ACQUIRE, "agent");
            asm volatile("s_waitcnt vmcnt(0)" ::: "memory");
        }
        __syncthreads();
        f32x4 g0[2], g1[2];
#pragma unroll
        for (int bj = 0; bj < 2; ++bj) { g0[bj] = *(const f32x4*)(gf + col0 + bj * HALF); g1[bj] = *(const f32x4*)(gf + col0 + bj * HALF + 4); }
#pragma unroll
        for (int ai = 0; ai < 2; ++ai)
#pragma unroll
            for (int m = 0; m < 4; ++m) { const int row = row0 + ai * HALF + m * 16; const size_t off = (size_t)row * D + col0;
                const float tot = __hip_atomic_load(ss + row, __ATOMIC_RELAXED, __HIP_MEMORY_SCOPE_AGENT);
                const float rs = 1.0f / sqrtf(tot * (1.0f / D) + RMS_EPS);
#pragma unroll
                for (int bj = 0; bj < 2; ++bj) { *(f32x4*)(OUT + off + bj * HALF) = xv[ai][bj][m][0] * rs * g0[bj]; *(f32x4*)(OUT + off + bj * HALF + 4) = xv[ai][bj][m][1] * rs * g1[bj]; } }
    }
};
__device__ __forceinline__ char* uni_ptr(const void* p) { const unsigned long long b = (unsigned long long)p; const unsigned lo = __builtin_amdgcn_readfirstlane((unsigned)b), hi = __builtin_amdgcn_readfirstlane((unsigned)(b >> 32)); return (char*)(((unsigned long long)hi << 32) | lo); }
struct EpiPartStore {
    float* part; unsigned* flag;
    __device__ __forceinline__ void operator()(const Acc& acc, const Unit&, int, int, int, int) const {
        char* pb = uni_ptr(part); const unsigned lo = threadIdx.x * 16u;
        asm volatile("s_nop 15\n\ts_nop 15" ::: "memory");
#pragma unroll
        for (int ai = 0; ai < 2; ++ai)
#pragma unroll
            for (int bj = 0; bj < 2; ++bj)
#pragma unroll
                for (int m = 0; m < 4; ++m)
#pragma unroll
                    for (int n = 0; n < 2; ++n) asm volatile("global_store_dwordx4 %0, %1, %2 sc0 sc1" :: "v"(lo), "v"(acc[ai][bj][m][n]), "s"(uni_ptr(pb + (((ai * 2 + bj) * 4 + m) * 2 + n) * 8192)) : "memory");
        asm volatile("s_waitcnt vmcnt(0)" ::: "memory");
        __syncthreads();
        if (threadIdx.x == 0) __hip_atomic_store(flag, 1u, __ATOMIC_RELAXED, __HIP_MEMORY_SCOPE_AGENT);
    }
};
template <class Base>
struct EpiJoin {
    Base base; const float* part; unsigned* flag;
    __device__ __forceinline__ void operator()(const Acc& acc_, const Unit& u, int wr, int wc, int fr, int fq) const {
        if (threadIdx.x == 0) { unsigned sp = 0; while (__hip_atomic_load(flag, __ATOMIC_RELAXED, __HIP_MEMORY_SCOPE_AGENT) == 0u) { __builtin_amdgcn_s_sleep(2); if (++sp > (1u << 22)) break; } }
        __syncthreads();
        Acc& acc = const_cast<Acc&>(acc_);
        const char* pb = uni_ptr(part); const unsigned lo = threadIdx.x * 16u;
#pragma unroll
        for (int ai = 0; ai < 2; ++ai)
#pragma unroll
            for (int bj = 0; bj < 2; ++bj) {
                const char* gb = uni_ptr(pb + (ai * 2 + bj) * 65536);
                f32x4 t0, t1, t2, t3, t4, t5, t6, t7;
                asm volatile("global_load_dwordx4 %0, %8, %9 sc0 sc1\n\tglobal_load_dwordx4 %1, %8, %10 sc0 sc1\n\tglobal_load_dwordx4 %2, %8, %11 sc0 sc1\n\tglobal_load_dwordx4 %3, %8, %12 sc0 sc1\n\t"
                             "global_load_dwordx4 %4, %8, %13 sc0 sc1\n\tglobal_load_dwordx4 %5, %8, %14 sc0 sc1\n\tglobal_load_dwordx4 %6, %8, %15 sc0 sc1\n\tglobal_load_dwordx4 %7, %8, %16 sc0 sc1\n\ts_waitcnt vmcnt(0)"
                             : "=&v"(t0), "=&v"(t1), "=&v"(t2), "=&v"(t3), "=&v"(t4), "=&v"(t5), "=&v"(t6), "=&v"(t7)
                             : "v"(lo), "s"(gb), "s"(gb + 8192), "s"(gb + 16384), "s"(gb + 24576), "s"(gb + 32768), "s"(gb + 40960), "s"(gb + 49152), "s"(gb + 57344) : "memory");
                acc[ai][bj][0][0] += t0; acc[ai][bj][0][1] += t1; acc[ai][bj][1][0] += t2; acc[ai][bj][1][1] += t3; acc[ai][bj][2][0] += t4; acc[ai][bj][2][1] += t5; acc[ai][bj][3][0] += t6; acc[ai][bj][3][1] += t7; }
        base(acc, u, wr, wc, fr, fq);
    }
};
template <class Base>
struct EpiSplit {
    Base base; float* part; unsigned* flag; bool helper;
    __device__ __forceinline__ void operator()(const Acc& acc, const Unit& u, int wr, int wc, int fr, int fq) const {
        if (helper) EpiPartStore{part, flag}(acc, u, wr, wc, fr, fq); else EpiJoin<Base>{base, part, flag}(acc, u, wr, wc, fr, fq);
    }
};
struct EpiSwiGLU {
    bf16* O; const float* ss;
    __device__ __forceinline__ void operator()(const Acc& acc, const Unit& u, int wr, int wc, int fr, int fq) const {
        const int row0 = u.pm * BM + wr * 64 + fr, col0 = u.pn * HALF + wc * 32 + 8 * fq;
#pragma unroll
        for (int ai = 0; ai < 2; ++ai)
#pragma unroll
            for (int m = 0; m < 4; ++m) { const int row = row0 + ai * HALF + m * 16; const float rs = __builtin_amdgcn_rsqf(ss[row] * (1.0f / D) + RMS_EPS);
                float a[8];
#pragma unroll
                for (int n = 0; n < 2; ++n)
#pragma unroll
                    for (int e = 0; e < 4; ++e) { const float g = acc[ai][0][m][n][e] * rs, up = acc[ai][1][m][n][e] * rs;
                        a[4 * n + e] = g * __builtin_amdgcn_rcpf(1.0f + __builtin_amdgcn_exp2f(-LOG2E * g)) * up; }
                u32x4 w; w.x = cvtpk(a[0], a[1]); w.y = cvtpk(a[2], a[3]); w.z = cvtpk(a[4], a[5]); w.w = cvtpk(a[6], a[7]);
                *(u32x4*)(O + (size_t)row * FF + col0) = w; }
    }
};
__device__ __forceinline__ void rope8(float (&v)[8], const float* cs_row  , int fq) {
    const int f0 = 8 * (fq & 1);
#pragma unroll
    for (int e = 0; e < 8; ++e) { const float other = __shfl_xor(v[e], 32); const float c = cs_row[2 * (f0 + e)], s = cs_row[2 * (f0 + e) + 1];
        v[e] = (fq < 2) ? (v[e] * c - other * s) : (other * s + v[e] * c); }
}
struct EpiMlaIn {
    bf16* P; const float* ss; float* ssq; float* sskv; bf16* KF; const float* cs;
    __device__ __forceinline__ void operator()(const Acc& acc, const Unit& u, int wr, int wc, int fr, int fq) const {
        const int row0 = u.pm * BM + wr * 64 + fr, col0 = u.pn * BM + wc * 32 + 8 * fq;
#pragma unroll
        for (int ai = 0; ai < 2; ++ai)
#pragma unroll
            for (int m = 0; m < 4; ++m) { const int row = row0 + ai * HALF + m * 16; const float rs = __builtin_amdgcn_rsqf(ss[row] * (1.0f / D) + RMS_EPS);
                bf16* rowp = P + (size_t)row * NIN1P + col0;
                if (u.pn < 2) {
                    float sq[2];
#pragma unroll
                    for (int bj = 0; bj < 2; ++bj) { const f32x4 v0 = acc[ai][bj][m][0] * rs, v1 = acc[ai][bj][m][1] * rs;
                        u32x4 w; w.x = cvtpk(v0[0], v0[1]); w.y = cvtpk(v0[2], v0[3]); w.z = cvtpk(v1[0], v1[1]); w.w = cvtpk(v1[2], v1[3]);
                        *(u32x4*)(rowp + bj * HALF) = w;
                        sq[bj] = (v0[0] * v0[0] + v0[1] * v0[1]) + (v0[2] * v0[2] + v0[3] * v0[3]) + (v1[0] * v1[0] + v1[1] * v1[1]) + (v1[2] * v1[2] + v1[3] * v1[3]); }
                    float sa = (u.pn == 0) ? sq[0] + sq[1] : sq[0], sb = (u.pn == 0) ? 0.f : sq[1];
                    sa += __shfl_xor(sa, 16); sa += __shfl_xor(sa, 32); sb += __shfl_xor(sb, 16); sb += __shfl_xor(sb, 32);
                    if (fq == 0) { atomicAdd(ssq + row, sa); if (u.pn == 1) atomicAdd(sskv + row, sb); }
                } else {
                    const u32x4 z = {0u, 0u, 0u, 0u};
                    *(u32x4*)(rowp) = z; *(u32x4*)(rowp + HALF) = z;
                    if (wc == 0) {
                        float v[8];
#pragma unroll
                        for (int n = 0; n < 2; ++n)
#pragma unroll
                            for (int e = 0; e < 4; ++e) v[4 * n + e] = acc[ai][0][m][n][e] * rs;
                        rope8(v, cs + (size_t)row * 32, fq);
                        u32x4 w; w.x = cvtpk(v[0], v[1]); w.y = cvtpk(v[2], v[3]); w.z = cvtpk(v[4], v[5]); w.w = cvtpk(v[6], v[7]);
                        bf16* kp = KF + (size_t)row * KPITCH + 64 + 8 * fq;
#pragma unroll
                        for (int h = 0; h < 16; ++h) *(u32x4*)(kp + h * 96) = w;
                    }
                } }
    }
};
struct EpiMlaQ {
    bf16* Q; const float* ssq; const float* cs;
    __device__ __forceinline__ void operator()(const Acc& acc, const Unit& u, int wr, int wc, int fr, int fq) const {
        const int row0 = u.pm * BM + wr * 64 + fr;
#pragma unroll
        for (int ai = 0; ai < 2; ++ai)
#pragma unroll
            for (int m = 0; m < 4; ++m) { const int row = row0 + ai * HALF + m * 16; const float rs = __builtin_amdgcn_rsqf(ssq[row] * (1.0f / QL) + RMS_EPS);
#pragma unroll
                for (int bj = 0; bj < 2; ++bj) { const int g0 = u.pn * BM + bj * HALF + wc * 32;
                    float v[8];
#pragma unroll
                    for (int n = 0; n < 2; ++n)
#pragma unroll
                        for (int e = 0; e < 4; ++e) v[4 * n + e] = acc[ai][bj][m][n][e] * rs;
                    if ((g0 % 96) == 64) rope8(v, cs + (size_t)row * 32, fq);
                    u32x4 w; w.x = cvtpk(v[0] * C2_MLA, v[1] * C2_MLA); w.y = cvtpk(v[2] * C2_MLA, v[3] * C2_MLA); w.z = cvtpk(v[4] * C2_MLA, v[5] * C2_MLA); w.w = cvtpk(v[6] * C2_MLA, v[7] * C2_MLA);
                    *(u32x4*)(Q + (size_t)row * NQ1 + g0 + 8 * fq) = w; } }
    }
};
struct EpiMlaKV {
    bf16* KF; bf16* V; const float* sskv;
    __device__ __forceinline__ void operator()(const Acc& acc, const Unit& u, int wr, int wc, int fr, int fq) const {
        const int row0 = u.pm * BM + wr * 64 + fr;
#pragma unroll
        for (int ai = 0; ai < 2; ++ai)
#pragma unroll
            for (int m = 0; m < 4; ++m) { const int row = row0 + ai * HALF + m * 16; const float rs = __builtin_amdgcn_rsqf(sskv[row] * (1.0f / KVL) + RMS_EPS);
#pragma unroll
                for (int bj = 0; bj < 2; ++bj) { const int col = u.pn * BM + bj * HALF + wc * 32 + 8 * fq;
                    const f32x4 v0 = acc[ai][bj][m][0] * rs, v1 = acc[ai][bj][m][1] * rs;
                    u32x4 w; w.x = cvtpk(v0[0], v0[1]); w.y = cvtpk(v0[2], v0[3]); w.z = cvtpk(v1[0], v1[1]); w.w = cvtpk(v1[2], v1[3]);
                    bf16* dst = (col < 1024) ? KF + (size_t)row * KPITCH + (col >> 6) * 96 + (col & 63) : V + (size_t)row * D + (col - 1024);
                    *(u32x4*)dst = w; } }
    }
};

template <class Epi, bool ALIGN_EPI>
__device__ __forceinline__ void gemm_phase(LAS unsigned char* lds, const Gemm g, const StaticOrder& S, const Epi& E) {
    const int tid = threadIdx.x, wid = __builtin_amdgcn_readfirstlane(tid >> 6), lane = tid & 63, wr = wid >> 2, wc = wid & 3, fr = lane & 15, fq = lane >> 4;
    const int K = g.K, nt = K / BK, lda = g.lda, ldb = g.ldb ? g.ldb : g.K;
    unsigned voffA[2], voffB[2];
#pragma unroll
    for (int i = 0; i < 2; ++i) { int R, C; stage_rc(tid * 16 + i * 8192, R, C); const int Rb = (R & ~31) + perm32(R & 31);
        voffA[i] = (unsigned)(R * lda + C) * 2u; voffB[i] = (unsigned)(Rb * ldb + C) * 2u; }
    const size_t kstep = (size_t)(BK * 2);
    const size_t hsA = (size_t)HALF * lda * 2, hsB = (size_t)HALF * ldb * 2, tsA = 2 * hsA, tsB = 2 * hsB;
    const unsigned ldsw = (unsigned)wid * 1024u;
    const int aoff = lds_byte(wr * 64 + fr, fq * 8), boff = lds_byte(wc * 32 + fr, fq * 8);
#define PG8_SA(b, h) (((b) * 2 + (h)) * HTB)
#define PG8_SB(b, h) ((4 + (b) * 2 + (h)) * HTB)
#define PG8_STAGE(bufoff, gbase, voff) do { _Pragma("unroll") for (int _i = 0; _i < 2; ++_i) \
        __builtin_amdgcn_global_load_lds((const unsigned*)((const char*)(gbase) + (voff)[_i]), (LAS unsigned*)(lds + (bufoff) + ldsw + _i * 8192), 16, 0, 0); } while (0)
#define PG8_LDA(dst, b, h) do { _Pragma("unroll") for (int m = 0; m < 4; ++m) _Pragma("unroll") for (int k = 0; k < 2; ++k) dst[m][k] = *(const LAS bf16x8*)(lds + PG8_SA(b, h) + aoff + m * 2048 + k * 1024); } while (0)
#define PG8_LDB(dst, b, h) do { _Pragma("unroll") for (int n = 0; n < 2; ++n) _Pragma("unroll") for (int k = 0; k < 2; ++k) dst[n][k] = *(const LAS bf16x8*)(lds + PG8_SB(b, h) + boff + n * 2048 + k * 1024); } while (0)
#define PG8_MMA(ai, bj, At, Bt) do { __builtin_amdgcn_s_setprio(1); _Pragma("unroll") for (int m = 0; m < 4; ++m) _Pragma("unroll") for (int n = 0; n < 2; ++n) _Pragma("unroll") for (int k = 0; k < 2; ++k) \
        acc[ai][bj][m][n] = __builtin_amdgcn_mfma_f32_16x16x32_bf16(Bt[n][k], At[m][k], acc[ai][bj][m][n], 0, 0, 0); __builtin_amdgcn_s_setprio(0); } while (0)
#define PG8_WAIT_V(n) asm volatile("s_waitcnt vmcnt(" #n ")" ::: "memory")
#define PG8_WAIT_L(n) asm volatile("s_waitcnt lgkmcnt(" #n ")" ::: "memory")
#define PG8_BAR __builtin_amdgcn_s_barrier()
#define PG8_SCHED __builtin_amdgcn_sched_barrier(0)
    Unit cur, nxt; int ui = 0;
    if (!S.next(0, cur)) return;
    Acc acc;
#pragma unroll
    for (int a = 0; a < 2; ++a)
#pragma unroll
        for (int b = 0; b < 2; ++b)
#pragma unroll
            for (int m = 0; m < 4; ++m)
#pragma unroll
                for (int n = 0; n < 2; ++n) acc[a][b][m][n] = (f32x4){0.f, 0.f, 0.f, 0.f};
    bf16x8 At[4][2], B0[2][2], B1[2][2];
    const char* cA = (const char*)g.A + (size_t)cur.pm * tsA; const char* cB = (const char*)g.Bt + (size_t)cur.pn * tsB;
    PG8_STAGE(PG8_SB(0, 0), cB, voffB); PG8_STAGE(PG8_SB(0, 1), cB + hsB, voffB); PG8_STAGE(PG8_SA(0, 0), cA, voffA); PG8_STAGE(PG8_SA(0, 1), cA + hsA, voffA);
    if (wr == 1) PG8_BAR;
    PG8_WAIT_V(2); PG8_BAR;
    PG8_STAGE(PG8_SB(1, 0), cB + kstep, voffB); PG8_STAGE(PG8_SA(1, 0), cA + kstep, voffA); PG8_STAGE(PG8_SB(1, 1), cB + hsB + kstep, voffB);
    PG8_WAIT_V(6); PG8_BAR;
    for (;;) {
        const bool has_next = S.next(ui + 1, nxt);
        const char* nA = has_next ? (const char*)g.A + (size_t)nxt.pm * tsA : cA; const char* nB = has_next ? (const char*)g.Bt + (size_t)nxt.pn * tsB : cB;
#pragma unroll 1
        for (int t = 0; t < nt; t += 2) {
            const bool last = (t == nt - 2);
            const char* a1 = cA + (size_t)(t + 1) * kstep;
            const char* a2 = last ? nA : cA + (size_t)(t + 2) * kstep; const char* b2 = last ? nB : cB + (size_t)(t + 2) * kstep;
            const char* a3 = a2 + kstep; const char* b3 = b2 + kstep;
            PG8_LDB(B0, 0, 0); PG8_LDB(B1, 0, 1); PG8_SCHED; PG8_LDA(At, 0, 0); PG8_STAGE(PG8_SA(1, 1), a1 + hsA, voffA);
            PG8_WAIT_V(8); PG8_WAIT_L(0); PG8_BAR; PG8_MMA(0, 0, At, B0); PG8_MMA(0, 1, At, B1); PG8_BAR; PG8_SCHED;
            PG8_LDA(At, 0, 1); PG8_STAGE(PG8_SB(0, 0), b2, voffB); PG8_STAGE(PG8_SB(0, 1), b2 + hsB, voffB); PG8_STAGE(PG8_SA(0, 0), a2, voffA);
            PG8_WAIT_V(8); PG8_WAIT_L(0); PG8_BAR; PG8_MMA(1, 0, At, B0); PG8_MMA(1, 1, At, B1); PG8_BAR; PG8_SCHED;
            PG8_LDB(B0, 1, 0); PG8_LDB(B1, 1, 1); PG8_SCHED; PG8_LDA(At, 1, 0); PG8_STAGE(PG8_SA(0, 1), a2 + hsA, voffA);
            PG8_WAIT_V(8); PG8_WAIT_L(0); PG8_BAR; PG8_MMA(0, 0, At, B0); PG8_MMA(0, 1, At, B1); PG8_BAR; PG8_SCHED;
            PG8_LDA(At, 1, 1); PG8_STAGE(PG8_SB(1, 0), b3, voffB); PG8_STAGE(PG8_SB(1, 1), b3 + hsB, voffB); PG8_STAGE(PG8_SA(1, 0), a3, voffA);
            PG8_WAIT_V(8); PG8_WAIT_L(0); PG8_BAR; PG8_MMA(1, 0, At, B0); PG8_MMA(1, 1, At, B1); PG8_BAR; PG8_SCHED;
        }
        if constexpr (ALIGN_EPI) { if (wr == 0) PG8_BAR; }
        E(acc, cur, wr, wc, fr, fq);
        if (!has_next) break;
#pragma unroll
        for (int a = 0; a < 2; ++a)
#pragma unroll
            for (int b = 0; b < 2; ++b)
#pragma unroll
                for (int m = 0; m < 4; ++m)
#pragma unroll
                    for (int n = 0; n < 2; ++n) acc[a][b][m][n] = (f32x4){0.f, 0.f, 0.f, 0.f};
        cur = nxt; cA = nA; cB = nB; ++ui;
        if constexpr (ALIGN_EPI) { if (wr == 1) PG8_BAR; }
    }
    PG8_WAIT_V(0);
    if constexpr (!ALIGN_EPI) { if (wr == 0) PG8_BAR; }
    PG8_BAR;
#undef PG8_SA
#undef PG8_SB
#undef PG8_STAGE
#undef PG8_LDA
#undef PG8_LDB
#undef PG8_MMA
#undef PG8_WAIT_V
#undef PG8_WAIT_L
#undef PG8_BAR
#undef PG8_SCHED
}
}

typedef GAS unsigned gu32;
#define RLX_AGENT __ATOMIC_RELAXED, __HIP_MEMORY_SCOPE_AGENT
#define LDS_WAIT() asm volatile("s_waitcnt lgkmcnt(0)" ::: "memory")
#define VM_WAIT() asm volatile("s_waitcnt vmcnt(0)" ::: "memory")
#define XB_TMO      128
#define XB_XCNT(j)  (256  + 64 * (j))
#define XB_XSUB(j)  (1280 + 64 * (j))
#define XB_XGEN(j)  (2304 + 64 * (j))
#define XB_TOP      3328
#define XB_TOPGEN   3392
#define XCD_BAR_WORDS 3456
#define XB_SPIN_CAP (1u << 18)
__device__ __forceinline__ unsigned xb_ld(unsigned* p)              { return __hip_atomic_load(p, __ATOMIC_RELAXED, __HIP_MEMORY_SCOPE_AGENT); }
__device__ __forceinline__ unsigned xb_add(unsigned* p, unsigned v) { return __hip_atomic_fetch_add(p, v, __ATOMIC_RELAXED, __HIP_MEMORY_SCOPE_AGENT); }
__device__ __forceinline__ unsigned xb_xcc_id() { return (unsigned)__builtin_amdgcn_s_getreg((3 << 11) | 20) & 0xFu; }
#define XB_SPIN(cond, bar) do { unsigned _sp = 0; while (cond) { __builtin_amdgcn_s_sleep(1); \
    if ((++_sp & 255u) == 0u) { if (xb_ld(&(bar)[XB_TMO])) break; if (_sp > XB_SPIN_CAP) { atomicAdd(&(bar)[XB_TMO], 1u); break; } } } } while (0)
struct XcdBarrier { unsigned* bar; unsigned x; volatile LAS unsigned* st; };
__device__ __forceinline__ XcdBarrier xcd_barrier_post(unsigned* bar, volatile LAS unsigned* st) {
    XcdBarrier b; b.bar = bar; b.x = xb_xcc_id(); b.st = st;
    if (threadIdx.x == 0) (void)xb_add(&bar[XB_XCNT(b.x)], 1u);
    return b;
}
__device__ __forceinline__ void xcd_barrier_complete(unsigned* bar, unsigned x, unsigned& nloc, unsigned& nx) {
    const unsigned G = gridDim.x * gridDim.y * gridDim.z;
    unsigned sum, cnt, mine, sp = 0u;
    for (;;) {
        sum = 0u; cnt = 0u; mine = 0u;
#pragma unroll
        for (unsigned j = 0; j < 16; ++j) { const unsigned c = xb_ld(&bar[XB_XCNT(j)]); sum += c; cnt += (c > 0u) ? 1u : 0u; mine = (j == x) ? c : mine; }
        if (sum == G) break;
        __builtin_amdgcn_s_sleep(1);
        if ((++sp & 255u) == 0u) { if (xb_ld(&bar[XB_TMO])) break; if (sp > XB_SPIN_CAP) { atomicAdd(&bar[XB_TMO], 1u); break; } }
    }
    nloc = mine > 0u ? mine : 1u; nx = cnt > 0u ? cnt : 1u;
}
__device__ __forceinline__ void xcd_barrier(const XcdBarrier& b) {
    asm volatile("s_waitcnt vmcnt(0)" ::: "memory");
    __syncthreads();
    if (threadIdx.x == 0) {
        unsigned* bar = b.bar;
        __builtin_amdgcn_s_waitcnt(0);
        unsigned nloc = b.st[0], nx = b.st[1];
        if (nloc == 0u) { xcd_barrier_complete(bar, b.x, nloc, nx); b.st[0] = nloc; b.st[1] = nx; }
        const unsigned old = xb_add(&bar[XB_XSUB(b.x)], 1u);
        const unsigned gen = old / nloc;
        if (old + 1u == (gen + 1u) * nloc) {
            __builtin_amdgcn_fence(__ATOMIC_RELEASE, "agent");
            asm volatile("s_waitcnt vmcnt(0)" ::: "memory");
            const unsigned og = xb_add(&bar[XB_TOP], 1u);
            const unsigned tg = og / nx;
            if (og + 1u == (tg + 1u) * nx) xb_add(&bar[XB_TOPGEN], 1u);
            else XB_SPIN(xb_ld(&bar[XB_TOPGEN]) == tg, bar);
            __builtin_amdgcn_fence(__ATOMIC_ACQUIRE, "agent");
            xb_add(&bar[XB_XGEN(b.x)], 1u);
            asm volatile("s_waitcnt vmcnt(0)" ::: "memory");
        } else {
            XB_SPIN(xb_ld(&bar[XB_XGEN(b.x)]) == gen, bar);
            __builtin_amdgcn_fence(__ATOMIC_ACQUIRE, "agent");
            asm volatile("s_waitcnt vmcnt(0)" ::: "memory");
        }
    }
    __syncthreads();
}

__device__ __forceinline__ int t5_bucket(int rel) {
    const int n = rel < 0 ? -rel : rel;
    const float nf = (float)(n > 8 ? n : 8);
    int large = 8 + (int)(__logf(nf / 8.0f) / 4.852030263919617f * 8.0f);
    large = large < 15 ? large : 15;
    return (rel > 0 ? 16 : 0) + (n < 8 ? n : large);
}
__device__ __forceinline__ int t5_bucket_precise(int rel) {
    const int n = rel < 0 ? -rel : rel;
    const float nf = (float)(n > 8 ? n : 8);
    int large = 8 + (int)(logf(nf / 8.0f) / 4.852030263919617f * 8.0f);
    large = large < 15 ? large : 15;
    return (rel > 0 ? 16 : 0) + (n < 8 ? n : large);
}

struct Args {
    const float* in[18];
    float* out; unsigned char* ws;
    int ph_lo, ph_hi;
};
enum { I_X = 0, I_T5, I_ANORM, I_FNORM, I_EWIN, I_RPB, I_EWOUT, I_OWIN, I_QNORM, I_WUQ, I_KVNORM, I_WUK, I_WUV, I_OWOUT, I_WG, I_WU, I_WD, I_FINAL };
constexpr int NPH = 13;

__device__ __forceinline__ void p0_transpose_item(const float* W, int N, const float* gain, bf16* WT, int ldk, int dst_row0, int k0, int n0, LAS float* scr, int lane) {
    float v[32], gk[32];
#pragma unroll
    for (int i = 0; i < 32; ++i) { const int kk = 2 * i + (lane >> 5); v[i] = __builtin_nontemporal_load(W + (size_t)(k0 + kk) * N + n0 + (lane & 31)); gk[i] = gain ? gain[k0 + kk] : 1.0f; }
#pragma unroll
    for (int i = 0; i < 32; ++i) { const int kk = 2 * i + (lane >> 5); scr[kk * 33 + (lane & 31)] = v[i] * gk[i]; }
    LDS_WAIT(); asm volatile("" ::: "memory");
    const int c = lane & 7;
#pragma unroll
    for (int j = 0; j < 4; ++j) { const int n = (lane >> 3) + 8 * j; const LAS float* s = scr + (8 * c) * 33 + n;
        u32x4 o; o.x = cvtpk(s[0 * 33], s[1 * 33]); o.y = cvtpk(s[2 * 33], s[3 * 33]); o.z = cvtpk(s[4 * 33], s[5 * 33]); o.w = cvtpk(s[6 * 33], s[7 * 33]);
        *(u32x4*)(WT + (size_t)(dst_row0 + n) * ldk + k0 + 8 * c) = o; }
    LDS_WAIT(); asm volatile("" ::: "memory");
}
template <int MODE>
__device__ __forceinline__ bool p0_matrix(int& r, const float* W, int K, int N, const float* gain, bf16* WT, int ldk, int row_off, LAS float* scr, int lane) {
    const int nblk = N / 32, items = (K / 64) * nblk;
    if (r >= items) { r -= items; return false; }
    const int kb = r / nblk, nb = r % nblk, n0 = 32 * nb;
    int dr = row_off + n0;
    if (MODE != 0) dr = (n0 >> 7) * 256 + (n0 & 127) + (MODE == 2 ? 128 : 0);
    p0_transpose_item(W, N, gain, WT, ldk, dr, 64 * kb, n0, scr, lane);
    return true;
}

__device__ __forceinline__ const char* mla_sgpr_ptr(const char* p) { const unsigned long long b = (unsigned long long)p; const unsigned lo = __builtin_amdgcn_readfirstlane((unsigned)b), hi = __builtin_amdgcn_readfirstlane((unsigned)(b >> 32)); return (const char*)(((unsigned long long)hi << 32) | lo); }

namespace wattn {
__device__ __forceinline__ int crow(int r, int hi) { return (r & 3) + 8 * (r >> 2) + 4 * hi; }
typedef short v4i16_t __attribute__((ext_vector_type(4)));
__device__ __forceinline__ s16x4 vtr(const LAS unsigned char* p) { return __builtin_bit_cast(s16x4, __builtin_amdgcn_ds_read_tr16_b64_v4i16((LAS v4i16_t*)p)); }
constexpr int WREG = 16384;

template <bool SAFE, class F>
__device__ __forceinline__ bool run_unit(const F& f, const bf16* __restrict__ Qrow  , const char* __restrict__ Kbase  ,
                                         bf16* __restrict__ Orow  , LAS unsigned char* wl, int lane) {
    constexpr int ND = 4, PITCHB = NQKV * 2, TB = 8192;
    const int r32 = lane & 31, hi = lane >> 5;
    bf16x8 qf[ND];
#pragma unroll
    for (int d0 = 0; d0 < ND; ++d0) qf[d0] = *(const bf16x8*)(Qrow + 16 * d0 + 8 * hi);
    float m = NEGB, l = 0.f; f32x16 ot[2];
#pragma unroll
    for (int r = 0; r < 16; ++r) { ot[0][r] = 0.f; ot[1][r] = 0.f; }
    const int nt = f.ntiles();
    const int kg = lane >> 3, sl = lane & 7, kgv = (lane >> 2) & 7;
    const unsigned kce = (unsigned)((sl ^ (kg >> 1)) * 16), kco = kce ^ 64u;
    const unsigned vco = (unsigned)(1024 + (lane >> 5) * 64 + (lane & 3) * 16);
    const char* const Kb = mla_sgpr_ptr(Kbase);
    auto dma_tile = [&](int t, int bo) {
        LAS unsigned char* kd = wl + bo; LAS unsigned char* vd = wl + bo + 4096;
        int tb_, st_;
        if (f.affine(t, tb_, st_)) {
            const char* kt = mla_sgpr_ptr(Kbase + (size_t)tb_ * PITCHB);
            const unsigned rowk = (unsigned)(kg * st_ * PITCHB), rowv = (unsigned)(kgv * st_ * PITCHB) + vco; const unsigned stepb = (unsigned)(8 * st_ * PITCHB);
#pragma unroll
            for (int i = 0; i < 4; ++i) { const char* p = kt + (size_t)(i * stepb);
                __builtin_amdgcn_global_load_lds((const unsigned*)(p + (rowk + ((i & 1) ? kco : kce))), (LAS unsigned*)(kd + i * 1024), 16, 0, 0);
                __builtin_amdgcn_global_load_lds((const unsigned*)(p + rowv), (LAS unsigned*)(vd + i * 1024), 16, 0, 0); }
        } else {
#pragma unroll
            for (int i = 0; i < 4; ++i) { const unsigned offk = (unsigned)f.tok(t, kg + 8 * i) * (unsigned)PITCHB + ((i & 1) ? kco : kce), offv = (unsigned)f.tok(t, kgv + 8 * i) * (unsigned)PITCHB + vco;
                __builtin_amdgcn_global_load_lds((const unsigned*)(Kb + offk), (LAS unsigned*)(kd + i * 1024), 16, 0, 0);
                __builtin_amdgcn_global_load_lds((const unsigned*)(Kb + offv), (LAS unsigned*)(vd + i * 1024), 16, 0, 0); }
        }
    };
    const LAS unsigned char* kp[ND];
#pragma unroll
    for (int d0 = 0; d0 < ND; ++d0) kp[d0] = wl + r32 * 128 + (((2 * d0 + hi) ^ ((r32 >> 1) & 7)) * 16);
    const LAS unsigned char* vbase = wl + 4096 + (4 * hi + ((lane & 15) >> 2)) * 64 + ((lane >> 4) & 1) * 32 + (lane & 3) * 8;
    dma_tile(0, 0);
    if (nt > 1) dma_tile(1, TB);
    auto body = [&](int t, int bo) {
        if (t + 1 < nt) asm volatile("s_waitcnt vmcnt(8)" ::: "memory"); else asm volatile("s_waitcnt vmcnt(0)" ::: "memory");
        const int tc = f.cls(t);
        if (tc != 2) {
        float bb[16];
        f.bias16(t, hi, r32, bb, tc == 1);
        f32x16 s;
#pragma unroll
        for (int r = 0; r < 16; ++r) s[r] = bb[r];
#pragma unroll
        for (int d0 = 0; d0 < ND; ++d0) { const bf16x8 kf = *(const LAS bf16x8*)(kp[d0] + bo); s = __builtin_amdgcn_mfma_f32_32x32x16_bf16(kf, qf[d0], s, 0, 0, 0); }
        float ps = 0.f;
        if (SAFE) {
            float mx = NEGB;
#pragma unroll
            for (int r = 0; r < 16; ++r) mx = fmaxf(mx, s[r]);
            mx = fmaxf(mx, __shfl_xor(mx, 32));
            const float mnew = fmaxf(m, mx), alpha = __builtin_amdgcn_exp2f(m - mnew);
            m = mnew;
#pragma unroll
            for (int r = 0; r < 16; ++r) { s[r] = __builtin_amdgcn_exp2f(s[r] - mnew); ps += s[r]; }
            l = l * alpha + ps;
#pragma unroll
            for (int r = 0; r < 16; ++r) { ot[0][r] *= alpha; ot[1][r] *= alpha; }
        } else {
#pragma unroll
            for (int r = 0; r < 16; ++r) s[r] = __builtin_amdgcn_exp2f(s[r]);
            l += ((s[0] + s[1]) + (s[2] + s[3])) + ((s[4] + s[5]) + (s[6] + s[7])) + (((s[8] + s[9]) + (s[10] + s[11])) + ((s[12] + s[13]) + (s[14] + s[15])));
        }
        u32x4 pw[2];
#pragma unroll
        for (int ks = 0; ks < 2; ++ks) { pw[ks].x = cvtpk(s[8 * ks + 0], s[8 * ks + 1]); pw[ks].y = cvtpk(s[8 * ks + 2], s[8 * ks + 3]); pw[ks].z = cvtpk(s[8 * ks + 4], s[8 * ks + 5]); pw[ks].w = cvtpk(s[8 * ks + 6], s[8 * ks + 7]); }
#pragma unroll
        for (int db = 0; db < 2; ++db)
#pragma unroll
            for (int ks = 0; ks < 2; ++ks) {
                const s16x4 lo = vtr(vbase + bo + ks * 2048 + db * 512), hh = vtr(vbase + bo + ks * 2048 + 1024 + db * 512);
                const bf16x8 vf = (bf16x8){lo[0], lo[1], lo[2], lo[3], hh[0], hh[1], hh[2], hh[3]};
                ot[db] = __builtin_amdgcn_mfma_f32_32x32x16_bf16(vf, __builtin_bit_cast(bf16x8, pw[ks]), ot[db], 0, 0, 0);
            }
        }
        if (t + 2 < nt) {
            __builtin_amdgcn_sched_barrier(0);
            asm volatile("s_waitcnt lgkmcnt(0)" ::: "memory");
            dma_tile(t + 2, bo);
            asm volatile("" ::: "memory");
        }
    };
#pragma unroll 1
    for (int t = 0; t < nt; t += 2) { body(t, 0); if (t + 1 < nt) body(t + 1, TB); }
    l += __shfl_xor(l, 32);
    if (!SAFE && __any(!(l > 1.0e-30f && l < 1.0e37f))) return false;
    const float inv = 1.0f / l;
#pragma unroll
    for (int db = 0; db < 2; ++db)
#pragma unroll
        for (int g = 0; g < 4; ++g) { u32x2 w; w.x = cvtpk(ot[db][4 * g] * inv, ot[db][4 * g + 1] * inv); w.y = cvtpk(ot[db][4 * g + 2] * inv, ot[db][4 * g + 3] * inv);
            *(u32x2*)(Orow + 32 * db + 8 * g + 4 * hi) = w; }
    return true;
}

struct DilF {
    int t0, w; bool edge; const LAS float* tbl;
    __device__ __forceinline__ int ntiles() const { return 23; }
    __device__ __forceinline__ int tok_raw(int t, int j) const {
        if (t < 8) return t0 - 64 + 32 * t + j;
        const int ii = (t - 8) * 32 + j, e = ii < 240 ? ii - 256 : ii - 192;
        return t0 + w + 4 * e;
    }
    __device__ __forceinline__ int tok(int t, int j) const { int u = tok_raw(t, j); u = u < 0 ? 0 : u; return u > S - 1 ? S - 1 : u; }
    __device__ __forceinline__ bool affine(int t, int& base, int& step) const {
        if (t < 8) { base = t0 - 64 + 32 * t; step = 1; }
        else { if (t == 15) return false; base = t0 + w + 4 * ((t - 8) * 32 - (t < 15 ? 256 : 192)); step = 4; }
        return !(edge && (base < 0 || base + 31 * step >= S));
    }
    __device__ __forceinline__ float bias(int t, int r, int hi, int r32) const {
        const int u = tok_raw(t, crow(r, hi)), d = u - (t0 + w + 4 * r32);
        float b = tbl[((d + 1152) & 3) * 592 + ((d + 1152) >> 2)];
        if (edge && (u < 0 || u >= S)) b = NEGB;
        return b;
    }
    __device__ __forceinline__ int cls(int t) const {
        if (!edge) return 0;
        if (t == 15) return 1;
        const int lo = t < 8 ? t0 - 64 + 32 * t : t0 + w + 4 * ((t - 8) * 32 - (t < 15 ? 256 : 192)), hi_ = t < 8 ? lo + 31 : lo + 124;
        return (hi_ < 0 || lo >= S) ? 2 : ((lo >= 0 && hi_ < S) ? 0 : 1);
    }
    __device__ __forceinline__ void bias16(int t, int hi, int r32, float (&b)[16], const bool slow) const {
        if (slow) {
#pragma unroll
            for (int r = 0; r < 16; ++r) b[r] = bias(t, r, hi, r32);
        } else if (t < 8) {
            const LAS float* lb = tbl + (272 - r32 + hi + 8 * t);
#pragma unroll
            for (int j = 0; j < 4; ++j) { const LAS float* tp = lb + (((j - w) & 3) * 592 - (j < w ? 1 : 0));
#pragma unroll
                for (int c = 0; c < 4; ++c) b[4 * c + j] = tp[2 * c]; }
        } else {
            const LAS float* tp = tbl + (288 - r32 + 4 * hi + 32 * (t - 8) - (t > 15 ? 192 : 256));
            if (t == 15) {
#pragma unroll
                for (int r = 0; r < 16; ++r) b[r] = tp[(r & 3) + 8 * (r >> 2) + (r >= 8 ? 64 : 0)];
            } else {
#pragma unroll
                for (int r = 0; r < 16; ++r) b[r] = tp[(r & 3) + 8 * (r >> 2)];
            }
        }
    }
};
struct NaF {
    int r0, gr, jw; const LAS float* rpb;
    __device__ __forceinline__ int ntiles() const { return 16; }
    __device__ __forceinline__ int tok(int t, int j) const { return (r0 + (t >> 1)) * 64 + 32 * (t & 1) + j; }
    __device__ __forceinline__ bool affine(int t, int& base, int& step) const { base = (r0 + (t >> 1)) * 64 + 32 * (t & 1); step = 1; return true; }
    __device__ __forceinline__ int cls(int) const { return 0; }
    __device__ __forceinline__ void bias16(int t, int hi, int r32, float (&b)[16], const bool = false) const {
        const int c = 32 * jw + r32; int c0 = c - 8; c0 = c0 < 0 ? 0 : (c0 > 48 ? 48 : c0);
        const int kc0 = 32 * (t & 1) + 4 * hi;
        const LAS float* tp = rpb + ((r0 + (t >> 1) - gr + 7) * 31 + kc0 - c + 15);
        const int rel = kc0 - c0;
#pragma unroll
        for (int r = 0; r < 16; ++r) { const int o = (r & 3) + 8 * (r >> 2); b[r] = ((unsigned)(rel + o) < 16u) ? tp[o] : NEGB; }
    }
};
constexpr int NA_NS = 4, NA_SLOT = 16384, NA_FLAG = NA_NS * NA_SLOT;
template <bool SAFE>
__device__ __forceinline__ bool na_coop(int gr0, const bf16* __restrict__ Qb  , const char* __restrict__ Kbase  , bf16* __restrict__ Ob,
                                        const LAS float* rpb, LAS unsigned char* lds, int wave, int lane) {
    constexpr int ND = 4, PITCHB = NQKV * 2;
    const int r32 = lane & 31, hi = lane >> 5, g = wave >> 1, jw = wave & 1, gr = gr0 + g;
    int r0 = gr - 4; r0 = r0 < 0 ? 0 : (r0 > 248 ? 248 : r0);
    int rmin = gr0 - 4; rmin = rmin < 0 ? 0 : (rmin > 248 ? 248 : rmin);
    int rl = gr0 - 1; rl = rl < 0 ? 0 : (rl > 248 ? 248 : rl);
    const int NR = rl + 8 - rmin;
    const NaF f{r0, gr, jw, rpb};
    const int tq = gr * 64 + 32 * jw + r32;
    const bf16* Qrow = Qb + (size_t)tq * NQKV; bf16* Orow = Ob + (size_t)tq * D;
    bf16x8 qf[ND];
#pragma unroll
    for (int d0 = 0; d0 < ND; ++d0) qf[d0] = *(const bf16x8*)(Qrow + 16 * d0 + 8 * hi);
    float m = NEGB, l = 0.f; f32x16 ot[2];
#pragma unroll
    for (int r = 0; r < 16; ++r) { ot[0][r] = 0.f; ot[1][r] = 0.f; }
    const int kg = lane >> 3, sl = lane & 7, kgv = (lane >> 2) & 7, ph = wave >> 2, pi = wave & 3;
    const unsigned offk = (unsigned)((32 * ph + 8 * pi + kg) * PITCHB) + (unsigned)((((sl ^ (kg >> 1)) * 16) ^ ((pi & 1) ? 64 : 0)));
    const unsigned offv = (unsigned)((32 * ph + 8 * pi + kgv) * PITCHB) + (unsigned)(1024 + (lane >> 5) * 64 + (lane & 3) * 16);
    auto stage = [&](int k) {
        const char* rb = mla_sgpr_ptr(Kbase + (size_t)(rmin + k) * (64 * PITCHB));
        LAS unsigned char* sb = lds + (k & (NA_NS - 1)) * NA_SLOT + ph * 8192 + pi * 1024;
        __builtin_amdgcn_global_load_lds((const unsigned*)(rb + offk), (LAS unsigned*)sb, 16, 0, 0);
        __builtin_amdgcn_global_load_lds((const unsigned*)(rb + offv), (LAS unsigned*)(sb + 4096), 16, 0, 0);
    };
    __syncthreads();
    stage(0); stage(1); stage(2);
    unsigned kp[ND];
#pragma unroll
    for (int d0 = 0; d0 < ND; ++d0) kp[d0] = (unsigned)(r32 * 128 + (((2 * d0 + hi) ^ ((r32 >> 1) & 7)) * 16));
    const unsigned vb = (unsigned)(4096 + (4 * hi + ((lane & 15) >> 2)) * 64 + ((lane >> 4) & 1) * 32 + (lane & 3) * 8);
    auto tile = [&](int t, LAS unsigned char* tb) {
        float bb[16];
        f.bias16(t, hi, r32, bb);
        f32x16 s;
#pragma unroll
        for (int r = 0; r < 16; ++r) s[r] = bb[r];
#pragma unroll
        for (int d0 = 0; d0 < ND; ++d0) { const bf16x8 kf = *(const LAS bf16x8*)(tb + kp[d0]); s = __builtin_amdgcn_mfma_f32_32x32x16_bf16(kf, qf[d0], s, 0, 0, 0); }
        float ps = 0.f;
        if (SAFE) {
            float mx = NEGB;
#pragma unroll
            for (int r = 0; r < 16; ++r) mx = fmaxf(mx, s[r]);
            mx = fmaxf(mx, __shfl_xor(mx, 32));
            const float mnew = fmaxf(m, mx), alpha = __builtin_amdgcn_exp2f(m - mnew);
            m = mnew;
#pragma unroll
            for (int r = 0; r < 16; ++r) { s[r] = __builtin_amdgcn_exp2f(s[r] - mnew); ps += s[r]; }
            l = l * alpha + ps;
#pragma unroll
            for (int r = 0; r < 16; ++r) { ot[0][r] *= alpha; ot[1][r] *= alpha; }
        } else {
#pragma unroll
            for (int r = 0; r < 16; ++r) s[r] = __builtin_amdgcn_exp2f(s[r]);
            l += ((s[0] + s[1]) + (s[2] + s[3])) + ((s[4] + s[5]) + (s[6] + s[7])) + (((s[8] + s[9]) + (s[10] + s[11])) + ((s[12] + s[13]) + (s[14] + s[15])));
        }
        u32x4 pw[2];
#pragma unroll
        for (int ks = 0; ks < 2; ++ks) { pw[ks].x = cvtpk(s[8 * ks + 0], s[8 * ks + 1]); pw[ks].y = cvtpk(s[8 * ks + 2], s[8 * ks + 3]); pw[ks].z = cvtpk(s[8 * ks + 4], s[8 * ks + 5]); pw[ks].w = cvtpk(s[8 * ks + 6], s[8 * ks + 7]); }
#pragma unroll
        for (int db = 0; db < 2; ++db)
#pragma unroll
            for (int ks = 0; ks < 2; ++ks) {
                const s16x4 lo = vtr(tb + vb + ks * 2048 + db * 512), hh = vtr(tb + vb + ks * 2048 + 1024 + db * 512);
                const bf16x8 vf = (bf16x8){lo[0], lo[1], lo[2], lo[3], hh[0], hh[1], hh[2], hh[3]};
                ot[db] = __builtin_amdgcn_mfma_f32_32x32x16_bf16(vf, __builtin_bit_cast(bf16x8, pw[ks]), ot[db], 0, 0, 0);
            }
    };
#pragma unroll 1
    for (int k = 0; k < NR; ++k) {
        const int newer = (k + 2 < NR ? k + 2 : NR - 1) - k;
        if (newer == 2) asm volatile("s_waitcnt vmcnt(4) lgkmcnt(0)" ::: "memory"); else if (newer == 1) asm volatile("s_waitcnt vmcnt(2) lgkmcnt(0)" ::: "memory"); else asm volatile("s_waitcnt vmcnt(0) lgkmcnt(0)" ::: "memory");
        __builtin_amdgcn_s_barrier();
        asm volatile("" ::: "memory");
        if (k + 3 < NR) stage(k + 3);
        const int tr = rmin + k - r0;
        if (tr >= 0 && tr < 8) {
            LAS unsigned char* sb = lds + (k & (NA_NS - 1)) * NA_SLOT;
            tile(2 * tr, sb); tile(2 * tr + 1, sb + 8192);
        }
    }
    l += __shfl_xor(l, 32);
    bool ok = true;
    if (!SAFE) {
        LAS unsigned* fl = (LAS unsigned*)(lds + NA_FLAG);
        const bool bad = __any(!(l > 1.0e-30f && l < 1.0e37f));
        if (lane == 0) fl[wave] = bad ? 1u : 0u;
        __syncthreads();
        unsigned any = 0;
#pragma unroll
        for (int w = 0; w < 8; ++w) any |= fl[w];
        ok = (__builtin_amdgcn_readfirstlane(any) == 0u);
        if (!ok) return false;
    }
    const float inv = 1.0f / l;
#pragma unroll
    for (int db = 0; db < 2; ++db)
#pragma unroll
        for (int gq = 0; gq < 4; ++gq) { u32x2 w; w.x = cvtpk(ot[db][4 * gq] * inv, ot[db][4 * gq + 1] * inv); w.y = cvtpk(ot[db][4 * gq + 2] * inv, ot[db][4 * gq + 3] * inv);
            *(u32x2*)(Orow + 32 * db + 8 * gq + 4 * hi) = w; }
    return true;
}
struct MlaF {
    int tq0; const LAS float* tbl;
    __device__ __forceinline__ int ntiles() const { return S / 32; }
    __device__ __forceinline__ int tok(int t, int j) const { return 32 * t + j; }
    __device__ __forceinline__ float bias(int t, int r, int hi, int r32) const {
        int d = 32 * t + crow(r, hi) - (tq0 + r32); d = d < -600 ? -600 : (d > 600 ? 600 : d);
        return tbl[d + 600];
    }
};
}


namespace mla {
using wattn::crow; using wattn::vtr;
constexpr int NSLOT = 4, KSLOT = 12288, VSLOT = 8192, L_K = 0, L_V = NSLOT * KSLOT, L_TBL = L_V + NSLOT * VSLOT, L_FLAG = L_TBL + 7936, L_OST = L_TBL + 8192, L_END = L_OST + 8 * 4096;
constexpr int NT = S / 64;
constexpr float THR = 8.0f;
#define MLA_WAITBAR() do { asm volatile("s_waitcnt vmcnt(0) lgkmcnt(0)" ::: "memory"); __builtin_amdgcn_s_barrier(); asm volatile("" ::: "memory"); } while (0)
#define MLA_WAITBAR_N(n) do { asm volatile("s_waitcnt vmcnt(" #n ") lgkmcnt(0)" ::: "memory"); __builtin_amdgcn_s_barrier(); asm volatile("" ::: "memory"); } while (0)
#define MLA_BAR() do { asm volatile("s_waitcnt lgkmcnt(0)" ::: "memory"); __builtin_amdgcn_s_barrier(); asm volatile("" ::: "memory"); } while (0)
#define MLA_SB() __builtin_amdgcn_sched_barrier(0)
__device__ __forceinline__ float max3f(float a, float b, float c) { float r; asm("v_max3_f32 %0, %1, %2, %3" : "=v"(r) : "v"(a), "v"(b), "v"(c)); return r; }
__device__ __forceinline__ const char* sgpr_ptr(const char* p) { const unsigned long long b = (unsigned long long)p; const unsigned lo = __builtin_amdgcn_readfirstlane((unsigned)b), hi = __builtin_amdgcn_readfirstlane((unsigned)(b >> 32)); return (const char*)(((unsigned long long)hi << 32) | lo); }

struct St {
    bf16x8 qf[6]; f32x16 ot[2]; f32x16 accl; f32x16 negm; u32x4 pw[4]; float m, l, cbn; int qrow;
    const LAS unsigned char* kfb; const LAS unsigned char* vfb; const LAS float* tbl;
    int tl_end, tr_beg; float clo, chi;
};
__device__ __forceinline__ float tile_cb(const St& st, int t) { return t < st.tl_end ? st.clo : (t >= st.tr_beg ? st.chi : 0.f); }

template <bool SAFE, bool ONES>
__device__ __forceinline__ void h1(St& st, f32x16& s0, f32x16& s1, int t, int lane) {
    const int hi = lane >> 5;
    if (SAFE) asm volatile("s_nop 15\n\ts_nop 7" : "+v"(s0), "+v"(s1));
    if (__builtin_expect(t >= st.tl_end && t < st.tr_beg, 0)) {
        const LAS float* tp = st.tbl + (64 * t + 4 * hi - st.qrow + 960);
#pragma unroll
        for (int g = 0; g < 4; ++g) {
#pragma unroll
            for (int e = 0; e < 4; ++e) { s0[4 * g + e] += tp[8 * g + e]; s1[4 * g + e] += tp[32 + 8 * g + e]; }
            asm volatile("" ::: "memory");
        }
    }
    bool resc = false;
    if (SAFE) {
        float a = max3f(s0[0], s0[1], s1[0]), b = max3f(s0[2], s0[3], s1[1]); a = max3f(a, s1[2], s1[3]);
#pragma unroll
        for (int r = 4; r < 16; r += 4) { a = max3f(a, s0[r], s0[r + 1]); b = max3f(b, s0[r + 2], s0[r + 3]); a = max3f(a, s1[r], s1[r + 1]); b = max3f(b, s1[r + 2], s1[r + 3]); }
        float mx = fmaxf(a, b);
        { auto rr = __builtin_amdgcn_permlane32_swap(__float_as_uint(mx), __float_as_uint(mx), false, false); mx = fmaxf(__uint_as_float(rr[0]), __uint_as_float(rr[1])); }
        if (__builtin_expect(__any(mx > THR), 0)) { const float dl = fmaxf(mx, 0.f), alpha = __builtin_amdgcn_exp2f(-dl); st.m += dl; st.l *= alpha; resc = true;
#pragma unroll
            for (int r = 0; r < 16; ++r) { s0[r] -= dl; s1[r] -= dl; st.ot[0][r] *= alpha; st.ot[1][r] *= alpha; if (ONES) st.accl[r] *= alpha; } }
    }
    { const float cbn = tile_cb(st, t + 1); if (__builtin_expect(resc || cbn != st.cbn, 0)) { st.cbn = cbn; const float v = cbn - st.m;
#pragma unroll
        for (int r = 0; r < 16; ++r) st.negm[r] = v;
        asm volatile("" : "+v"(st.negm)); } }
#pragma unroll
    for (int r = 0; r < 16; ++r) { s0[r] = __builtin_amdgcn_exp2f(s0[r]); s1[r] = __builtin_amdgcn_exp2f(s1[r]); }
    if (!ONES) { f32x16 tt = s0 + s1;
      float u0 = (tt[0] + tt[1]) + (tt[2] + tt[3]), u1 = (tt[4] + tt[5]) + (tt[6] + tt[7]), u2 = (tt[8] + tt[9]) + (tt[10] + tt[11]), u3 = (tt[12] + tt[13]) + (tt[14] + tt[15]);
      st.l += (u0 + u1) + (u2 + u3); }
#pragma unroll
    for (int ks = 0; ks < 2; ++ks) { st.pw[ks].x = cvtpk(s0[8 * ks + 0], s0[8 * ks + 1]); st.pw[ks].y = cvtpk(s0[8 * ks + 2], s0[8 * ks + 3]); st.pw[ks].z = cvtpk(s0[8 * ks + 4], s0[8 * ks + 5]); st.pw[ks].w = cvtpk(s0[8 * ks + 6], s0[8 * ks + 7]);
        st.pw[2 + ks].x = cvtpk(s1[8 * ks + 0], s1[8 * ks + 1]); st.pw[2 + ks].y = cvtpk(s1[8 * ks + 2], s1[8 * ks + 3]); st.pw[2 + ks].z = cvtpk(s1[8 * ks + 4], s1[8 * ks + 5]); st.pw[2 + ks].w = cvtpk(s1[8 * ks + 6], s1[8 * ks + 7]); }
    asm volatile("" : "+v"(st.pw[0]), "+v"(st.pw[1]), "+v"(st.pw[2]), "+v"(st.pw[3]));
}
template <bool ONES>
__device__ __forceinline__ void h2(St& st, f32x16& s0, f32x16& s1, int kslot, int vslot) {
    const bf16x8 ones = (bf16x8){16256, 16256, 16256, 16256, 16256, 16256, 16256, 16256};
    const unsigned kaddr = (unsigned)(uintptr_t)(st.kfb + kslot * KSLOT), vaddr = (unsigned)(uintptr_t)(st.vfb + vslot * VSLOT);
    s16x4 vlo[6], vhi[6]; bf16x8 kfr[6];
#define H2_RDV(i) asm volatile("ds_read_b64_tr_b16 %0, %2 offset:%3\n\tds_read_b64_tr_b16 %1, %2 offset:%4" : "=&v"(vlo[(i) % 6]), "=&v"(vhi[(i) % 6]) : "v"(vaddr), "i"(((i) & 1) * 4096 + ((i) >> 1) * 1024), "i"(((i) & 1) * 4096 + ((i) >> 1) * 1024 + 512))
#define H2_RDK(i) asm volatile("ds_read_b128 %0, %1 offset:%2" : "=v"(kfr[(i) % 6]) : "v"(kaddr), "i"((((i) - 8) >> 1) * 2048 + (((i) - 8) & 1) * 512))
#define H2_WV(i, n) asm volatile("s_waitcnt %2" : "+v"(vlo[(i) % 6]), "+v"(vhi[(i) % 6]) : "i"(0xC07F | ((n) << 8)))
#define H2_WK(i, n) asm volatile("s_waitcnt %1" : "+v"(kfr[(i) % 6]) : "i"(0xC07F | ((n) << 8)))
#define H2_MV(g) do { const bf16x8 vf = (bf16x8){vlo[(g) % 6][0], vlo[(g) % 6][1], vlo[(g) % 6][2], vlo[(g) % 6][3], vhi[(g) % 6][0], vhi[(g) % 6][1], vhi[(g) % 6][2], vhi[(g) % 6][3]}; \
        st.ot[(g) & 1] = __builtin_amdgcn_mfma_f32_32x32x16_bf16(vf, __builtin_bit_cast(bf16x8, st.pw[(g) >> 1]), st.ot[(g) & 1], 0, 0, 0); \
        if (ONES && ((g) & 1)) st.accl = __builtin_amdgcn_mfma_f32_32x32x16_bf16(ones, __builtin_bit_cast(bf16x8, st.pw[(g) >> 1]), st.accl, 0, 0, 0); } while (0)
#define H2_MK(g) do { if ((((g) - 8) & 1) == 0) s0 = __builtin_amdgcn_mfma_f32_32x32x16_bf16(kfr[(g) % 6], st.qf[((g) - 8) >> 1], (g) < 10 ? st.negm : s0, 0, 0, 0); \
        else s1 = __builtin_amdgcn_mfma_f32_32x32x16_bf16(kfr[(g) % 6], st.qf[((g) - 8) >> 1], (g) < 10 ? st.negm : s1, 0, 0, 0); } while (0)
    __builtin_amdgcn_s_setprio(1);
    H2_RDV(0); H2_RDV(1); H2_RDV(2); H2_RDV(3); H2_RDV(4);
    H2_RDV(5);  H2_WV(0, 10); H2_MV(0);  MLA_SB();
    H2_RDV(6);  H2_WV(1, 10); H2_MV(1);  MLA_SB();
    H2_RDV(7);  H2_WV(2, 10); H2_MV(2);  MLA_SB();
    H2_RDK(8);  H2_WV(3, 9);  H2_MV(3);  MLA_SB();
    H2_RDK(9);  H2_WV(4, 8);  H2_MV(4);  MLA_SB();
    H2_RDK(10); H2_WV(5, 7);  H2_MV(5);  MLA_SB();
    H2_RDK(11); H2_WV(6, 6);  H2_MV(6);  MLA_SB();
    H2_RDK(12); H2_WV(7, 5);  H2_MV(7);  MLA_SB();
    H2_RDK(13); H2_WK(8, 5);  H2_MK(8);  MLA_SB();
    H2_RDK(14); H2_WK(9, 5);  H2_MK(9);  MLA_SB();
    H2_RDK(15); H2_WK(10, 5); H2_MK(10); MLA_SB();
    H2_RDK(16); H2_WK(11, 5); H2_MK(11); MLA_SB();
    H2_RDK(17); H2_WK(12, 5); H2_MK(12); MLA_SB();
    H2_RDK(18); H2_WK(13, 5); H2_MK(13); MLA_SB();
    H2_RDK(19); H2_WK(14, 5); H2_MK(14); MLA_SB();
    H2_WK(15, 4); H2_MK(15); MLA_SB();
    H2_WK(16, 3); H2_MK(16); MLA_SB();
    H2_WK(17, 2); H2_MK(17); MLA_SB();
    H2_WK(18, 1); H2_MK(18); MLA_SB();
    H2_WK(19, 0); H2_MK(19); MLA_SB();
    __builtin_amdgcn_s_setprio(0);
#undef H2_RDV
#undef H2_RDK
#undef H2_WV
#undef H2_WK
#undef H2_MV
#undef H2_MK
}

template <bool SAFE>
__device__ __forceinline__ bool unit(int h, int q0, const bf16* __restrict__ Q1, const bf16* __restrict__ K1, const bf16* __restrict__ V1, bf16* __restrict__ O,
                                     LAS unsigned char* lds, const float clo, const float chi, int wave, int lane, float* dbg_tp = nullptr) {
    const int r32 = lane & 31, hi = lane >> 5, grp = wave >> 2;
    St st;
    st.tbl = (const LAS float*)(lds + L_TBL); st.clo = clo; st.chi = chi;
    st.qrow = q0 + 32 * wave + r32;
    const unsigned koff0 = (unsigned)(lane * KPITCH + h * 96 + wave * 8) * 2u, koff1 = (unsigned)(lane * KPITCH + h * 96 + (8 + (wave & 3)) * 8) * 2u;
    const unsigned voff = (unsigned)((16 * (wave & 3) + (lane >> 2)) * D + h * 64 + (wave >> 2) * 32 + (lane & 3) * 8) * 2u;
#define MLA_DMA_K(t, slot, W4) do { const char* kt_ = sgpr_ptr((const char*)K1 + (size_t)(t) * (64 * KPITCH * 2)); \
        __builtin_amdgcn_global_load_lds((const unsigned*)(kt_ + koff0), (LAS unsigned*)(lds + L_K + (slot) * KSLOT + wave * 1024), 16, 0, 0); \
        if (W4) __builtin_amdgcn_global_load_lds((const unsigned*)(kt_ + koff1), (LAS unsigned*)(lds + L_K + (slot) * KSLOT + (8 + wave) * 1024), 16, 0, 0); } while (0)
#define MLA_DMA_V(t, slot) __builtin_amdgcn_global_load_lds((const unsigned*)(sgpr_ptr((const char*)V1 + (size_t)(t) * (64 * D * 2)) + voff), (LAS unsigned*)(lds + L_V + (slot) * VSLOT + wave * 1024), 16, 0, 0)
    MLA_DMA_K(0, 0, wave < 4); MLA_DMA_K(1, 1, wave < 4); MLA_DMA_V(0, 0); MLA_DMA_K(2, 2, wave < 4); MLA_DMA_V(1, 1);
    { const bf16* qp = Q1 + (size_t)st.qrow * NQ1 + h * 96 + 8 * hi;
#pragma unroll
      for (int d0 = 0; d0 < 6; ++d0) st.qf[d0] = *(const bf16x8*)(qp + 16 * d0); }
    st.l = 0.f;
#pragma unroll
    for (int r = 0; r < 16; ++r) { st.ot[0][r] = 0.f; st.ot[1][r] = 0.f; st.accl[r] = 0.f; }
    st.kfb = lds + L_K + hi * 1024 + r32 * 16;
    st.vfb = lds + L_V + (4 * hi + ((lane & 15) >> 2)) * 64 + ((lane >> 4) & 1) * 32 + (lane & 3) * 8;
    st.tl_end = (q0 - 622 >= 0) ? (q0 - 622) / 64 + 1 : 0;
    st.tr_beg = (q0 + 814 + 63) / 64;
    f32x16 s0, s1;
    MLA_WAITBAR();
    { const LAS unsigned char* kb = st.kfb;
#pragma unroll
      for (int r = 0; r < 16; ++r) { s0[r] = 0.f; s1[r] = 0.f; }
#pragma unroll
      for (int d0 = 0; d0 < 6; ++d0) { const bf16x8 a0 = *(const LAS bf16x8*)(kb + d0 * 2048), a1 = *(const LAS bf16x8*)(kb + d0 * 2048 + 512);
          s0 = __builtin_amdgcn_mfma_f32_32x32x16_bf16(a0, st.qf[d0], s0, 0, 0, 0); s1 = __builtin_amdgcn_mfma_f32_32x32x16_bf16(a1, st.qf[d0], s1, 0, 0, 0); }
      float mx = s0[0];
#pragma unroll
      for (int r = 0; r < 16; ++r) mx = fmaxf(mx, fmaxf(s0[r], s1[r]));
      mx = fmaxf(mx, __shfl_xor(mx, 32));
      st.m = mx + tile_cb(st, 0);
#pragma unroll
      for (int r = 0; r < 16; ++r) { s0[r] -= mx; s1[r] -= mx; }
      st.cbn = 1e30f; }
    MLA_BAR();
#define MLA_STAGE(t, W4) do { if (__builtin_expect((t) + 3 < NT, 1)) MLA_DMA_K((t) + 3, ((t) + 3) & 3, W4); if (__builtin_expect((t) + 2 < NT, 1)) MLA_DMA_V((t) + 2, ((t) + 2) & 3); } while (0)
#ifdef TIMING_SEL
    unsigned long long ta_[6] = {0, 0, 0, 0, 0, 0};
#define TS(x) const unsigned long long x = __builtin_amdgcn_s_memtime()
#define TACC(i, a, b) ta_[i] += (b) - (a)
#else
#define TS(x)
#define TACC(i, a, b)
#endif
    if (grp == 0) {
        MLA_STAGE(0, true);
        for (int t = 0; t < NT; ++t) {
            TS(t1_);
            h1<SAFE, false>(st, s0, s1, t, lane); TS(t2_);
            if (__builtin_expect(t + 3 < NT, 1)) MLA_WAITBAR_N(6); else MLA_WAITBAR();
            TS(t3_); h2<false>(st, s0, s1, (t + 1) & 3, t & 3); TS(t4_);
            MLA_STAGE(t + 1, true); TS(t0_);
            MLA_BAR(); TS(t5_);
            TACC(2, t4_, t0_); TACC(0, t1_, t2_); TACC(1, t2_, t3_); TACC(3, t3_, t4_); TACC(4, t0_, t5_);
        }
    } else {
        for (int t = 0; t < NT; ++t) {
            TS(t0_); TS(t1_);
            if (__builtin_expect(t > 0, 1)) h2<true>(st, s0, s1, t & 3, (t - 1) & 3);
            TS(t2_); if (__builtin_expect(t + 3 < NT, 1)) MLA_WAITBAR_N(2); else MLA_WAITBAR();
            TS(t3_); MLA_STAGE(t, false);
            h1<SAFE, true>(st, s0, s1, t, lane); TS(t4_);
            MLA_BAR(); TS(t5_);
            TACC(2, t0_, t1_); TACC(3, t1_, t2_); TACC(1, t2_, t3_); TACC(0, t3_, t4_); TACC(4, t4_, t5_);
        }
        h2<true>(st, s0, s1, NT & 3, (NT - 1) & 3);
    }
#undef MLA_STAGE
#ifdef TIMING_SEL
    if (blockIdx.x == 0 && lane == 0 && (wave == 0 || wave == 4)) { float* tp = dbg_tp + (wave >> 2) * 8;
        for (int i = 0; i < 5; ++i) atomicAdd(tp + i, (float)ta_[i]); }
#endif
    float l = st.l; l += __shfl_xor(l, 32);
    if (grp == 1) l = st.accl[0];
    bool ok = true;
    if (!SAFE) { const bool bad = !(l > 0.f && l < 1.0e37f);
        LAS unsigned* flag = (LAS unsigned*)(lds + L_FLAG);
        if (lane == 0) flag[wave] = __any(bad) ? 1u : 0u;
        else (void)__any(bad);
        MLA_BAR();
        unsigned f = 0;
#pragma unroll
        for (int i = 0; i < 8; ++i) f |= flag[i];
        ok = (f == 0u); }
    const float inv = 1.0f / l;
    LAS bf16* stg = (LAS bf16*)(lds + L_OST) + wave * 2048;
#pragma unroll
    for (int db = 0; db < 2; ++db)
#pragma unroll
        for (int g = 0; g < 4; ++g) { u32x2 w; w.x = cvtpk(st.ot[db][4 * g] * inv, st.ot[db][4 * g + 1] * inv); w.y = cvtpk(st.ot[db][4 * g + 2] * inv, st.ot[db][4 * g + 3] * inv);
            *(LAS u32x2*)(stg + r32 * 64 + 32 * db + 8 * g + 4 * hi) = w; }
    asm volatile("s_waitcnt lgkmcnt(0)" ::: "memory");
    bf16* Ow = O + (size_t)(q0 + 32 * wave) * D + h * 64;
#pragma unroll
    for (int i = 0; i < 4; ++i) { const int row = i * 8 + (lane >> 3), ch = lane & 7; const u32x4 v = *(const LAS u32x4*)(stg + row * 64 + ch * 8); *(u32x4*)(Ow + (size_t)row * D + ch * 8) = v; }
    MLA_WAITBAR();
#undef MLA_DMA_K
#undef MLA_DMA_V
    return ok;
}
}

__device__ __forceinline__ void ffn_up_phase(LAS unsigned char* lds, const bf16* Xb, const bf16* Wgu, bf16* act, const float* ss, unsigned char* ws, int which, int G, int bx) {
    pg8::Gemm g{Xb, Wgu, S, 2 * FF, D, D}; pg8::StaticOrder So; So.init(S, 2 * FF, G, bx);
    const pg8::EpiSwiGLU E{act, ss};
    const int full = (So.nwg / G) * G, tail = So.nwg - full;
    const bool split = (tail * 2 == G) && (WS_V1 + (size_t)tail * 262144 <= WS_SAVE);
    if (split) So.hi = full;
    pg8::gemm_phase<pg8::EpiSwiGLU, true>(lds, g, So, E);
    if (split) {
        const int cc = bx < tail ? bx : bx - tail; const bool helper = bx >= tail;
        const pg8::Gemm g2{Xb + (helper ? D / 2 : 0), Wgu + (helper ? D / 2 : 0), S, 2 * FF, D / 2, D, D};
        pg8::StaticOrder So2; So2.init(S, 2 * FF, G, cc); So2.lo = full;
        float* part = (float*)(ws + WS_V1) + (size_t)cc * 65536; unsigned* fl = (unsigned*)(ws + CTL_SPLIT) + which * 2048 + cc * 16;
        pg8::gemm_phase<pg8::EpiSplit<pg8::EpiSwiGLU>, true>(lds, g2, So2, pg8::EpiSplit<pg8::EpiSwiGLU>{E, part, fl, helper});
    }
}

constexpr int NWAVES = 8;
__global__ void __launch_bounds__(NWAVES * 64, 2) fwd_kernel(Args args) {
    extern __shared__ __attribute__((aligned(16))) unsigned char lds_raw[];
    LAS unsigned char* lds = (LAS unsigned char*)lds_raw;
    volatile LAS unsigned* MISC = (volatile LAS unsigned*)(lds + MISC_OFF);
    const int tid = threadIdx.x, lane = tid & 63, wave = __builtin_amdgcn_readfirstlane(tid >> 6);
    const int G = gridDim.x; const int bx = blockIdx.x;
    const int vcu = (G % 8 == 0) ? (bx % 8) * (G / 8) + bx / 8 : bx;
    unsigned char* ws = args.ws;
    float* const out = args.out;
    const int lo = args.ph_lo, hi_ph = args.ph_hi;
    for (int u = tid; u < (LDS_BYTES - LDSCTL_OFF) / 4; u += NWAVES * 64) ((LAS unsigned*)(lds + LDSCTL_OFF))[u] = 0u;
    __syncthreads();
    const bool multi = (hi_ph - lo) > 1;
    XcdBarrier bar; bar.bar = (unsigned*)(ws + CTL_BAR); bar.x = 0; bar.st = nullptr;
    if (multi) bar = xcd_barrier_post((unsigned*)(ws + CTL_BAR), MISC + 8);
#ifndef PHASE_MASK
#define PHASE_MASK 0x1fff
#endif
#define IN(k) ((((PHASE_MASK) >> (k)) & 1) && lo <= (k) && (k) < hi_ph)
#ifndef REPEAT_MASK
#define REPEAT_MASK 0
#endif
#define REPS(k) ((((REPEAT_MASK) >> (k)) & 1) ? 2 : 1)
#define SEAM(k) do { if (IN(k) && IN((k) + 1)) xcd_barrier(bar); } while (0)

    float* const SS = (float*)(ws + CTL_SS);
    float* const SS0 = SS, * const SS1 = SS + S, * const SS2 = SS + 2 * S, * const SS3 = SS + 3 * S, * const SS4 = SS + 4 * S, * const SSQ = SS + 5 * S, * const SSKV = SS + 6 * S;
    bf16* const XB = (bf16*)(ws + WS_XB); bf16* const OB = (bf16*)(ws + WS_O); bf16* const BIG = (bf16*)(ws + WS_BIG);
    bf16* const Q1 = (bf16*)(ws + WS_Q1); bf16* const K1 = (bf16*)(ws + WS_K1); bf16* const V1 = (bf16*)(ws + WS_V1);
    const float* const ROPE = (const float*)(ws + WS_ROPE);
    const int gw = vcu * NWAVES + wave, NGW = G * NWAVES;

    if (IN(0)) {
        LAS float* scr = (LAS float*)(lds + wave * 16384);
        const float* an0 = args.in[I_ANORM], * an1 = args.in[I_ANORM] + D, * fn0 = args.in[I_FNORM], * fn1 = args.in[I_FNORM] + D;
        constexpr int NITEMS = 1536 + 512 + 1408 * 3 + 272 + 288 + 64 + 64 + 512 + 1408 * 3;
        for (int it = gw; it < NITEMS; it += NGW) {
            int r = it;
            if (p0_matrix<0>(r, args.in[I_EWIN], D, NQKV, an0, (bf16*)(ws + W_IN0), D, 0, scr, lane)) continue;
            if (p0_matrix<0>(r, args.in[I_EWOUT], D, D, nullptr, (bf16*)(ws + W_OUT0), D, 0, scr, lane)) continue;
            if (p0_matrix<1>(r, args.in[I_WG], D, FF, fn0, (bf16*)(ws + W_GU0), D, 0, scr, lane)) continue;
            if (p0_matrix<2>(r, args.in[I_WU], D, FF, fn0, (bf16*)(ws + W_GU0), D, 0, scr, lane)) continue;
            if (p0_matrix<0>(r, args.in[I_WD], FF, D, nullptr, (bf16*)(ws + W_D0), FF, 0, scr, lane)) continue;
            if (p0_matrix<0>(r, args.in[I_OWIN], D, NIN1, an1, (bf16*)(ws + W_IN1), D, 0, scr, lane)) continue;
            if (p0_matrix<0>(r, args.in[I_WUQ], QL, NQ1, args.in[I_QNORM], (bf16*)(ws + W_UQ), QL, 0, scr, lane)) continue;
            if (p0_matrix<0>(r, args.in[I_WUK], KVL, D, args.in[I_KVNORM], (bf16*)(ws + W_UKV), KVLP, 0, scr, lane)) continue;
            if (p0_matrix<0>(r, args.in[I_WUV], KVL, D, args.in[I_KVNORM], (bf16*)(ws + W_UKV), KVLP, 1024, scr, lane)) continue;
            if (p0_matrix<0>(r, args.in[I_OWOUT], D, D, nullptr, (bf16*)(ws + W_OUT1), D, 0, scr, lane)) continue;
            if (p0_matrix<1>(r, args.in[I_WG] + (size_t)D * FF, D, FF, fn1, (bf16*)(ws + W_GU1), D, 0, scr, lane)) continue;
            if (p0_matrix<2>(r, args.in[I_WU] + (size_t)D * FF, D, FF, fn1, (bf16*)(ws + W_GU1), D, 0, scr, lane)) continue;
            p0_matrix<0>(r, args.in[I_WD] + (size_t)FF * D, FF, D, nullptr, (bf16*)(ws + W_D1), FF, 0, scr, lane);
        }
        const int gt = vcu * (NWAVES * 64) + tid, NGT = G * NWAVES * 64;
        for (int i = gt; i < (NIN1P - NIN1) * D / 8; i += NGT) ((u32x4*)(ws + W_IN1 + (size_t)NIN1 * D * 2))[i] = (u32x4){0u, 0u, 0u, 0u};
        for (int i = gt; i < NKV1 * 16; i += NGT) { const int row = i >> 4, c = i & 15; *(u32x4*)(ws + W_UKV + ((size_t)row * KVLP + KVL + c * 8) * 2) = (u32x4){0u, 0u, 0u, 0u}; }
        for (int mrow = gw * 4; mrow < S; mrow += NGW * 4) {
            f32x4 v[4][4];
#pragma unroll
            for (int rr = 0; rr < 4; ++rr) { const f32x4* xr = (const f32x4*)(args.in[I_X] + (size_t)(mrow + rr) * D) + lane;
#pragma unroll
                for (int j = 0; j < 4; ++j) v[rr][j] = xr[64 * j]; }
#pragma unroll
            for (int rr = 0; rr < 4; ++rr) { float s2 = 0.f; unsigned long long* o8 = (unsigned long long*)(XB + (size_t)(mrow + rr) * D) + lane;
#pragma unroll
                for (int j = 0; j < 4; ++j) { const f32x4 w = v[rr][j]; s2 += (w.x * w.x + w.y * w.y) + (w.z * w.z + w.w * w.w);
                    o8[64 * j] = (unsigned long long)cvtpk(w.x, w.y) | ((unsigned long long)cvtpk(w.z, w.w) << 32); }
                s2 = wave_sum(s2);
                if (lane == 0) SS0[mrow + rr] = s2; }
        }
        float* rope = (float*)(ws + WS_ROPE);
        for (int i = gt; i < S * 16; i += NGT) { const int pos = i >> 4, fi = i & 15; const float fr = powf(10000.0f, -(float)fi / 16.0f), ang = (float)pos * fr;
            rope[2 * i] = cosf(ang); rope[2 * i + 1] = sinf(ang); }
        const float* t5 = args.in[I_T5];
        float* tdil = (float*)(ws + WS_TDIL);
        for (int i = gt; i < 8 * 2368; i += NGT) { const int h = i / 2368, d = i % 2368 - 1152, n = d < 0 ? -d : d; int mult = 0;
            if (n <= 64) ++mult; if ((d & 3) == 0 && n <= 256) ++mult; if ((d & 15) == 0 && n <= 1024) ++mult;
            tdil[i] = mult ? (t5[t5_bucket_precise(d) * 16 + h] + logf((float)mult)) * LOG2E : NEGB; }
        float* tmla = (float*)(ws + WS_TMLA);
        for (int i = gt; i < 16 * 1984; i += NGT) { const int h = i / 1984; int d = i % 1984 - 960; d = d > 960 ? 960 : d; tmla[i] = t5[t5_bucket_precise(d) * 16 + h] * LOG2E; }
        float* trpb = (float*)(ws + WS_TRPB);
        for (int i = gt; i < 8 * 465; i += NGT) trpb[i] = args.in[I_RPB][i] * LOG2E;
    }
    SEAM(0);

    if (IN(1)) for (int rep_ = 0; rep_ < REPS(1); ++rep_) {
        pg8::Gemm g{XB, (const bf16*)(ws + W_IN0), S, NQKV, D, D}; pg8::StaticOrder So; So.init(S, NQKV, G, bx);
        pg8::EpiRowScale E{BIG, NQKV, SS0, 1.0f / D, 1};
        pg8::gemm_phase<pg8::EpiRowScale, true>(lds, g, So, E);
    }
    SEAM(1);

    if (IN(2)) for (int rep_ = 0; rep_ < REPS(2); ++rep_) {
        const int hd = vcu >> 5;
        LAS float* tdl = (LAS float*)(lds + 132096); LAS float* trp = (LAS float*)(lds + 132096 + 9472);
        for (int i = tid; i < 2368; i += NWAVES * 64) tdl[(i & 3) * 592 + (i >> 2)] = ((const float*)(ws + WS_TDIL))[hd * 2368 + i];
        for (int i = tid; i < 465; i += NWAVES * 64) trp[i] = ((const float*)(ws + WS_TRPB))[hd * 465 + i];
        __syncthreads();
        LAS unsigned char* wl = lds + wave * wattn::WREG;
        const int r32 = lane & 31;
        for (int rd = 0; rd < 2; ++rd) {
            const int blk = rd * 64 + 2 * (vcu & 31) + (wave >> 2), t0 = blk * 128, w = wave & 3;
            wattn::DilF f{t0, w, (t0 < 1152) || (t0 + 128 + 1152 > S), tdl};
            const int tq = t0 + w + 4 * r32;
            if (!wattn::run_unit<false>(f, BIG + (size_t)tq * NQKV + hd * 64, (const char*)(BIG + 512 + hd * 64), OB + (size_t)tq * D + hd * 64, wl, lane))
                (void)wattn::run_unit<true>(f, BIG + (size_t)tq * NQKV + hd * 64, (const char*)(BIG + 512 + hd * 64), OB + (size_t)tq * D + hd * 64, wl, lane);
        }
        for (int rn = 0; rn < 2; ++rn) {
            const int gr0 = rn * 128 + 4 * (vcu & 31);
            if (!wattn::na_coop<false>(gr0, BIG + 1536 + hd * 64, (const char*)(BIG + 2048 + hd * 64), OB + 512 + hd * 64, trp, lds, wave, lane))
                (void)wattn::na_coop<true>(gr0, BIG + 1536 + hd * 64, (const char*)(BIG + 2048 + hd * 64), OB + 512 + hd * 64, trp, lds, wave, lane);
        }
        __syncthreads();
    }
    SEAM(2);

    if (IN(3)) {
        pg8::Gemm g{OB, (const bf16*)(ws + W_OUT0), S, D, D, D}; pg8::StaticOrder So; So.init(S, D, G, bx);
#if DBG_CHECK
        pg8::EpiResid E{args.in[I_X], nullptr, out, XB, SS1};
#else
        pg8::EpiResid E{args.in[I_X], nullptr, nullptr, XB, SS1};
#endif
        pg8::gemm_phase<pg8::EpiResid, true>(lds, g, So, E);
    }
    SEAM(3);
    if (IN(4)) for (int rep_ = 0; rep_ < REPS(4); ++rep_) {
        ffn_up_phase(lds, XB, (const bf16*)(ws + W_GU0), BIG, SS1, ws, 0, G, bx);
    }
    SEAM(4);
    if (IN(5)) {
        pg8::Gemm g{BIG, (const bf16*)(ws + W_D0), S, D, FF, FF}; pg8::StaticOrder So; So.init(S, D, G, bx);
#if DBG_CHECK
        pg8::EpiResid E{out, nullptr, out, XB, SS2};
#else
        pg8::EpiResid E{nullptr, XB, nullptr, XB, SS2};
#endif
        pg8::gemm_phase<pg8::EpiResid, true>(lds, g, So, E);
    }
    SEAM(5);
    if (IN(6)) {
        pg8::Gemm g{XB, (const bf16*)(ws + W_IN1), S, NIN1P, D, D}; pg8::StaticOrder So; So.init(S, NIN1P, G, bx);
        pg8::EpiMlaIn E{OB, SS2, SSQ, SSKV, K1, ROPE};
        pg8::gemm_phase<pg8::EpiMlaIn, true>(lds, g, So, E);
    }
    SEAM(6);
    if (IN(7)) for (int rep_ = 0; rep_ < REPS(7); ++rep_) {
        { pg8::Gemm g{OB, (const bf16*)(ws + W_UQ), S, NQ1, QL, NIN1P}; pg8::StaticOrder So; So.init(S, NQ1, G, bx);
          pg8::EpiMlaQ E{Q1, SSQ, ROPE};
          pg8::gemm_phase<pg8::EpiMlaQ, true>(lds, g, So, E); }
        { pg8::Gemm g{OB + QL, (const bf16*)(ws + W_UKV), S, NKV1, KVLP, NIN1P}; pg8::StaticOrder So; So.init(S, NKV1, G, bx);
          pg8::EpiMlaKV E{K1, V1, SSKV};
          pg8::gemm_phase<pg8::EpiMlaKV, true>(lds, g, So, E); }
    }
    SEAM(7);
    if (IN(8)) for (int rep_ = 0; rep_ < REPS(8); ++rep_) {
        const int hm = vcu >> 4;
        LAS float* tml = (LAS float*)(lds + mla::L_TBL);
        const float* tg = (const float*)(ws + WS_TMLA) + hm * 1984;
        for (int i = tid; i < 1921; i += NWAVES * 64) tml[i] = tg[i];
        const float clo = tg[0], chi = tg[1920];
        __syncthreads();
        for (int rd = 0; rd < 4; ++rd) { const int q0 = ((vcu & 15) * 4 + rd) * 256;
            if (!mla::unit<false>(hm, q0, Q1, K1, V1, OB, lds, clo, chi, wave, lane, (float*)(ws + CTL_STATS))) (void)mla::unit<true>(hm, q0, Q1, K1, V1, OB, lds, clo, chi, wave, lane, (float*)(ws + CTL_STATS) + 32); }
        __syncthreads();
    }
    SEAM(8);
    if (IN(9)) {
        pg8::Gemm g{OB, (const bf16*)(ws + W_OUT1), S, D, D, D}; pg8::StaticOrder So; So.init(S, D, G, bx);
#if DBG_CHECK
        pg8::EpiResid E{out, nullptr, out, XB, SS3};
#else
        pg8::EpiResid E{nullptr, XB, nullptr, XB, SS3};
#endif
        pg8::gemm_phase<pg8::EpiResid, true>(lds, g, So, E);
    }
    SEAM(9);
    if (IN(10)) for (int rep_ = 0; rep_ < REPS(10); ++rep_) {
        ffn_up_phase(lds, XB, (const bf16*)(ws + W_GU1), BIG, SS3, ws, 1, G, bx);
    }
    SEAM(10);
#if DBG_CHECK || !defined(FUSE_FINAL_NORM)
    if (IN(11)) {
        pg8::Gemm g{BIG, (const bf16*)(ws + W_D1), S, D, FF, FF}; pg8::StaticOrder So; So.init(S, D, G, bx);
        pg8::EpiResid E{out, nullptr, out, XB, SS4};
        pg8::gemm_phase<pg8::EpiResid, true>(lds, g, So, E);
    }
    SEAM(11);
    if (IN(12)) {
        const f32x4* gf = (const f32x4*)args.in[I_FINAL] + lane;
        for (int mrow = gw; mrow < S; mrow += NGW) {
            f32x4* xr = (f32x4*)(out + (size_t)mrow * D) + lane; f32x4 v[4]; float s2 = 0.f;
#pragma unroll
            for (int j = 0; j < 4; ++j) { v[j] = xr[64 * j]; s2 += (v[j].x * v[j].x + v[j].y * v[j].y) + (v[j].z * v[j].z + v[j].w * v[j].w); }
            const float rs = 1.0f / sqrtf(wave_sum(s2) * (1.0f / D) + RMS_EPS);
#pragma unroll
            for (int j = 0; j < 4; ++j) xr[64 * j] = v[j] * rs * gf[64 * j];
        }
    }
#else
    if (IN(11)) {
        pg8::Gemm g{BIG, (const bf16*)(ws + W_D1), S, D, FF, FF}; pg8::StaticOrder So; So.init(S, D, G, bx);
        pg8::EpiFinal E{nullptr, XB, out, SS4, (unsigned*)(ws + CTL_PANEL), args.in[I_FINAL]};
        pg8::gemm_phase<pg8::EpiFinal, true>(lds, g, So, E);
    }
#endif
#ifdef TIMING_SEL
    if (IN(12)) { __syncthreads(); if (blockIdx.x == 0) { const float* tp = (const float*)(ws + CTL_STATS); const float A = rintf(tp[TIMING_SEL] * (1.0f / 1024.0f) * (1.0f / 32.0f)) * 32.0f, B = rintf(tp[TIMING_SEL2] * (1.0f / 1024.0f) * (1.0f / 32.0f)) * 0.32f;
        if (tid == 0) out[0] += A; for (int i = tid; i < 16384; i += NWAVES * 64) if (i) out[(size_t)i * 1024] += B; } }
#endif
#undef IN
#undef SEAM
}

#if DBG_CHECK
namespace dbg {
constexpr int NSAMP = 1024;
__device__ __forceinline__ int srow(int i) { return 16 * i + ((i * 5) & 15); }
__device__ __forceinline__ void accum(float err, float ref, float* stats, int slot) {
    __shared__ float se[8], sr[8];
    err = wave_sum(err); ref = wave_sum(ref);
    const int w = threadIdx.x >> 6;
    if ((threadIdx.x & 63) == 0) { se[w] = err; sr[w] = ref; }
    __syncthreads();
    if (threadIdx.x == 0) { float e = 0.f, r = 0.f; for (int i = 0; i < (int)(blockDim.x >> 6); ++i) { e += se[i]; r += sr[i]; } atomicAdd(stats + 2 * slot, e); atomicAdd(stats + 2 * slot + 1, r); }
    __syncthreads();
}
__global__ void k_rowrstd(const float* src, int ld, int ncols, int compact, float* outv) {
    const int i = blockIdx.x, m = compact ? i : srow(i); float s = 0.f;
    for (int k = threadIdx.x; k < ncols; k += 64) { const float v = src[(size_t)m * ld + k]; s += v * v; }
    s = wave_sum(s);
    if (threadIdx.x == 0) outv[i] = 1.0f / sqrtf(s / ncols + RMS_EPS);
}
__global__ void k_rowrstd_bf(const bf16* src, int ld, int ncols, float* outv) {
    const int i = blockIdx.x, m = srow(i); float s = 0.f;
    for (int k = threadIdx.x; k < ncols; k += 64) { const float v = bf2f(src[(size_t)m * ld + k]); s += v * v; }
    s = wave_sum(s);
    if (threadIdx.x == 0) outv[i] = 1.0f / sqrtf(s / ncols + RMS_EPS);
}
__global__ void k_save_rows(const float* src, float* dst) {
    const int i = blockIdx.x, m = srow(i);
    for (int k = threadIdx.x; k < D; k += blockDim.x) dst[(size_t)i * D + k] = src[(size_t)m * D + k];
}
template <int ABF, int GOTBF>
__global__ void k_chk_lin(const void* A, int lda, int acomp, const float* rs, const float* gain, const float* W, int ldw, int K, int N,
                          const float* resid, int ldr, int rcomp, const void* got, int ldg, float gscale, float* stats, int slot) {
    const int i = blockIdx.y, m = srow(i), n = blockIdx.x * 256 + threadIdx.x;
    float err = 0.f, ref2 = 0.f;
    if (n < N) {
        const size_t arow = (size_t)(acomp ? i : m) * lda; float acc = 0.f;
        for (int k = 0; k < K; ++k) { const float a = ABF ? bf2f(((const bf16*)A)[arow + k]) : ((const float*)A)[arow + k]; acc += a * (gain ? gain[k] : 1.0f) * W[(size_t)k * ldw + n]; }
        float ref = acc * (rs ? rs[i] : 1.0f);
        if (resid) ref += resid[(size_t)(rcomp ? i : m) * ldr + n];
        float g = (GOTBF ? bf2f(((const bf16*)got)[(size_t)m * ldg + n]) : ((const float*)got)[(size_t)m * ldg + n]) * gscale;
        if (slot == 1 && (n < 512 || (n >= 1536 && n < 2048))) g *= (1.0f / C2_LOCAL);
        err = (g - ref) * (g - ref); ref2 = ref * ref;
    }
    accum(err, ref2, stats, slot);
}
__global__ void k_chk_swiglu(const float* X, const float* rs, const float* gain, const float* Wg, const float* Wu, const bf16* got, float* stats, int slot) {
    const int i = blockIdx.y, m = srow(i), n = blockIdx.x * 256 + threadIdx.x;
    float a = 0.f, b = 0.f;
    for (int k = 0; k < D; ++k) { const float h = X[(size_t)m * D + k] * gain[k]; a += h * Wg[(size_t)k * FF + n]; b += h * Wu[(size_t)k * FF + n]; }
    a *= rs[i]; b *= rs[i];
    const float ref = a / (1.0f + expf(-a)) * b, g = bf2f(got[(size_t)m * FF + n]);
    accum((g - ref) * (g - ref), ref * ref, stats, slot);
}
__global__ void k_chk_krope(const float* X, const float* rs, const float* gain, const float* Win1, const bf16* K1, float* stats, int slot) {
    const int si = blockIdx.x, m = srow(si), i = threadIdx.x & 31, f = i & 15;
    float x1 = 0.f, x2 = 0.f;
    for (int k = 0; k < D; ++k) { const float h = X[(size_t)m * D + k] * gain[k]; x1 += h * Win1[(size_t)k * NIN1 + 512 + f]; x2 += h * Win1[(size_t)k * NIN1 + 528 + f]; }
    x1 *= rs[si]; x2 *= rs[si];
    const float fr = powf(10000.0f, -(float)f / 16.0f), ang = (float)m * fr, c = cosf(ang), sn = sinf(ang);
    const float ref = (i < 16) ? (x1 * c - x2 * sn) : (x1 * sn + x2 * c);
    float err = 0.f, r2 = 0.f;
    for (int h = (threadIdx.x >> 5) * 8; h < (threadIdx.x >> 5) * 8 + 8; ++h) { const float g = bf2f(K1[(size_t)m * KPITCH + h * 96 + 64 + i]); err += (g - ref) * (g - ref); r2 += ref * ref; }
    accum(err, r2, stats, slot);
}
__global__ void k_chk_q(const bf16* P, const float* rsq, const float* qnorm, const float* Wuq, const bf16* Q1, float* stats, int slot) {
    const int si = blockIdx.y, m = srow(si), n = blockIdx.x * 256 + threadIdx.x, off = n % 96;
    const bool rope = off >= 64; const int f = (off - 64) & 15; const int n1 = n - off + 64 + f, n2 = n1 + 16;
    float a = 0.f, b = 0.f;
    for (int k = 0; k < QL; ++k) { const float c = bf2f(P[(size_t)m * NIN1P + k]) * qnorm[k];
        if (rope) { a += c * Wuq[(size_t)k * NQ1 + n1]; b += c * Wuq[(size_t)k * NQ1 + n2]; } else a += c * Wuq[(size_t)k * NQ1 + n]; }
    a *= rsq[si]; b *= rsq[si];
    float ref = a;
    if (rope) { const float fr = powf(10000.0f, -(float)f / 16.0f), ang = (float)m * fr, c = cosf(ang), sn = sinf(ang); ref = (off < 80) ? (a * c - b * sn) : (a * sn + b * c); }
    const float g = bf2f(Q1[(size_t)m * NQ1 + n]) / C2_MLA;
    accum((g - ref) * (g - ref), ref * ref, stats, slot);
}
__global__ void k_chk_kv(const bf16* P, const float* rskv, const float* kvnorm, const float* W, const bf16* got, int iskf, float* stats, int slot) {
    const int si = blockIdx.y, m = srow(si), n = blockIdx.x * 256 + threadIdx.x;
    float a = 0.f;
    for (int k = 0; k < KVL; ++k) a += bf2f(P[(size_t)m * NIN1P + QL + k]) * kvnorm[k] * W[(size_t)k * D + n];
    a *= rskv[si];
    const float g = iskf ? bf2f(got[(size_t)m * KPITCH + (n >> 6) * 96 + (n & 63)]) : bf2f(got[(size_t)m * D + n]);
    accum((g - a) * (g - a), a * a, stats, slot);
}
__device__ __forceinline__ int ltok(int i) { if (i < 4) return i; if (i < 8) return S - 1 - (i - 4); return 32 * i + ((i * 13) & 31); }
__global__ void __launch_bounds__(64) k_chk_local(const bf16* QKV, const float* t5, const float* rpb, const bf16* O, float* stats, int slot) {
    const int idx = blockIdx.x * 64 + threadIdx.x, i = idx >> 4, h = idx & 15, t = ltok(i);
    float q[64], o[64];
    float err = 0.f, r2 = 0.f;
    if (h < 8) {
        const bf16* qp = QKV + (size_t)t * NQKV + h * 64;
        _Pragma("unroll") for (int d = 0; d < 64; ++d) { q[d] = bf2f(qp[d]) * (1.0f / C2_LOCAL); o[d] = 0.f; }
        float mb[3], denb[3];
        _Pragma("unroll") for (int b = 0; b < 3; ++b) { const int dil = b == 0 ? 1 : (b == 1 ? 4 : 16); float mx = -3e38f;
            for (int j = -64; j <= 64; ++j) { const int u = t + dil * j; if (u < 0 || u >= S) continue;
                const bf16* kp = QKV + (size_t)u * NQKV + 512 + h * 64; float sc = 0.f; _Pragma("unroll") for (int d = 0; d < 64; ++d) sc += q[d] * bf2f(kp[d]);
                sc = sc * 0.125f + t5[t5_bucket_precise(dil * j) * 16 + h]; mx = fmaxf(mx, sc); }
            float den = 0.f;
            for (int j = -64; j <= 64; ++j) { const int u = t + dil * j; if (u < 0 || u >= S) continue;
                const bf16* kp = QKV + (size_t)u * NQKV + 512 + h * 64; float sc = 0.f; _Pragma("unroll") for (int d = 0; d < 64; ++d) sc += q[d] * bf2f(kp[d]);
                sc = sc * 0.125f + t5[t5_bucket_precise(dil * j) * 16 + h]; den += expf(sc - mx); }
            mb[b] = mx; denb[b] = den; }
        float lse[3], M = -3e38f; _Pragma("unroll") for (int b = 0; b < 3; ++b) { lse[b] = mb[b] + logf(denb[b]); M = fmaxf(M, lse[b]); }
        float wsum = 0.f, wb[3]; _Pragma("unroll") for (int b = 0; b < 3; ++b) { wb[b] = expf(lse[b] - M); wsum += wb[b]; }
        _Pragma("unroll") for (int b = 0; b < 3; ++b) { const int dil = b == 0 ? 1 : (b == 1 ? 4 : 16); const float coef = wb[b] / wsum / denb[b];
            for (int j = -64; j <= 64; ++j) { const int u = t + dil * j; if (u < 0 || u >= S) continue;
                const bf16* kp = QKV + (size_t)u * NQKV + 512 + h * 64; const bf16* vp = QKV + (size_t)u * NQKV + 1024 + h * 64; float sc = 0.f; _Pragma("unroll") for (int d = 0; d < 64; ++d) sc += q[d] * bf2f(kp[d]);
                sc = sc * 0.125f + t5[t5_bucket_precise(dil * j) * 16 + h]; const float p = expf(sc - mb[b]) * coef;
                _Pragma("unroll") for (int d = 0; d < 64; ++d) o[d] += p * bf2f(vp[d]); } }
        const bf16* op = O + (size_t)t * D + h * 64;
        _Pragma("unroll") for (int d = 0; d < 64; ++d) { const float g = bf2f(op[d]); err += (g - o[d]) * (g - o[d]); r2 += o[d] * o[d]; }
    } else {
        const int hb = h - 8, r = t >> 6, c = t & 63;
        int r0 = r - 4; r0 = r0 < 0 ? 0 : (r0 > 248 ? 248 : r0); int c0 = c - 8; c0 = c0 < 0 ? 0 : (c0 > 48 ? 48 : c0);
        const bf16* qp = QKV + (size_t)t * NQKV + 1536 + hb * 64;
        _Pragma("unroll") for (int d = 0; d < 64; ++d) { q[d] = bf2f(qp[d]) * (1.0f / C2_LOCAL); o[d] = 0.f; }
        float mx = -3e38f;
        for (int kr = 0; kr < 8; ++kr) for (int kc = c0; kc < c0 + 16; ++kc) { const int u = (r0 + kr) * 64 + kc;
            const bf16* kp = QKV + (size_t)u * NQKV + 2048 + hb * 64; float sc = 0.f; _Pragma("unroll") for (int d = 0; d < 64; ++d) sc += q[d] * bf2f(kp[d]);
            sc = sc * 0.125f + rpb[(hb * 15 + (r0 + kr - r + 7)) * 31 + (kc - c + 15)]; mx = fmaxf(mx, sc); }
        float den = 0.f;
        for (int kr = 0; kr < 8; ++kr) for (int kc = c0; kc < c0 + 16; ++kc) { const int u = (r0 + kr) * 64 + kc;
            const bf16* kp = QKV + (size_t)u * NQKV + 2048 + hb * 64; const bf16* vp = QKV + (size_t)u * NQKV + 2560 + hb * 64; float sc = 0.f; _Pragma("unroll") for (int d = 0; d < 64; ++d) sc += q[d] * bf2f(kp[d]);
            sc = sc * 0.125f + rpb[(hb * 15 + (r0 + kr - r + 7)) * 31 + (kc - c + 15)]; const float p = expf(sc - mx); den += p;
            _Pragma("unroll") for (int d = 0; d < 64; ++d) o[d] += p * bf2f(vp[d]); }
        const bf16* op = O + (size_t)t * D + 512 + hb * 64;
        _Pragma("unroll") for (int d = 0; d < 64; ++d) { const float g = bf2f(op[d]); const float rf = o[d] / den; err += (g - rf) * (g - rf); r2 += rf * rf; }
    }
    accum(err, r2, stats, slot);
}
__global__ void __launch_bounds__(256) k_chk_mla(const bf16* Q1, const bf16* K1, const bf16* V1, const float* t5, const bf16* O, float* stats, int slot) {
    const int i = blockIdx.x >> 4, h = blockIdx.x & 15, t = 256 * i + ((i * 37) & 255), tid = threadIdx.x;
    __shared__ float qs[96], red[8], so[64];
    if (tid < 96) qs[tid] = bf2f(Q1[(size_t)t * NQ1 + h * 96 + tid]);
    if (tid < 64) so[tid] = 0.f;
    __syncthreads();
    float mx = -3e38f;
    for (int k = tid; k < S; k += 256) { const bf16* kp = K1 + (size_t)k * KPITCH + h * 96; float sc = 0.f; _Pragma("unroll") for (int d = 0; d < 96; ++d) sc += qs[d] * bf2f(kp[d]);
        sc += t5[t5_bucket_precise(k - t) * 16 + h] * LOG2E; mx = fmaxf(mx, sc); }
    for (int o = 1; o < 64; o <<= 1) mx = fmaxf(mx, __shfl_xor(mx, o));
    if ((tid & 63) == 0) red[tid >> 6] = mx;
    __syncthreads();
    mx = fmaxf(fmaxf(red[0], red[1]), fmaxf(red[2], red[3]));
    __syncthreads();
    float den = 0.f, o[64];
    _Pragma("unroll") for (int d = 0; d < 64; ++d) o[d] = 0.f;
    for (int k = tid; k < S; k += 256) { const bf16* kp = K1 + (size_t)k * KPITCH + h * 96; const bf16* vp = V1 + (size_t)k * D + h * 64; float sc = 0.f; _Pragma("unroll") for (int d = 0; d < 96; ++d) sc += qs[d] * bf2f(kp[d]);
        sc += t5[t5_bucket_precise(k - t) * 16 + h] * LOG2E; const float p = exp2f(sc - mx); den += p;
        _Pragma("unroll") for (int d = 0; d < 64; ++d) o[d] += p * bf2f(vp[d]); }
    den = wave_sum(den);
    if ((tid & 63) == 0) red[4 + (tid >> 6)] = den;
    _Pragma("unroll") for (int d = 0; d < 64; ++d) { const float v = wave_sum(o[d]); if ((tid & 63) == 0) atomicAdd(&so[d], v); }
    __syncthreads();
    den = red[4] + red[5] + red[6] + red[7];
    float err = 0.f, r2 = 0.f;
    if (tid < 64) { const float rf = so[tid] / den, g = bf2f(O[(size_t)t * D + h * 64 + tid]); err = (g - rf) * (g - rf); r2 = rf * rf; }
    accum(err, r2, stats, slot);
}
__global__ void k_chk_final(const float* save, const float* rs, const float* gf, const float* outp, float* stats, int slot) {
    const int i = blockIdx.x, m = srow(i); float err = 0.f, r2 = 0.f;
    for (int k = threadIdx.x; k < D; k += 256) { const float ref = save[(size_t)i * D + k] * rs[i] * gf[k], g = outp[(size_t)m * D + k]; err += (g - ref) * (g - ref); r2 += ref * ref; }
    accum(err, r2, stats, slot);
}
__global__ void k_finalize(const float* stats, float* outp, float tol, int magslot) {
    if (threadIdx.x != 0 || blockIdx.x != 0) return;
    int fail = 0; float relf = 0.f;
    for (int s = 1; s <= 16; ++s) { const float e = stats[2 * s], r = stats[2 * s + 1]; const float rel = sqrtf(e / fmaxf(r, 1e-30f)); const bool bad = !(rel <= tol) || !(r > 0.f);
        if (bad && !fail) { fail = s; relf = rel; } }
    if (magslot > 0) { const float e = stats[2 * magslot], r = stats[2 * magslot + 1]; outp[0] += 1.0e4f * fminf(sqrtf(e / fmaxf(r, 1e-30f)), 10.f) + 1.0f; }
    else if (fail) outp[0] += 100.0f + 10.0f * fail;
}
}

#endif

extern "C" void kernel_launch(void* const* d_in, const int* in_sizes, int n_in, void* d_out, int out_size, void* d_ws, size_t ws_size, hipStream_t stream) {
    static int grid = 0;
    if (grid == 0) {
        if (n_in != 18 || in_sizes[0] != S * D || out_size != S * D || ws_size < WS_END) { fprintf(stderr, "kernel_launch: unexpected shapes (n_in %d, in0 %d, out %d, ws %zu)\n", n_in, n_in > 0 ? in_sizes[0] : -1, out_size, ws_size); grid = -1; return; }
        int dev = 0, cus = 0, per_cu = 0;
        if (hipGetDevice(&dev) != hipSuccess || hipDeviceGetAttribute(&cus, hipDeviceAttributeMultiprocessorCount, dev) != hipSuccess) { grid = -1; return; }
        if (hipFuncSetAttribute((const void*)fwd_kernel, hipFuncAttributeMaxDynamicSharedMemorySize, LDS_BYTES) != hipSuccess) { fprintf(stderr, "kernel_launch: hipFuncSetAttribute failed\n"); grid = -1; return; }
        if (hipOccupancyMaxActiveBlocksPerMultiprocessor(&per_cu, (const void*)fwd_kernel, NWAVES * 64, LDS_BYTES) != hipSuccess || per_cu < 1) fprintf(stderr, "kernel_launch: occupancy query reports %d\n", per_cu);
        (void)hipGetLastError();
        grid = cus;
        if (grid != 256) fprintf(stderr, "kernel_launch: %d CUs; this kernel's unit maps assume 256\n", grid);
    }
    if (grid < 0) return;
    (void)hipMemsetAsync((char*)d_ws + WS_CTL, 0, CTL_ZERO_BYTES, stream);
    Args a{};
    for (int i = 0; i < 18; ++i) a.in[i] = (const float*)d_in[i];
    a.out = (float*)d_out; a.ws = (unsigned char*)d_ws;
#if DBG_CHECK
    {
        using namespace dbg;
        unsigned char* ws = (unsigned char*)d_ws; float* outp = (float*)d_out;
        float* stats = (float*)(ws + CTL_STATS); float* rstd = (float*)(ws + CTL_RSTD); float* rstd2 = rstd + 1024; float* save = (float*)(ws + WS_SAVE);
        bf16* XBp = (bf16*)(ws + WS_XB); bf16* OBp = (bf16*)(ws + WS_O); bf16* BIGp = (bf16*)(ws + WS_BIG); bf16* Q1p = (bf16*)(ws + WS_Q1); bf16* K1p = (bf16*)(ws + WS_K1); bf16* V1p = (bf16*)(ws + WS_V1);
        const float* x = a.in[I_X];
        for (int ph = 0; ph < NPH; ++ph) {
            if (ph == 5 || ph == 9 || ph == 11 || ph == 12) hipLaunchKernelGGL(k_save_rows, dim3(NSAMP), dim3(256), 0, stream, (const float*)outp, save);
            a.ph_lo = ph; a.ph_hi = ph + 1;
            hipLaunchKernelGGL(fwd_kernel, dim3(grid), dim3(NWAVES * 64), LDS_BYTES, stream, a);
            switch (ph) {
            case 1: hipLaunchKernelGGL(k_rowrstd, dim3(NSAMP), dim3(64), 0, stream, x, D, D, 0, rstd);
                hipLaunchKernelGGL((k_chk_lin<0, 1>), dim3(12, NSAMP), dim3(256), 0, stream, (const void*)x, D, 0, (const float*)rstd, a.in[I_ANORM], a.in[I_EWIN], NQKV, D, NQKV, (const float*)nullptr, 0, 0, (const void*)BIGp, NQKV, 1.0f, stats, 1); break;
            case 2: hipLaunchKernelGGL(k_chk_local, dim3(512 * 16 / 64), dim3(64), 0, stream, (const bf16*)BIGp, a.in[I_T5], a.in[I_RPB], (const bf16*)OBp, stats, 2); break;
            case 3: hipLaunchKernelGGL((k_chk_lin<1, 0>), dim3(4, NSAMP), dim3(256), 0, stream, (const void*)OBp, D, 0, (const float*)nullptr, (const float*)nullptr, a.in[I_EWOUT], D, D, D, x, D, 0, (const void*)outp, D, 1.0f, stats, 3);
                hipLaunchKernelGGL((k_chk_lin<1, 1>), dim3(4, NSAMP), dim3(256), 0, stream, (const void*)OBp, D, 0, (const float*)nullptr, (const float*)nullptr, a.in[I_EWOUT], D, D, D, x, D, 0, (const void*)XBp, D, 1.0f, stats, 16); break;
            case 4: hipLaunchKernelGGL(k_rowrstd, dim3(NSAMP), dim3(64), 0, stream, (const float*)outp, D, D, 0, rstd);
                hipLaunchKernelGGL(k_chk_swiglu, dim3(11, NSAMP), dim3(256), 0, stream, (const float*)outp, (const float*)rstd, a.in[I_FNORM], a.in[I_WG], a.in[I_WU], (const bf16*)BIGp, stats, 4); break;
            case 5: hipLaunchKernelGGL((k_chk_lin<1, 0>), dim3(4, NSAMP), dim3(256), 0, stream, (const void*)BIGp, FF, 0, (const float*)nullptr, (const float*)nullptr, a.in[I_WD], D, FF, D, (const float*)save, D, 1, (const void*)outp, D, 1.0f, stats, 5); break;
            case 6: hipLaunchKernelGGL(k_rowrstd, dim3(NSAMP), dim3(64), 0, stream, (const float*)outp, D, D, 0, rstd);
                hipLaunchKernelGGL((k_chk_lin<0, 1>), dim3(2, NSAMP), dim3(256), 0, stream, (const void*)outp, D, 0, (const float*)rstd, a.in[I_ANORM] + D, a.in[I_OWIN], NIN1, D, 512, (const float*)nullptr, 0, 0, (const void*)OBp, NIN1P, 1.0f, stats, 6);
                hipLaunchKernelGGL(k_chk_krope, dim3(NSAMP), dim3(64), 0, stream, (const float*)outp, (const float*)rstd, a.in[I_ANORM] + D, a.in[I_OWIN], (const bf16*)K1p, stats, 7); break;
            case 7: hipLaunchKernelGGL(k_rowrstd_bf, dim3(NSAMP), dim3(64), 0, stream, (const bf16*)OBp, NIN1P, QL, rstd);
                hipLaunchKernelGGL(k_rowrstd_bf, dim3(NSAMP), dim3(64), 0, stream, (const bf16*)OBp + QL, NIN1P, KVL, rstd2);
                hipLaunchKernelGGL(k_chk_q, dim3(6, NSAMP), dim3(256), 0, stream, (const bf16*)OBp, (const float*)rstd, a.in[I_QNORM], a.in[I_WUQ], (const bf16*)Q1p, stats, 8);
                hipLaunchKernelGGL(k_chk_kv, dim3(4, NSAMP), dim3(256), 0, stream, (const bf16*)OBp, (const float*)rstd2, a.in[I_KVNORM], a.in[I_WUK], (const bf16*)K1p, 1, stats, 9);
                hipLaunchKernelGGL(k_chk_kv, dim3(4, NSAMP), dim3(256), 0, stream, (const bf16*)OBp, (const float*)rstd2, a.in[I_KVNORM], a.in[I_WUV], (const bf16*)V1p, 0, stats, 10); break;
            case 8: hipLaunchKernelGGL(k_chk_mla, dim3(64 * 16), dim3(256), 0, stream, (const bf16*)Q1p, (const bf16*)K1p, (const bf16*)V1p, a.in[I_T5], (const bf16*)OBp, stats, 11); break;
            case 9: hipLaunchKernelGGL((k_chk_lin<1, 0>), dim3(4, NSAMP), dim3(256), 0, stream, (const void*)OBp, D, 0, (const float*)nullptr, (const float*)nullptr, a.in[I_OWOUT], D, D, D, (const float*)save, D, 1, (const void*)outp, D, 1.0f, stats, 12); break;
            case 10: hipLaunchKernelGGL(k_rowrstd, dim3(NSAMP), dim3(64), 0, stream, (const float*)outp, D, D, 0, rstd);
                hipLaunchKernelGGL(k_chk_swiglu, dim3(11, NSAMP), dim3(256), 0, stream, (const float*)outp, (const float*)rstd, a.in[I_FNORM] + D, a.in[I_WG] + (size_t)D * FF, a.in[I_WU] + (size_t)D * FF, (const bf16*)BIGp, stats, 13); break;
            case 11: hipLaunchKernelGGL((k_chk_lin<1, 0>), dim3(4, NSAMP), dim3(256), 0, stream, (const void*)BIGp, FF, 0, (const float*)nullptr, (const float*)nullptr, a.in[I_WD] + (size_t)FF * D, D, FF, D, (const float*)save, D, 1, (const void*)outp, D, 1.0f, stats, 14); break;
            case 12: hipLaunchKernelGGL(k_rowrstd, dim3(NSAMP), dim3(64), 0, stream, (const float*)save, D, D, 1, rstd);
                hipLaunchKernelGGL(k_chk_final, dim3(NSAMP), dim3(256), 0, stream, (const float*)save, (const float*)rstd, a.in[I_FINAL], (const float*)outp, stats, 15); break;
            default: break;
            }
        }
        hipLaunchKernelGGL(k_finalize, dim3(1), dim3(64), 0, stream, (const float*)stats, outp, DBG_TOL, DBG_MAGSLOT);
    }
#else
    a.ph_lo = 0; a.ph_hi = NPH;
    hipLaunchKernelGGL(fwd_kernel, dim3(grid), dim3(NWAVES * 64), LDS_BYTES, stream, a);
#endif
}
```

```cpp
#include <hip/hip_runtime.h>
#include <cstdio>
#include <cstdint>

#ifndef DBG_CHECK
#define DBG_CHECK 0
#endif
#ifndef DBG_CHECK_NOFUSE
#define FUSE_FINAL_NORM 1
#endif
#ifndef DBG_TOL
#define DBG_TOL 0.03f
#endif
#ifndef DBG_MAGSLOT
#define DBG_MAGSLOT 0
#endif

#define LAS __attribute__((address_space(3)))
#define GAS __attribute__((address_space(1)))
typedef unsigned short bf16;
typedef short bf16x8 __attribute__((ext_vector_type(8)));
typedef short s16x4 __attribute__((ext_vector_type(4)));
typedef float f32x4 __attribute__((ext_vector_type(4)));
typedef float f32x16 __attribute__((ext_vector_type(16)));
typedef unsigned u32x4 __attribute__((ext_vector_type(4)));
typedef unsigned u32x2 __attribute__((ext_vector_type(2)));
typedef float f32x2_t __attribute__((ext_vector_type(2)));
typedef __bf16 bf16x2_t __attribute__((ext_vector_type(2)));

constexpr int S = 16384, D = 1024, FF = 2816, NQKV = 3072;
constexpr int NIN1 = 544, NIN1P = 768, QL = 384, KVL = 128, KVLP = 256, NQ1 = 1536, NKV1 = 2048, KPITCH = 1536  ;
constexpr float RMS_EPS = 1e-6f, LOG2E = 1.4426950408889634f;
constexpr float C2_LOCAL = 0.125f * LOG2E;
constexpr float C2_MLA = 0.10206207261596577f * LOG2E;
constexpr float NEGB = -1e30f;

constexpr size_t MiB = 1u << 20;
constexpr size_t WS_CTL = 0, CTL_ZERO_BYTES = 1 * MiB;
constexpr size_t CTL_BAR = 16384;
constexpr size_t CTL_PANEL = 96 * 1024;
constexpr size_t CTL_SPLIT = 112 * 1024;
constexpr size_t CTL_SS = 128 * 1024;
constexpr size_t CTL_STATS = 600 * 1024;
constexpr size_t CTL_RSTD = 640 * 1024;
constexpr size_t WS_ROPE = 1 * MiB;
constexpr size_t WS_TDIL = 3 * MiB;
constexpr size_t WS_TMLA = 3 * MiB + 128 * 1024;
constexpr size_t WS_TRPB = 3 * MiB + 256 * 1024;
constexpr size_t WS_W = 8 * MiB;
constexpr size_t W_IN0 = WS_W, W_OUT0 = W_IN0 + 6 * MiB, W_GU0 = W_OUT0 + 2 * MiB, W_D0 = W_GU0 + 11 * MiB, W_IN1 = W_D0 + 6 * MiB,
                 W_UQ = W_IN1 + 2 * MiB, W_UKV = W_UQ + 2 * MiB, W_OUT1 = W_UKV + 1 * MiB, W_GU1 = W_OUT1 + 2 * MiB, W_D1 = W_GU1 + 11 * MiB, W_END = W_D1 + 6 * MiB;
constexpr size_t WS_XB = 57 * MiB;
constexpr size_t WS_O = 89 * MiB;
constexpr size_t WS_BIG = 121 * MiB;
constexpr size_t WS_Q1 = WS_BIG, WS_K1 = WS_BIG + 48 * MiB, WS_V1 = 217 * MiB;
constexpr size_t WS_SAVE = 252 * MiB, WS_END = 256 * MiB;
static_assert(W_END <= WS_XB && WS_V1 + 32 * MiB <= WS_SAVE, "d_ws map");

constexpr int LDS_BYTES = 147456;
constexpr int MISC_OFF = 131072 + 320;
constexpr int LDSCTL_OFF = 131072;

__device__ __forceinline__ float bf2f(unsigned short b) { return __builtin_bit_cast(float, (unsigned)b << 16); }
__device__ __forceinline__ unsigned cvtpk(float lo, float hi) { f32x2_t v = {lo, hi}; bf16x2_t b = __builtin_convertvector(v, bf16x2_t); return __builtin_bit_cast(unsigned, b); }
__device__ __forceinline__ float wave_sum(float v) {
#pragma unroll
    for (int o = 1; o < 64; o <<= 1) v += __shfl_xor(v, o);
    return v;
}

namespace pg8 {
constexpr int BM = 256, BK = 64, HALF = 128, HTB = HALF * BK * 2, STAGE_BYTES = 8 * HTB, NXCD = 8, WGM = 8;
__host__ __device__ __forceinline__ int lds_byte(int r, int c) { const int st = (r >> 4) * 2 + (c >> 5), rr = r & 15, cc = c & 31, ob = rr * 64 + cc * 2; return st * 1024 + (ob ^ (((ob >> 9) & 1) << 5)); }
__host__ __device__ __forceinline__ void stage_rc(int b, int& R, int& C) { const int st = b / 1024, sb = b % 1024, swz = sb ^ (((sb >> 9) & 1) << 5); R = (st >> 1) * 16 + swz / 64; C = (st & 1) * 32 + (swz % 64) / 2; }
__host__ __device__ __forceinline__ int perm32(int rho) { const int n = rho >> 4, i = rho & 15; return 8 * (i >> 2) + 4 * n + (i & 3); }

struct Unit { int pm, pn; };
struct Gemm { const bf16* A; const bf16* Bt; int M, N, K, lda; int ldb = 0; };

struct StaticOrder {
    int nM, nN, nwg, G, c, lo, hi;
    __device__ void init(int M, int N, int G_, int c_) { nM = M / BM; nN = N / BM; nwg = nM * nN; G = G_; c = c_; lo = 0; hi = nwg; }
    __device__ bool next(int i, Unit& u) const {
        const long L = (long)lo + (long)i * G + c; if (L >= hi) return false;
        int wgid = (int)L; { const int q = nwg / NXCD, r = nwg % NXCD, xcd = wgid % NXCD, off = wgid / NXCD; wgid = (xcd < r ? xcd * (q + 1) : r * (q + 1) + (xcd - r) * q) + off; }
        const int nig = WGM * nN, gid = wgid / nig, fm = gid * WGM, gsz = (nM - fm) < WGM ? (nM - fm) : WGM;
        u.pm = fm + ((wgid % nig) % gsz); u.pn = (wgid % nig) / gsz; return true;
    }
};

typedef f32x4 Acc[2][2][4][2];

struct EpiRowScale {
    bf16* O; int ldc; const float* ss; float invk; int qscale;
    __device__ __forceinline__ void operator()(const Acc& acc, const Unit& u, int wr, int wc, int fr, int fq) const {
        const int row0 = u.pm * BM + wr * 64 + fr, col0 = u.pn * BM + wc * 32 + 8 * fq;
#pragma unroll
        for (int ai = 0; ai < 2; ++ai)
#pragma unroll
            for (int m = 0; m < 4; ++m) { const int row = row0 + ai * HALF + m * 16; const float rs = __builtin_amdgcn_rsqf(ss[row] * invk + RMS_EPS) * ((qscale && (u.pn < 2 || (u.pn & ~1) == 6)) ? C2_LOCAL : 1.0f);
                bf16* rowp = O + (size_t)row * ldc + col0;
#pragma unroll
                for (int bj = 0; bj < 2; ++bj) { const f32x4 v0 = acc[ai][bj][m][0] * rs, v1 = acc[ai][bj][m][1] * rs;
                    u32x4 w; w.x = cvtpk(v0[0], v0[1]); w.y = cvtpk(v0[2], v0[3]); w.z = cvtpk(v1[0], v1[1]); w.w = cvtpk(v1[2], v1[3]);
                    *(u32x4*)(rowp + bj * HALF) = w; } }
    }
};
struct EpiResid {
    const float* R; const bf16* R16; float* X; bf16* XB; float* ssout;
    __device__ __forceinline__ void operator()(const Acc& acc, const Unit& u, int wr, int wc, int fr, int fq) const {
        const int row0 = u.pm * BM + wr * 64 + fr, col0 = u.pn * BM + wc * 32 + 8 * fq;
#pragma unroll
        for (int ai = 0; ai < 2; ++ai)
#pragma unroll
            for (int m = 0; m < 4; ++m) { const int row = row0 + ai * HALF + m * 16; const size_t off = (size_t)row * D + col0; float sq = 0.f;
#pragma unroll
                for (int bj = 0; bj < 2; ++bj) { f32x4 r0, r1;
                    if (R) { r0 = *(const f32x4*)(R + off + bj * HALF); r1 = *(const f32x4*)(R + off + bj * HALF + 4); }
                    else { const u32x4 rb = *(const u32x4*)(R16 + off + bj * HALF);
                        r0 = (f32x4){__builtin_bit_cast(float, rb.x << 16), __builtin_bit_cast(float, rb.x & 0xffff0000u), __builtin_bit_cast(float, rb.y << 16), __builtin_bit_cast(float, rb.y & 0xffff0000u)};
                        r1 = (f32x4){__builtin_bit_cast(float, rb.z << 16), __builtin_bit_cast(float, rb.z & 0xffff0000u), __builtin_bit_cast(float, rb.w << 16), __builtin_bit_cast(float, rb.w & 0xffff0000u)}; }
                    const f32x4 v0 = acc[ai][bj][m][0] + r0, v1 = acc[ai][bj][m][1] + r1;
                    if (X) { *(f32x4*)(X + off + bj * HALF) = v0; *(f32x4*)(X + off + bj * HALF + 4) = v1; }
                    u32x4 w; w.x = cvtpk(v0[0], v0[1]); w.y = cvtpk(v0[2], v0[3]); w.z = cvtpk(v1[0], v1[1]); w.w = cvtpk(v1[2], v1[3]);
                    *(u32x4*)(XB + off + bj * HALF) = w;
                    sq += (v0[0] * v0[0] + v0[1] * v0[1]) + (v0[2] * v0[2] + v0[3] * v0[3]) + (v1[0] * v1[0] + v1[1] * v1[1]) + (v1[2] * v1[2] + v1[3] * v1[3]); }
                sq += __shfl_xor(sq, 16); sq += __shfl_xor(sq, 32);
                if (fq == 0) atomicAdd(ssout + row, sq); }
    }
};
struct EpiFinal {
    const float* R; const bf16* R16; float* OUT; float* ss; unsigned* cnt; const float* gf;
    __device__ __forceinline__ void operator()(const Acc& acc, const Unit& u, int wr, int wc, int fr, int fq) const {
        const int row0 = u.pm * BM + wr * 64 + fr, col0 = u.pn * BM + wc * 32 + 8 * fq;
        f32x4 xv[2][2][4][2];
#pragma unroll
        for (int ai = 0; ai < 2; ++ai)
#pragma unroll
            for (int m = 0; m < 4; ++m) { const int row = row0 + ai * HALF + m * 16; const size_t off = (size_t)row * D + col0; float sq = 0.f;
#pragma unroll
                for (int bj = 0; bj < 2; ++bj) { f32x4 r0, r1;
                    if (R) { r0 = *(const f32x4*)(R + off + bj * HALF); r1 = *(const f32x4*)(R + off + bj * HALF + 4); }
                    else { const u32x4 rb = *(const u32x4*)(R16 + off + bj * HALF);
                        r0 = (f32x4){__builtin_bit_cast(float, rb.x << 16), __builtin_bit_cast(float, rb.x & 0xffff0000u), __builtin_bit_cast(float, rb.y << 16), __builtin_bit_cast(float, rb.y & 0xffff0000u)};
                        r1 = (f32x4){__builtin_bit_cast(float, rb.z << 16), __builtin_bit_cast(float, rb.z & 0xffff0000u), __builtin_bit_cast(float, rb.w << 16), __builtin_bit_cast(float, rb.w & 0xffff0000u)}; }
                    const f32x4 v0 = acc[ai][bj][m][0] + r0, v1 = acc[ai][bj][m][1] + r1; xv[ai][bj][m][0] = v0; xv[ai][bj][m][1] = v1;
                    sq += (v0[0] * v0[0] + v0[1] * v0[1]) + (v0[2] * v0[2] + v0[3] * v0[3]) + (v1[0] * v1[0] + v1[1] * v1[1]) + (v1[2] * v1[2] + v1[3] * v1[3]); }
                sq += __shfl_xor(sq, 16); sq += __shfl_xor(sq, 32);
                if (fq == 0) atomicAdd(ss + row, sq); }
        asm volatile("s_waitcnt vmcnt(0)" ::: "memory");
        __syncthreads();
        unsigned* c = cnt + 64 * u.pm;
        if (threadIdx.x == 0) {
            __builtin_amdgcn_fence(__ATOMIC_RELEASE, "agent");
            asm volatile("s_waitcnt vmcnt(0)" ::: "memory");
            __hip_atomic_fetch_add(c, 1u, __ATOMIC_RELAXED, __HIP_MEMORY_SCOPE_AGENT);
            unsigned sp = 0;
            while (__hip_atomic_load(c, __ATOMIC_RELAXED, __HIP_MEMORY_SCOPE_AGENT) < 4u) { __builtin_amdgcn_s_sleep(2); if (++sp > (1u << 22)) break; }
            __builtin_amdgcn_fence(__ATOMIC_ACQUIRE, "agent");
            asm volatile("s_waitcnt vmcnt(0)" ::: "memory");
        }
        __syncthreads();
        f32x4 g0[2], g1[2];
#pragma unroll
        for (int bj = 0; bj < 2; ++bj) { g0[bj] = *(const f32x4*)(gf + col0 + bj * HALF); g1[bj] = *(const f32x4*)(gf + col0 + bj * HALF + 4); }
#pragma unroll
        for (int ai = 0; ai < 2; ++ai)
#pragma unroll
            for (int m = 0; m < 4; ++m) { const int row = row0 + ai * HALF + m * 16; const size_t off = (size_t)row * D + col0;
                const float tot = __hip_atomic_load(ss + row, __ATOMIC_RELAXED, __HIP_MEMORY_SCOPE_AGENT);
                const float rs = 1.0f / sqrtf(tot * (1.0f / D) + RMS_EPS);
#pragma unroll
                for (int bj = 0; bj < 2; ++bj) { *(f32x4*)(OUT + off + bj * HALF) = xv[ai][bj][m][0] * rs * g0[bj]; *(f32x4*)(OUT + off + bj * HALF + 4) = xv[ai][bj][m][1] * rs * g1[bj]; } }
    }
};
__device__ __forceinline__ char* uni_ptr(const void* p) { const unsigned long long b = (unsigned long long)p; const unsigned lo = __builtin_amdgcn_readfirstlane((unsigned)b), hi = __builtin_amdgcn_readfirstlane((unsigned)(b >> 32)); return (char*)(((unsigned long long)hi << 32) | lo); }
struct EpiPartStore {
    float* part; unsigned* flag;
    __device__ __forceinline__ void operator()(const Acc& acc, const Unit&, int, int, int, int) const {
        char* pb = uni_ptr(part); const unsigned lo = threadIdx.x * 16u;
        asm volatile("s_nop 15\n\ts_nop 15" ::: "memory");
#pragma unroll
        for (int ai = 0; ai < 2; ++ai)
#pragma unroll
            for (int bj = 0; bj < 2; ++bj)
#pragma unroll
                for (int m = 0; m < 4; ++m)
#pragma unroll
                    for (int n = 0; n < 2; ++n) asm volatile("global_store_dwordx4 %0, %1, %2 sc0 sc1" :: "v"(lo), "v"(acc[ai][bj][m][n]), "s"(uni_ptr(pb + (((ai * 2 + bj) * 4 + m) * 2 + n) * 8192)) : "memory");
        asm volatile("s_waitcnt vmcnt(0)" ::: "memory");
        __syncthreads();
        if (threadIdx.x == 0) __hip_atomic_store(flag, 1u, __ATOMIC_RELAXED, __HIP_MEMORY_SCOPE_AGENT);
    }
};
template <class Base>
struct EpiJoin {
    Base base; const float* part; unsigned* flag;
    __device__ __forceinline__ void operator()(const Acc& acc_, const Unit& u, int wr, int wc, int fr, int fq) const {
        if (threadIdx.x == 0) { unsigned sp = 0; while (__hip_atomic_load(flag, __ATOMIC_RELAXED, __HIP_MEMORY_SCOPE_AGENT) == 0u) { __builtin_amdgcn_s_sleep(2); if (++sp > (1u << 22)) break; } }
        __syncthreads();
        Acc& acc = const_cast<Acc&>(acc_);
        const char* pb = uni_ptr(part); const unsigned lo = threadIdx.x * 16u;
#pragma unroll
        for (int ai = 0; ai < 2; ++ai)
#pragma unroll
            for (int bj = 0; bj < 2; ++bj) {
                const char* gb = uni_ptr(pb + (ai * 2 + bj) * 65536);
                f32x4 t0, t1, t2, t3, t4, t5, t6, t7;
                asm volatile("global_load_dwordx4 %0, %8, %9 sc0 sc1\n\tglobal_load_dwordx4 %1, %8, %10 sc0 sc1\n\tglobal_load_dwordx4 %2, %8, %11 sc0 sc1\n\tglobal_load_dwordx4 %3, %8, %12 sc0 sc1\n\t"
                             "global_load_dwordx4 %4, %8, %13 sc0 sc1\n\tglobal_load_dwordx4 %5, %8, %14 sc0 sc1\n\tglobal_load_dwordx4 %6, %8, %15 sc0 sc1\n\tglobal_load_dwordx4 %7, %8, %16 sc0 sc1\n\ts_waitcnt vmcnt(0)"
                             : "=&v"(t0), "=&v"(t1), "=&v"(t2), "=&v"(t3), "=&v"(t4), "=&v"(t5), "=&v"(t6), "=&v"(t7)
                             : "v"(lo), "s"(gb), "s"(gb + 8192), "s"(gb + 16384), "s"(gb + 24576), "s"(gb + 32768), "s"(gb + 40960), "s"(gb + 49152), "s"(gb + 57344) : "memory");
                acc[ai][bj][0][0] += t0; acc[ai][bj][0][1] += t1; acc[ai][bj][1][0] += t2; acc[ai][bj][1][1] += t3; acc[ai][bj][2][0] += t4; acc[ai][bj][2][1] += t5; acc[ai][bj][3][0] += t6; acc[ai][bj][3][1] += t7; }
        base(acc, u, wr, wc, fr, fq);
    }
};
template <class Base>
struct EpiSplit {
    Base base; float* part; unsigned* flag; bool helper;
    __device__ __forceinline__ void operator()(const Acc& acc, const Unit& u, int wr, int wc, int fr, int fq) const {
        if (helper) EpiPartStore{part, flag}(acc, u, wr, wc, fr, fq); else EpiJoin<Base>{base, part, flag}(acc, u, wr, wc, fr, fq);
    }
};
struct EpiSwiGLU {
    bf16* O; const float* ss;
    __device__ __forceinline__ void operator()(const Acc& acc, const Unit& u, int wr, int wc, int fr, int fq) const {
        const int row0 = u.pm * BM + wr * 64 + fr, col0 = u.pn * HALF + wc * 32 + 8 * fq;
#pragma unroll
        for (int ai = 0; ai < 2; ++ai)
#pragma unroll
            for (int m = 0; m < 4; ++m) { const int row = row0 + ai * HALF + m * 16; const float rs = __builtin_amdgcn_rsqf(ss[row] * (1.0f / D) + RMS_EPS);
                float a[8];
#pragma unroll
                for (int n = 0; n < 2; ++n)
#pragma unroll
                    for (int e = 0; e < 4; ++e) { const float g = acc[ai][0][m][n][e] * rs, up = acc[ai][1][m][n][e] * rs;
                        a[4 * n + e] = g * __builtin_amdgcn_rcpf(1.0f + __builtin_amdgcn_exp2f(-LOG2E * g)) * up; }
                u32x4 w; w.x = cvtpk(a[0], a[1]); w.y = cvtpk(a[2], a[3]); w.z = cvtpk(a[4], a[5]); w.w = cvtpk(a[6], a[7]);
                *(u32x4*)(O + (size_t)row * FF + col0) = w; }
    }
};
__device__ __forceinline__ void rope8(float (&v)[8], const float* cs_row  , int fq) {
    const int f0 = 8 * (fq & 1);
#pragma unroll
    for (int e = 0; e < 8; ++e) { const float other = __shfl_xor(v[e], 32); const float c = cs_row[2 * (f0 + e)], s = cs_row[2 * (f0 + e) + 1];
        v[e] = (fq < 2) ? (v[e] * c - other * s) : (other * s + v[e] * c); }
}
struct EpiMlaIn {
    bf16* P; const float* ss; float* ssq; float* sskv; bf16* KF; const float* cs;
    __device__ __forceinline__ void operator()(const Acc& acc, const Unit& u, int wr, int wc, int fr, int fq) const {
        const int row0 = u.pm * BM + wr * 64 + fr, col0 = u.pn * BM + wc * 32 + 8 * fq;
#pragma unroll
        for (int ai = 0; ai < 2; ++ai)
#pragma unroll
            for (int m = 0; m < 4; ++m) { const int row = row0 + ai * HALF + m * 16; const float rs = __builtin_amdgcn_rsqf(ss[row] * (1.0f / D) + RMS_EPS);
                bf16* rowp = P + (size_t)row * NIN1P + col0;
                if (u.pn < 2) {
                    float sq[2];
#pragma unroll
                    for (int bj = 0; bj < 2; ++bj) { const f32x4 v0 = acc[ai][bj][m][0] * rs, v1 = acc[ai][bj][m][1] * rs;
                        u32x4 w; w.x = cvtpk(v0[0], v0[1]); w.y = cvtpk(v0[2], v0[3]); w.z = cvtpk(v1[0], v1[1]); w.w = cvtpk(v1[2], v1[3]);
                        *(u32x4*)(rowp + bj * HALF) = w;
                        sq[bj] = (v0[0] * v0[0] + v0[1] * v0[1]) + (v0[2] * v0[2] + v0[3] * v0[3]) + (v1[0] * v1[0] + v1[1] * v1[1]) + (v1[2] * v1[2] + v1[3] * v1[3]); }
                    float sa = (u.pn == 0) ? sq[0] + sq[1] : sq[0], sb = (u.pn == 0) ? 0.f : sq[1];
                    sa += __shfl_xor(sa, 16); sa += __shfl_xor(sa, 32); sb += __shfl_xor(sb, 16); sb += __shfl_xor(sb, 32);
                    if (fq == 0) { atomicAdd(ssq + row, sa); if (u.pn == 1) atomicAdd(sskv + row, sb); }
                } else {
                    const u32x4 z = {0u, 0u, 0u, 0u};
                    *(u32x4*)(rowp) = z; *(u32x4*)(rowp + HALF) = z;
                    if (wc == 0) {
                        float v[8];
#pragma unroll
                        for (int n = 0; n < 2; ++n)
#pragma unroll
                            for (int e = 0; e < 4; ++e) v[4 * n + e] = acc[ai][0][m][n][e] * rs;
                        rope8(v, cs + (size_t)row * 32, fq);
                        u32x4 w; w.x = cvtpk(v[0], v[1]); w.y = cvtpk(v[2], v[3]); w.z = cvtpk(v[4], v[5]); w.w = cvtpk(v[6], v[7]);
                        bf16* kp = KF + (size_t)row * KPITCH + 64 + 8 * fq;
#pragma unroll
                        for (int h = 0; h < 16; ++h) *(u32x4*)(kp + h * 96) = w;
                    }
                } }
    }
};
struct EpiMlaQ {
    bf16* Q; const float* ssq; const float* cs;
    __device__ __forceinline__ void operator()(const Acc& acc, const Unit& u, int wr, int wc, int fr, int fq) const {
        const int row0 = u.pm * BM + wr * 64 + fr;
#pragma unroll
        for (int ai = 0; ai < 2; ++ai)
#pragma unroll
            for (int m = 0; m < 4; ++m) { const int row = row0 + ai * HALF + m * 16; const float rs = __builtin_amdgcn_rsqf(ssq[row] * (1.0f / QL) + RMS_EPS);
#pragma unroll
                for (int bj = 0; bj < 2; ++bj) { const int g0 = u.pn * BM + bj * HALF + wc * 32;
                    float v[8];
#pragma unroll
                    for (int n = 0; n < 2; ++n)
#pragma unroll
                        for (int e = 0; e < 4; ++e) v[4 * n + e] = acc[ai][bj][m][n][e] * rs;
                    if ((g0 % 96) == 64) rope8(v, cs + (size_t)row * 32, fq);
                    u32x4 w; w.x = cvtpk(v[0] * C2_MLA, v[1] * C2_MLA); w.y = cvtpk(v[2] * C2_MLA, v[3] * C2_MLA); w.z = cvtpk(v[4] * C2_MLA, v[5] * C2_MLA); w.w = cvtpk(v[6] * C2_MLA, v[7] * C2_MLA);
                    *(u32x4*)(Q + (size_t)row * NQ1 + g0 + 8 * fq) = w; } }
    }
};
struct EpiMlaKV {
    bf16* KF; bf16* V; const float* sskv;
    __device__ __forceinline__ void operator()(const Acc& acc, const Unit& u, int wr, int wc, int fr, int fq) const {
        const int row0 = u.pm * BM + wr * 64 + fr;
#pragma unroll
        for (int ai = 0; ai < 2; ++ai)
#pragma unroll
            for (int m = 0; m < 4; ++m) { const int row = row0 + ai * HALF + m * 16; const float rs = __builtin_amdgcn_rsqf(sskv[row] * (1.0f / KVL) + RMS_EPS);
#pragma unroll
                for (int bj = 0; bj < 2; ++bj) { const int col = u.pn * BM + bj * HALF + wc * 32 + 8 * fq;
                    const f32x4 v0 = acc[ai][bj][m][0] * rs, v1 = acc[ai][bj][m][1] * rs;
                    u32x4 w; w.x = cvtpk(v0[0], v0[1]); w.y = cvtpk(v0[2], v0[3]); w.z = cvtpk(v1[0], v1[1]); w.w = cvtpk(v1[2], v1[3]);
                    bf16* dst = (col < 1024) ? KF + (size_t)row * KPITCH + (col >> 6) * 96 + (col & 63) : V + (size_t)row * D + (col - 1024);
                    *(u32x4*)dst = w; } }
    }
};

template <class Epi, bool ALIGN_EPI>
__device__ __forceinline__ void gemm_phase(LAS unsigned char* lds, const Gemm g, const StaticOrder& S, const Epi& E) {
    const int tid = threadIdx.x, wid = __builtin_amdgcn_readfirstlane(tid >> 6), lane = tid & 63, wr = wid >> 2, wc = wid & 3, fr = lane & 15, fq = lane >> 4;
    const int K = g.K, nt = K / BK, lda = g.lda, ldb = g.ldb ? g.ldb : g.K;
    unsigned voffA[2], voffB[2];
#pragma unroll
    for (int i = 0; i < 2; ++i) { int R, C; stage_rc(tid * 16 + i * 8192, R, C); const int Rb = (R & ~31) + perm32(R & 31);
        voffA[i] = (unsigned)(R * lda + C) * 2u; voffB[i] = (unsigned)(Rb * ldb + C) * 2u; }
    const size_t kstep = (size_t)(BK * 2);
    const size_t hsA = (size_t)HALF * lda * 2, hsB = (size_t)HALF * ldb * 2, tsA = 2 * hsA, tsB = 2 * hsB;
    const unsigned ldsw = (unsigned)wid * 1024u;
    const int aoff = lds_byte(wr * 64 + fr, fq * 8), boff = lds_byte(wc * 32 + fr, fq * 8);
#define PG8_SA(b, h) (((b) * 2 + (h)) * HTB)
#define PG8_SB(b, h) ((4 + (b) * 2 + (h)) * HTB)
#define PG8_STAGE(bufoff, gbase, voff) do { _Pragma("unroll") for (int _i = 0; _i < 2; ++_i) \
        __builtin_amdgcn_global_load_lds((const unsigned*)((const char*)(gbase) + (voff)[_i]), (LAS unsigned*)(lds + (bufoff) + ldsw + _i * 8192), 16, 0, 0); } while (0)
#define PG8_LDA(dst, b, h) do { _Pragma("unroll") for (int m = 0; m < 4; ++m) _Pragma("unroll") for (int k = 0; k < 2; ++k) dst[m][k] = *(const LAS bf16x8*)(lds + PG8_SA(b, h) + aoff + m * 2048 + k * 1024); } while (0)
#define PG8_LDB(dst, b, h) do { _Pragma("unroll") for (int n = 0; n < 2; ++n) _Pragma("unroll") for (int k = 0; k < 2; ++k) dst[n][k] = *(const LAS bf16x8*)(lds + PG8_SB(b, h) + boff + n * 2048 + k * 1024); } while (0)
#define PG8_MMA(ai, bj, At, Bt) do { __builtin_amdgcn_s_setprio(1); _Pragma("unroll") for (int m = 0; m < 4; ++m) _Pragma("unroll") for (int n = 0; n < 2; ++n) _Pragma("unroll") for (int k = 0; k < 2; ++k) \
        acc[ai][bj][m][n] = __builtin_amdgcn_mfma_f32_16x16x32_bf16(Bt[n][k], At[m][k], acc[ai][bj][m][n], 0, 0, 0); __builtin_amdgcn_s_setprio(0); } while (0)
#define PG8_WAIT_V(n) asm volatile("s_waitcnt vmcnt(" #n ")" ::: "memory")
#define PG8_WAIT_L(n) asm volatile("s_waitcnt lgkmcnt(" #n ")" ::: "memory")
#define PG8_BAR __builtin_amdgcn_s_barrier()
#define PG8_SCHED __builtin_amdgcn_sched_barrier(0)
    Unit cur, nxt; int ui = 0;
    if (!S.next(0, cur)) return;
    Acc acc;
#pragma unroll
    for (int a = 0; a < 2; ++a)
#pragma unroll
        for (int b = 0; b < 2; ++b)
#pragma unroll
            for (int m = 0; m < 4; ++m)
#pragma unroll
                for (int n = 0; n < 2; ++n) acc[a][b][m][n] = (f32x4){0.f, 0.f, 0.f, 0.f};
    bf16x8 At[4][2], B0[2][2], B1[2][2];
    const char* cA = (const char*)g.A + (size_t)cur.pm * tsA; const char* cB = (const char*)g.Bt + (size_t)cur.pn * tsB;
    PG8_STAGE(PG8_SB(0, 0), cB, voffB); PG8_STAGE(PG8_SB(0, 1), cB + hsB, voffB); PG8_STAGE(PG8_SA(0, 0), cA, voffA); PG8_STAGE(PG8_SA(0, 1), cA + hsA, voffA);
    if (wr == 1) PG8_BAR;
    PG8_WAIT_V(2); PG8_BAR;
    PG8_STAGE(PG8_SB(1, 0), cB + kstep, voffB); PG8_STAGE(PG8_SA(1, 0), cA + kstep, voffA); PG8_STAGE(PG8_SB(1, 1), cB + hsB + kstep, voffB);
    PG8_WAIT_V(6); PG8_BAR;
    for (;;) {
        const bool has_next = S.next(ui + 1, nxt);
        const char* nA = has_next ? (const char*)g.A + (size_t)nxt.pm * tsA : cA; const char* nB = has_next ? (const char*)g.Bt + (size_t)nxt.pn * tsB : cB;
#pragma unroll 1
        for (int t = 0; t < nt; t += 2) {
            const bool last = (t == nt - 2);
            const char* a1 = cA + (size_t)(t + 1) * kstep;
            const char* a2 = last ? nA : cA + (size_t)(t + 2) * kstep; const char* b2 = last ? nB : cB + (size_t)(t + 2) * kstep;
            const char* a3 = a2 + kstep; const char* b3 = b2 + kstep;
            PG8_LDB(B0, 0, 0); PG8_LDB(B1, 0, 1); PG8_SCHED; PG8_LDA(At, 0, 0); PG8_STAGE(PG8_SA(1, 1), a1 + hsA, voffA);
            PG8_WAIT_V(8); PG8_WAIT_L(0); PG8_BAR; PG8_MMA(0, 0, At, B0); PG8_MMA(0, 1, At, B1); PG8_BAR; PG8_SCHED;
            PG8_LDA(At, 0, 1); PG8_STAGE(PG8_SB(0, 0), b2, voffB); PG8_STAGE(PG8_SB(0, 1), b2 + hsB, voffB); PG8_STAGE(PG8_SA(0, 0), a2, voffA);
            PG8_WAIT_V(8); PG8_WAIT_L(0); PG8_BAR; PG8_MMA(1, 0, At, B0); PG8_MMA(1, 1, At, B1); PG8_BAR; PG8_SCHED;
            PG8_LDB(B0, 1, 0); PG8_LDB(B1, 1, 1); PG8_SCHED; PG8_LDA(At, 1, 0); PG8_STAGE(PG8_SA(0, 1), a2 + hsA, voffA);
            PG8_WAIT_V(8); PG8_WAIT_L(0); PG8_BAR; PG8_MMA(0, 0, At, B0); PG8_MMA(0, 1, At, B1); PG8_BAR; PG8_SCHED;
            PG8_LDA(At, 1, 1); PG8_STAGE(PG8_SB(1, 0), b3, voffB); PG8_STAGE(PG8_SB(1, 1), b3 + hsB, voffB); PG8_STAGE(PG8_SA(1, 0), a3, voffA);
            PG8_WAIT_V(8); PG8_WAIT_L(0); PG8_BAR; PG8_MMA(1, 0, At, B0); PG8_MMA(1, 1, At, B1); PG8_BAR; PG8_SCHED;
        }
        if constexpr (ALIGN_EPI) { if (wr == 0) PG8_BAR; }
        E(acc, cur, wr, wc, fr, fq);
        if (!has_next) break;
#pragma unroll
        for (int a = 0; a < 2; ++a)
#pragma unroll
            for (int b = 0; b < 2; ++b)
#pragma unroll
                for (int m = 0; m < 4; ++m)
#pragma unroll
                    for (int n = 0; n < 2; ++n) acc[a][b][m][n] = (f32x4){0.f, 0.f, 0.f, 0.f};
        cur = nxt; cA = nA; cB = nB; ++ui;
        if constexpr (ALIGN_EPI) { if (wr == 1) PG8_BAR; }
    }
    PG8_WAIT_V(0);
    if constexpr (!ALIGN_EPI) { if (wr == 0) PG8_BAR; }
    PG8_BAR;
#undef PG8_SA
#undef PG8_SB
#undef PG8_STAGE
#undef PG8_LDA
#undef PG8_LDB
#undef PG8_MMA
#undef PG8_WAIT_V
#undef PG8_WAIT_L
#undef PG8_BAR
#undef PG8_SCHED
}
}

typedef GAS unsigned gu32;
#define RLX_AGENT __ATOMIC_RELAXED, __HIP_MEMORY_SCOPE_AGENT
#define LDS_WAIT() asm volatile("s_waitcnt lgkmcnt(0)" ::: "memory")
#define VM_WAIT() asm volatile("s_waitcnt vmcnt(0)" ::: "memory")
#define XB_TMO      128
#define XB_XCNT(j)  (256  + 64 * (j))
#define XB_XSUB(j)  (1280 + 64 * (j))
#define XB_XGEN(j)  (2304 + 64 * (j))
#define XB_TOP      3328
#define XB_TOPGEN   3392
#define XCD_BAR_WORDS 3456
#define XB_SPIN_CAP (1u << 18)
__device__ __forceinline__ unsigned xb_ld(unsigned* p)              { return __hip_atomic_load(p, __ATOMIC_RELAXED, __HIP_MEMORY_SCOPE_AGENT); }
__device__ __forceinline__ unsigned xb_add(unsigned* p, unsigned v) { return __hip_atomic_fetch_add(p, v, __ATOMIC_RELAXED, __HIP_MEMORY_SCOPE_AGENT); }
__device__ __forceinline__ unsigned xb_xcc_id() { return (unsigned)__builtin_amdgcn_s_getreg((3 << 11) | 20) & 0xFu; }
#define XB_SPIN(cond, bar) do { unsigned _sp = 0; while (cond) { __builtin_amdgcn_s_sleep(1); \
    if ((++_sp & 255u) == 0u) { if (xb_ld(&(bar)[XB_TMO])) break; if (_sp > XB_SPIN_CAP) { atomicAdd(&(bar)[XB_TMO], 1u); break; } } } } while (0)
struct XcdBarrier { unsigned* bar; unsigned x; volatile LAS unsigned* st; };
__device__ __forceinline__ XcdBarrier xcd_barrier_post(unsigned* bar, volatile LAS unsigned* st) {
    XcdBarrier b; b.bar = bar; b.x = xb_xcc_id(); b.st = st;
    if (threadIdx.x == 0) (void)xb_add(&bar[XB_XCNT(b.x)], 1u);
    return b;
}
__device__ __forceinline__ void xcd_barrier_complete(unsigned* bar, unsigned x, unsigned& nloc, unsigned& nx) {
    const unsigned G = gridDim.x * gridDim.y * gridDim.z;
    unsigned sum, cnt, mine, sp = 0u;
    for (;;) {
        sum = 0u; cnt = 0u; mine = 0u;
#pragma unroll
        for (unsigned j = 0; j < 16; ++j) { const unsigned c = xb_ld(&bar[XB_XCNT(j)]); sum += c; cnt += (c > 0u) ? 1u : 0u; mine = (j == x) ? c : mine; }
        if (sum == G) break;
        __builtin_amdgcn_s_sleep(1);
        if ((++sp & 255u) == 0u) { if (xb_ld(&bar[XB_TMO])) break; if (sp > XB_SPIN_CAP) { atomicAdd(&bar[XB_TMO], 1u); break; } }
    }
    nloc = mine > 0u ? mine : 1u; nx = cnt > 0u ? cnt : 1u;
}
__device__ __forceinline__ void xcd_barrier(const XcdBarrier& b) {
    asm volatile("s_waitcnt vmcnt(0)" ::: "memory");
    __syncthreads();
    if (threadIdx.x == 0) {
        unsigned* bar = b.bar;
        __builtin_amdgcn_s_waitcnt(0);
        unsigned nloc = b.st[0], nx = b.st[1];
        if (nloc == 0u) { xcd_barrier_complete(bar, b.x, nloc, nx); b.st[0] = nloc; b.st[1] = nx; }
        const unsigned old = xb_add(&bar[XB_XSUB(b.x)], 1u);
        const unsigned gen = old / nloc;
        if (old + 1u == (gen + 1u) * nloc) {
            __builtin_amdgcn_fence(__ATOMIC_RELEASE, "agent");
            asm volatile("s_waitcnt vmcnt(0)" ::: "memory");
            const unsigned og = xb_add(&bar[XB_TOP], 1u);
            const unsigned tg = og / nx;
            if (og + 1u == (tg + 1u) * nx) xb_add(&bar[XB_TOPGEN], 1u);
            else XB_SPIN(xb_ld(&bar[XB_TOPGEN]) == tg, bar);
            __builtin_amdgcn_fence(__ATOMIC_ACQUIRE, "agent");
            xb_add(&bar[XB_XGEN(b.x)], 1u);
            asm volatile("s_waitcnt vmcnt(0)" ::: "memory");
        } else {
            XB_SPIN(xb_ld(&bar[XB_XGEN(b.x)]) == gen, bar);
            __builtin_amdgcn_fence(__ATOMIC_ACQUIRE, "agent");
            asm volatile("s_waitcnt vmcnt(0)" ::: "memory");
        }
    }
    __syncthreads();
}

__device__ __forceinline__ int t5_bucket(int rel) {
    const int n = rel < 0 ? -rel : rel;
    const float nf = (float)(n > 8 ? n : 8);
    int large = 8 + (int)(__logf(nf / 8.0f) / 4.852030263919617f * 8.0f);
    large = large < 15 ? large : 15;
    return (rel > 0 ? 16 : 0) + (n < 8 ? n : large);
}
__device__ __forceinline__ int t5_bucket_precise(int rel) {
    const int n = rel < 0 ? -rel : rel;
    const float nf = (float)(n > 8 ? n : 8);
    int large = 8 + (int)(logf(nf / 8.0f) / 4.852030263919617f * 8.0f);
    large = large < 15 ? large : 15;
    return (rel > 0 ? 16 : 0) + (n < 8 ? n : large);
}

struct Args {
    const float* in[18];
    float* out; unsigned char* ws;
    int ph_lo, ph_hi;
};
enum { I_X = 0, I_T5, I_ANORM, I_FNORM, I_EWIN, I_RPB, I_EWOUT, I_OWIN, I_QNORM, I_WUQ, I_KVNORM, I_WUK, I_WUV, I_OWOUT, I_WG, I_WU, I_WD, I_FINAL };
constexpr int NPH = 13;

__device__ __forceinline__ void p0_transpose_item(const float* W, int N, const float* gain, bf16* WT, int ldk, int dst_row0, int k0, int n0, LAS float* scr, int lane) {
    float v[32], gk[32];
#pragma unroll
    for (int i = 0; i < 32; ++i) { const int kk = 2 * i + (lane >> 5); v[i] = __builtin_nontemporal_load(W + (size_t)(k0 + kk) * N + n0 + (lane & 31)); gk[i] = gain ? gain[k0 + kk] : 1.0f; }
#pragma unroll
    for (int i = 0; i < 32; ++i) { const int kk = 2 * i + (lane >> 5); scr[kk * 33 + (lane & 31)] = v[i] * gk[i]; }
    LDS_WAIT(); asm volatile("" ::: "memory");
    const int c = lane & 7;
#pragma unroll
    for (int j = 0; j < 4; ++j) { const int n = (lane >> 3) + 8 * j; const LAS float* s = scr + (8 * c) * 33 + n;
        u32x4 o; o.x = cvtpk(s[0 * 33], s[1 * 33]); o.y = cvtpk(s[2 * 33], s[3 * 33]); o.z = cvtpk(s[4 * 33], s[5 * 33]); o.w = cvtpk(s[6 * 33], s[7 * 33]);
        *(u32x4*)(WT + (size_t)(dst_row0 + n) * ldk + k0 + 8 * c) = o; }
    LDS_WAIT(); asm volatile("" ::: "memory");
}
template <int MODE>
__device__ __forceinline__ bool p0_matrix(int& r, const float* W, int K, int N, const float* gain, bf16* WT, int ldk, int row_off, LAS float* scr, int lane) {
    const int nblk = N / 32, items = (K / 64) * nblk;
    if (r >= items) { r -= items; return false; }
    const int kb = r / nblk, nb = r % nblk, n0 = 32 * nb;
    int dr = row_off + n0;
    if (MODE != 0) dr = (n0 >> 7) * 256 + (n0 & 127) + (MODE == 2 ? 128 : 0);
    p0_transpose_item(W, N, gain, WT, ldk, dr, 64 * kb, n0, scr, lane);
    return true;
}

__device__ __forceinline__ const char* mla_sgpr_ptr(const char* p) { const unsigned long long b = (unsigned long long)p; const unsigned lo = __builtin_amdgcn_readfirstlane((unsigned)b), hi = __builtin_amdgcn_readfirstlane((unsigned)(b >> 32)); return (const char*)(((unsigned long long)hi << 32) | lo); }

namespace wattn {
__device__ __forceinline__ int crow(int r, int hi) { return (r & 3) + 8 * (r >> 2) + 4 * hi; }
typedef short v4i16_t __attribute__((ext_vector_type(4)));
__device__ __forceinline__ s16x4 vtr(const LAS unsigned char* p) { return __builtin_bit_cast(s16x4, __builtin_amdgcn_ds_read_tr16_b64_v4i16((LAS v4i16_t*)p)); }
constexpr int WREG = 16384;

template <bool SAFE, class F>
__device__ __forceinline__ bool run_unit(const F& f, const bf16* __restrict__ Qrow  , const char* __restrict__ Kbase  ,
                                         bf16* __restrict__ Orow  , LAS unsigned char* wl, int lane) {
    constexpr int ND = 4, PITCHB = NQKV * 2, TB = 8192;
    const int r32 = lane & 31, hi = lane >> 5;
    bf16x8 qf[ND];
#pragma unroll
    for (int d0 = 0; d0 < ND; ++d0) qf[d0] = *(const bf16x8*)(Qrow + 16 * d0 + 8 * hi);
    float m = NEGB, l = 0.f; f32x16 ot[2];
#pragma unroll
    for (int r = 0; r < 16; ++r) { ot[0][r] = 0.f; ot[1][r] = 0.f; }
    const int nt = f.ntiles();
    const int kg = lane >> 3, sl = lane & 7, kgv = (lane >> 2) & 7;
    const unsigned kce = (unsigned)((sl ^ (kg >> 1)) * 16), kco = kce ^ 64u;
    const unsigned vco = (unsigned)(1024 + (lane >> 5) * 64 + (lane & 3) * 16);
    const char* const Kb = mla_sgpr_ptr(Kbase);
    auto dma_tile = [&](int t, int bo) {
        LAS unsigned char* kd = wl + bo; LAS unsigned char* vd = wl + bo + 4096;
        int tb_, st_;
        if (f.affine(t, tb_, st_)) {
            const char* kt = mla_sgpr_ptr(Kbase + (size_t)tb_ * PITCHB);
            const unsigned rowk = (unsigned)(kg * st_ * PITCHB), rowv = (unsigned)(kgv * st_ * PITCHB) + vco; const unsigned stepb = (unsigned)(8 * st_ * PITCHB);
#pragma unroll
            for (int i = 0; i < 4; ++i) { const char* p = kt + (size_t)(i * stepb);
                __builtin_amdgcn_global_load_lds((const unsigned*)(p + (rowk + ((i & 1) ? kco : kce))), (LAS unsigned*)(kd + i * 1024), 16, 0, 0);
                __builtin_amdgcn_global_load_lds((const unsigned*)(p + rowv), (LAS unsigned*)(vd + i * 1024), 16, 0, 0); }
        } else {
#pragma unroll
            for (int i = 0; i < 4; ++i) { const unsigned offk = (unsigned)f.tok(t, kg + 8 * i) * (unsigned)PITCHB + ((i & 1) ? kco : kce), offv = (unsigned)f.tok(t, kgv + 8 * i) * (unsigned)PITCHB + vco;
                __builtin_amdgcn_global_load_lds((const unsigned*)(Kb + offk), (LAS unsigned*)(kd + i * 1024), 16, 0, 0);
                __builtin_amdgcn_global_load_lds((const unsigned*)(Kb + offv), (LAS unsigned*)(vd + i * 1024), 16, 0, 0); }
        }
    };
    const LAS unsigned char* kp[ND];
#pragma unroll
    for (int d0 = 0; d0 < ND; ++d0) kp[d0] = wl + r32 * 128 + (((2 * d0 + hi) ^ ((r32 >> 1) & 7)) * 16);
    const LAS unsigned char* vbase = wl + 4096 + (4 * hi + ((lane & 15) >> 2)) * 64 + ((lane >> 4) & 1) * 32 + (lane & 3) * 8;
    dma_tile(0, 0);
    if (nt > 1) dma_tile(1, TB);
    auto body = [&](int t, int bo) {
        if (t + 1 < nt) asm volatile("s_waitcnt vmcnt(8)" ::: "memory"); else asm volatile("s_waitcnt vmcnt(0)" ::: "memory");
        const int tc = f.cls(t);
        if (tc != 2) {
        float bb[16];
        f.bias16(t, hi, r32, bb, tc == 1);
        f32x16 s;
#pragma unroll
        for (int r = 0; r < 16; ++r) s[r] = bb[r];
#pragma unroll
        for (int d0 = 0; d0 < ND; ++d0) { const bf16x8 kf = *(const LAS bf16x8*)(kp[d0] + bo); s = __builtin_amdgcn_mfma_f32_32x32x16_bf16(kf, qf[d0], s, 0, 0, 0); }
        float ps = 0.f;
        if (SAFE) {
            float mx = NEGB;
#pragma unroll
            for (int r = 0; r < 16; ++r) mx = fmaxf(mx, s[r]);
            mx = fmaxf(mx, __shfl_xor(mx, 32));
            const float mnew = fmaxf(m, mx), alpha = __builtin_amdgcn_exp2f(m - mnew);
            m = mnew;
#pragma unroll
            for (int r = 0; r < 16; ++r) { s[r] = __builtin_amdgcn_exp2f(s[r] - mnew); ps += s[r]; }
            l = l * alpha + ps;
#pragma unroll
            for (int r = 0; r < 16; ++r) { ot[0][r] *= alpha; ot[1][r] *= alpha; }
        } else {
#pragma unroll
            for (int r = 0; r < 16; ++r) s[r] = __builtin_amdgcn_exp2f(s[r]);
            l += ((s[0] + s[1]) + (s[2] + s[3])) + ((s[4] + s[5]) + (s[6] + s[7])) + (((s[8] + s[9]) + (s[10] + s[11])) + ((s[12] + s[13]) + (s[14] + s[15])));
        }
        u32x4 pw[2];
#pragma unroll
        for (int ks = 0; ks < 2; ++ks) { pw[ks].x = cvtpk(s[8 * ks + 0], s[8 * ks + 1]); pw[ks].y = cvtpk(s[8 * ks + 2], s[8 * ks + 3]); pw[ks].z = cvtpk(s[8 * ks + 4], s[8 * ks + 5]); pw[ks].w = cvtpk(s[8 * ks + 6], s[8 * ks + 7]); }
#pragma unroll
        for (int db = 0; db < 2; ++db)
#pragma unroll
            for (int ks = 0; ks < 2; ++ks) {
                const s16x4 lo = vtr(vbase + bo + ks * 2048 + db * 512), hh = vtr(vbase + bo + ks * 2048 + 1024 + db * 512);
                const bf16x8 vf = (bf16x8){lo[0], lo[1], lo[2], lo[3], hh[0], hh[1], hh[2], hh[3]};
                ot[db] = __builtin_amdgcn_mfma_f32_32x32x16_bf16(vf, __builtin_bit_cast(bf16x8, pw[ks]), ot[db], 0, 0, 0);
            }
        }
        if (t + 2 < nt) {
            __builtin_amdgcn_sched_barrier(0);
            asm volatile("s_waitcnt lgkmcnt(0)" ::: "memory");
            dma_tile(t + 2, bo);
            asm volatile("" ::: "memory");
        }
    };
#pragma unroll 1
    for (int t = 0; t < nt; t += 2) { body(t, 0); if (t + 1 < nt) body(t + 1, TB); }
    l += __shfl_xor(l, 32);
    if (!SAFE && __any(!(l > 1.0e-30f && l < 1.0e37f))) return false;
    const float inv = 1.0f / l;
#pragma unroll
    for (int db = 0; db < 2; ++db)
#pragma unroll
        for (int g = 0; g < 4; ++g) { u32x2 w; w.x = cvtpk(ot[db][4 * g] * inv, ot[db][4 * g + 1] * inv); w.y = cvtpk(ot[db][4 * g + 2] * inv, ot[db][4 * g + 3] * inv);
            *(u32x2*)(Orow + 32 * db + 8 * g + 4 * hi) = w; }
    return true;
}

struct DilF {
    int t0, w; bool edge; const LAS float* tbl;
    __device__ __forceinline__ int ntiles() const { return 23; }
    __device__ __forceinline__ int tok_raw(int t, int j) const {
        if (t < 8) return t0 - 64 + 32 * t + j;
        const int ii = (t - 8) * 32 + j, e = ii < 240 ? ii - 256 : ii - 192;
        return t0 + w + 4 * e;
    }
    __device__ __forceinline__ int tok(int t, int j) const { int u = tok_raw(t, j); u = u < 0 ? 0 : u; return u > S - 1 ? S - 1 : u; }
    __device__ __forceinline__ bool affine(int t, int& base, int& step) const {
        if (t < 8) { base = t0 - 64 + 32 * t; step = 1; }
        else { if (t == 15) return false; base = t0 + w + 4 * ((t - 8) * 32 - (t < 15 ? 256 : 192)); step = 4; }
        return !(edge && (base < 0 || base + 31 * step >= S));
    }
    __device__ __forceinline__ float bias(int t, int r, int hi, int r32) const {
        const int u = tok_raw(t, crow(r, hi)), d = u - (t0 + w + 4 * r32);
        float b = tbl[((d + 1152) & 3) * 592 + ((d + 1152) >> 2)];
        if (edge && (u < 0 || u >= S)) b = NEGB;
        return b;
    }
    __device__ __forceinline__ int cls(int t) const {
        if (!edge) return 0;
        if (t == 15) return 1;
        const int lo = t < 8 ? t0 - 64 + 32 * t : t0 + w + 4 * ((t - 8) * 32 - (t < 15 ? 256 : 192)), hi_ = t < 8 ? lo + 31 : lo + 124;
        return (hi_ < 0 || lo >= S) ? 2 : ((lo >= 0 && hi_ < S) ? 0 : 1);
    }
    __device__ __forceinline__ void bias16(int t, int hi, int r32, float (&b)[16], const bool slow) const {
        if (slow) {
#pragma unroll
            for (int r = 0; r < 16; ++r) b[r] = bias(t, r, hi, r32);
        } else if (t < 8) {
            const LAS float* lb = tbl + (272 - r32 + hi + 8 * t);
#pragma unroll
            for (int j = 0; j < 4; ++j) { const LAS float* tp = lb + (((j - w) & 3) * 592 - (j < w ? 1 : 0));
#pragma unroll
                for (int c = 0; c < 4; ++c) b[4 * c + j] = tp[2 * c]; }
        } else {
            const LAS float* tp = tbl + (288 - r32 + 4 * hi + 32 * (t - 8) - (t > 15 ? 192 : 256));
            if (t == 15) {
#pragma unroll
                for (int r = 0; r < 16; ++r) b[r] = tp[(r & 3) + 8 * (r >> 2) + (r >= 8 ? 64 : 0)];
            } else {
#pragma unroll
                for (int r = 0; r < 16; ++r) b[r] = tp[(r & 3) + 8 * (r >> 2)];
            }
        }
    }
};
struct NaF {
    int r0, gr, jw; const LAS float* rpb;
    __device__ __forceinline__ int ntiles() const { return 16; }
    __device__ __forceinline__ int tok(int t, int j) const { return (r0 + (t >> 1)) * 64 + 32 * (t & 1) + j; }
    __device__ __forceinline__ bool affine(int t, int& base, int& step) const { base = (r0 + (t >> 1)) * 64 + 32 * (t & 1); step = 1; return true; }
    __device__ __forceinline__ int cls(int) const { return 0; }
    __device__ __forceinline__ void bias16(int t, int hi, int r32, float (&b)[16], const bool = false) const {
        const int c = 32 * jw + r32; int c0 = c - 8; c0 = c0 < 0 ? 0 : (c0 > 48 ? 48 : c0);
        const int kc0 = 32 * (t & 1) + 4 * hi;
        const LAS float* tp = rpb + ((r0 + (t >> 1) - gr + 7) * 31 + kc0 - c + 15);
        const int rel = kc0 - c0;
#pragma unroll
        for (int r = 0; r < 16; ++r) { const int o = (r & 3) + 8 * (r >> 2); b[r] = ((unsigned)(rel + o) < 16u) ? tp[o] : NEGB; }
    }
};
constexpr int NA_NS = 4, NA_SLOT = 16384, NA_FLAG = NA_NS * NA_SLOT;
template <bool SAFE>
__device__ __forceinline__ bool na_coop(int gr0, const bf16* __restrict__ Qb  , const char* __restrict__ Kbase  , bf16* __restrict__ Ob,
                                        const LAS float* rpb, LAS unsigned char* lds, int wave, int lane) {
    constexpr int ND = 4, PITCHB = NQKV * 2;
    const int r32 = lane & 31, hi = lane >> 5, g = wave >> 1, jw = wave & 1, gr = gr0 + g;
    int r0 = gr - 4; r0 = r0 < 0 ? 0 : (r0 > 248 ? 248 : r0);
    int rmin = gr0 - 4; rmin = rmin < 0 ? 0 : (rmin > 248 ? 248 : rmin);
    int rl = gr0 - 1; rl = rl < 0 ? 0 : (rl > 248 ? 248 : rl);
    const int NR = rl + 8 - rmin;
    const NaF f{r0, gr, jw, rpb};
    const int tq = gr * 64 + 32 * jw + r32;
    const bf16* Qrow = Qb + (size_t)tq * NQKV; bf16* Orow = Ob + (size_t)tq * D;
    bf16x8 qf[ND];
#pragma unroll
    for (int d0 = 0; d0 < ND; ++d0) qf[d0] = *(const bf16x8*)(Qrow + 16 * d0 + 8 * hi);
    float m = NEGB, l = 0.f; f32x16 ot[2];
#pragma unroll
    for (int r = 0; r < 16; ++r) { ot[0][r] = 0.f; ot[1][r] = 0.f; }
    const int kg = lane >> 3, sl = lane & 7, kgv = (lane >> 2) & 7, ph = wave >> 2, pi = wave & 3;
    const unsigned offk = (unsigned)((32 * ph + 8 * pi + kg) * PITCHB) + (unsigned)((((sl ^ (kg >> 1)) * 16) ^ ((pi & 1) ? 64 : 0)));
    const unsigned offv = (unsigned)((32 * ph + 8 * pi + kgv) * PITCHB) + (unsigned)(1024 + (lane >> 5) * 64 + (lane & 3) * 16);
    auto stage = [&](int k) {
        const char* rb = mla_sgpr_ptr(Kbase + (size_t)(rmin + k) * (64 * PITCHB));
        LAS unsigned char* sb = lds + (k & (NA_NS - 1)) * NA_SLOT + ph * 8192 + pi * 1024;
        __builtin_amdgcn_global_load_lds((const unsigned*)(rb + offk), (LAS unsigned*)sb, 16, 0, 0);
        __builtin_amdgcn_global_load_lds((const unsigned*)(rb + offv), (LAS unsigned*)(sb + 4096), 16, 0, 0);
    };
    __syncthreads();
    stage(0); stage(1); stage(2);
    unsigned kp[ND];
#pragma unroll
    for (int d0 = 0; d0 < ND; ++d0) kp[d0] = (unsigned)(r32 * 128 + (((2 * d0 + hi) ^ ((r32 >> 1) & 7)) * 16));
    const unsigned vb = (unsigned)(4096 + (4 * hi + ((lane & 15) >> 2)) * 64 + ((lane >> 4) & 1) * 32 + (lane & 3) * 8);
    auto tile = [&](int t, LAS unsigned char* tb) {
        float bb[16];
        f.bias16(t, hi, r32, bb);
        f32x16 s;
#pragma unroll
        for (int r = 0; r < 16; ++r) s[r] = bb[r];
#pragma unroll
        for (int d0 = 0; d0 < ND; ++d0) { const bf16x8 kf = *(const LAS bf16x8*)(tb + kp[d0]); s = __builtin_amdgcn_mfma_f32_32x32x16_bf16(kf, qf[d0], s, 0, 0, 0); }
        float ps = 0.f;
        if (SAFE) {
            float mx = NEGB;
#pragma unroll
            for (int r = 0; r < 16; ++r) mx = fmaxf(mx, s[r]);
            mx = fmaxf(mx, __shfl_xor(mx, 32));
            const float mnew = fmaxf(m, mx), alpha = __builtin_amdgcn_exp2f(m - mnew);
            m = mnew;
#pragma unroll
            for (int r = 0; r < 16; ++r) { s[r] = __builtin_amdgcn_exp2f(s[r] - mnew); ps += s[r]; }
            l = l * alpha + ps;
#pragma unroll
            for (int r = 0; r < 16; ++r) { ot[0][r] *= alpha; ot[1][r] *= alpha; }
        } else {
#pragma unroll
            for (int r = 0; r < 16; ++r) s[r] = __builtin_amdgcn_exp2f(s[r]);
            l += ((s[0] + s[1]) + (s[2] + s[3])) + ((s[4] + s[5]) + (s[6] + s[7])) + (((s[8] + s[9]) + (s[10] + s[11])) + ((s[12] + s[13]) + (s[14] + s[15])));
        }
        u32x4 pw[2];
#pragma unroll
        for (int ks = 0; ks < 2; ++ks) { pw[ks].x = cvtpk(s[8 * ks + 0], s[8 * ks + 1]); pw[ks].y = cvtpk(s[8 * ks + 2], s[8 * ks + 3]); pw[ks].z = cvtpk(s[8 * ks + 4], s[8 * ks + 5]); pw[ks].w = cvtpk(s[8 * ks + 6], s[8 * ks + 7]); }
#pragma unroll
        for (int db = 0; db < 2; ++db)
#pragma unroll
            for (int ks = 0; ks < 2; ++ks) {
                const s16x4 lo = vtr(tb + vb + ks * 2048 + db * 512), hh = vtr(tb + vb + ks * 2048 + 1024 + db * 512);
                const bf16x8 vf = (bf16x8){lo[0], lo[1], lo[2], lo[3], hh[0], hh[1], hh[2], hh[3]};
                ot[db] = __builtin_amdgcn_mfma_f32_32x32x16_bf16(vf, __builtin_bit_cast(bf16x8, pw[ks]), ot[db], 0, 0, 0);
            }
    };
#pragma unroll 1
    for (int k = 0; k < NR; ++k) {
        const int newer = (k + 2 < NR ? k + 2 : NR - 1) - k;
        if (newer == 2) asm volatile("s_waitcnt vmcnt(4) lgkmcnt(0)" ::: "memory"); else if (newer == 1) asm volatile("s_waitcnt vmcnt(2) lgkmcnt(0)" ::: "memory"); else asm volatile("s_waitcnt vmcnt(0) lgkmcnt(0)" ::: "memory");
        __builtin_amdgcn_s_barrier();
        asm volatile("" ::: "memory");
        if (k + 3 < NR) stage(k + 3);
        const int tr = rmin + k - r0;
        if (tr >= 0 && tr < 8) {
            LAS unsigned char* sb = lds + (k & (NA_NS - 1)) * NA_SLOT;
            tile(2 * tr, sb); tile(2 * tr + 1, sb + 8192);
        }
    }
    l += __shfl_xor(l, 32);
    bool ok = true;
    if (!SAFE) {
        LAS unsigned* fl = (LAS unsigned*)(lds + NA_FLAG);
        const bool bad = __any(!(l > 1.0e-30f && l < 1.0e37f));
        if (lane == 0) fl[wave] = bad ? 1u : 0u;
        __syncthreads();
        unsigned any = 0;
#pragma unroll
        for (int w = 0; w < 8; ++w) any |= fl[w];
        ok = (__builtin_amdgcn_readfirstlane(any) == 0u);
        if (!ok) return false;
    }
    const float inv = 1.0f / l;
#pragma unroll
    for (int db = 0; db < 2; ++db)
#pragma unroll
        for (int gq = 0; gq < 4; ++gq) { u32x2 w; w.x = cvtpk(ot[db][4 * gq] * inv, ot[db][4 * gq + 1] * inv); w.y = cvtpk(ot[db][4 * gq + 2] * inv, ot[db][4 * gq + 3] * inv);
            *(u32x2*)(Orow + 32 * db + 8 * gq + 4 * hi) = w; }
    return true;
}
struct MlaF {
    int tq0; const LAS float* tbl;
    __device__ __forceinline__ int ntiles() const { return S / 32; }
    __device__ __forceinline__ int tok(int t, int j) const { return 32 * t + j; }
    __device__ __forceinline__ float bias(int t, int r, int hi, int r32) const {
        int d = 32 * t + crow(r, hi) - (tq0 + r32); d = d < -600 ? -600 : (d > 600 ? 600 : d);
        return tbl[d + 600];
    }
};
}


namespace mla {
using wattn::crow; using wattn::vtr;
constexpr int NSLOT = 4, KSLOT = 12288, VSLOT = 8192, L_K = 0, L_V = NSLOT * KSLOT, L_TBL = L_V + NSLOT * VSLOT, L_FLAG = L_TBL + 7936, L_OST = L_TBL + 8192, L_END = L_OST + 8 * 4096;
constexpr int NT = S / 64;
constexpr float THR = 8.0f;
#define MLA_WAITBAR() do { asm volatile("s_waitcnt vmcnt(0) lgkmcnt(0)" ::: "memory"); __builtin_amdgcn_s_barrier(); asm volatile("" ::: "memory"); } while (0)
#define MLA_WAITBAR_N(n) do { asm volatile("s_waitcnt vmcnt(" #n ") lgkmcnt(0)" ::: "memory"); __builtin_amdgcn_s_barrier(); asm volatile("" ::: "memory"); } while (0)
#define MLA_BAR() do { asm volatile("s_waitcnt lgkmcnt(0)" ::: "memory"); __builtin_amdgcn_s_barrier(); asm volatile("" ::: "memory"); } while (0)
#define MLA_SB() __builtin_amdgcn_sched_barrier(0)
__device__ __forceinline__ float max3f(float a, float b, float c) { float r; asm("v_max3_f32 %0, %1, %2, %3" : "=v"(r) : "v"(a), "v"(b), "v"(c)); return r; }
__device__ __forceinline__ const char* sgpr_ptr(const char* p) { const unsigned long long b = (unsigned long long)p; const unsigned lo = __builtin_amdgcn_readfirstlane((unsigned)b), hi = __builtin_amdgcn_readfirstlane((unsigned)(b >> 32)); return (const char*)(((unsigned long long)hi << 32) | lo); }

struct St {
    bf16x8 qf[6]; f32x16 ot[2]; f32x16 accl; f32x16 negm; u32x4 pw[4]; float m, l, cbn; int qrow;
    const LAS unsigned char* kfb; const LAS unsigned char* vfb; const LAS float* tbl;
    int tl_end, tr_beg; float clo, chi;
};
__device__ __forceinline__ float tile_cb(const St& st, int t) { return t < st.tl_end ? st.clo : (t >= st.tr_beg ? st.chi : 0.f); }

template <bool SAFE, bool ONES>
__device__ __forceinline__ void h1(St& st, f32x16& s0, f32x16& s1, int t, int lane) {
    const int hi = lane >> 5;
    if (SAFE) asm volatile("s_nop 15\n\ts_nop 7" : "+v"(s0), "+v"(s1));
    if (t >= st.tl_end && t < st.tr_beg) {
        const LAS float* tp = st.tbl + (64 * t + 4 * hi - st.qrow + 960);
#pragma unroll
        for (int g = 0; g < 4; ++g) {
#pragma unroll
            for (int e = 0; e < 4; ++e) { s0[4 * g + e] += tp[8 * g + e]; s1[4 * g + e] += tp[32 + 8 * g + e]; }
            asm volatile("" ::: "memory");
        }
    }
    bool resc = false;
    if (SAFE) {
        float a = max3f(s0[0], s0[1], s1[0]), b = max3f(s0[2], s0[3], s1[1]); a = max3f(a, s1[2], s1[3]);
#pragma unroll
        for (int r = 4; r < 16; r += 4) { a = max3f(a, s0[r], s0[r + 1]); b = max3f(b, s0[r + 2], s0[r + 3]); a = max3f(a, s1[r], s1[r + 1]); b = max3f(b, s1[r + 2], s1[r + 3]); }
        float mx = fmaxf(a, b);
        { auto rr = __builtin_amdgcn_permlane32_swap(__float_as_uint(mx), __float_as_uint(mx), false, false); mx = fmaxf(__uint_as_float(rr[0]), __uint_as_float(rr[1])); }
        if (__any(mx > THR)) { const float dl = fmaxf(mx, 0.f), alpha = __builtin_amdgcn_exp2f(-dl); st.m += dl; st.l *= alpha; resc = true;
#pragma unroll
            for (int r = 0; r < 16; ++r) { s0[r] -= dl; s1[r] -= dl; st.ot[0][r] *= alpha; st.ot[1][r] *= alpha; if (ONES) st.accl[r] *= alpha; } }
    }
    { const float cbn = tile_cb(st, t + 1); if (resc || cbn != st.cbn) { st.cbn = cbn; const float v = cbn - st.m;
#pragma unroll
        for (int r = 0; r < 16; ++r) st.negm[r] = v;
        asm volatile("" : "+v"(st.negm)); } }
#pragma unroll
    for (int r = 0; r < 16; ++r) { s0[r] = __builtin_amdgcn_exp2f(s0[r]); s1[r] = __builtin_amdgcn_exp2f(s1[r]); }
    if (!ONES) { f32x16 tt = s0 + s1;
      float u0 = (tt[0] + tt[1]) + (tt[2] + tt[3]), u1 = (tt[4] + tt[5]) + (tt[6] + tt[7]), u2 = (tt[8] + tt[9]) + (tt[10] + tt[11]), u3 = (tt[12] + tt[13]) + (tt[14] + tt[15]);
      st.l += (u0 + u1) + (u2 + u3); }
#pragma unroll
    for (int ks = 0; ks < 2; ++ks) { st.pw[ks].x = cvtpk(s0[8 * ks + 0], s0[8 * ks + 1]); st.pw[ks].y = cvtpk(s0[8 * ks + 2], s0[8 * ks + 3]); st.pw[ks].z = cvtpk(s0[8 * ks + 4], s0[8 * ks + 5]); st.pw[ks].w = cvtpk(s0[8 * ks + 6], s0[8 * ks + 7]);
        st.pw[2 + ks].x = cvtpk(s1[8 * ks + 0], s1[8 * ks + 1]); st.pw[2 + ks].y = cvtpk(s1[8 * ks + 2], s1[8 * ks + 3]); st.pw[2 + ks].z = cvtpk(s1[8 * ks + 4], s1[8 * ks + 5]); st.pw[2 + ks].w = cvtpk(s1[8 * ks + 6], s1[8 * ks + 7]); }
    asm volatile("" : "+v"(st.pw[0]), "+v"(st.pw[1]), "+v"(st.pw[2]), "+v"(st.pw[3]));
}
template <bool ONES>
__device__ __forceinline__ void h2(St& st, f32x16& s0, f32x16& s1, int kslot, int vslot) {
    const bf16x8 ones = (bf16x8){16256, 16256, 16256, 16256, 16256, 16256, 16256, 16256};
    const unsigned kaddr = (unsigned)(uintptr_t)(st.kfb + kslot * KSLOT), vaddr = (unsigned)(uintptr_t)(st.vfb + vslot * VSLOT);
    s16x4 vlo[6], vhi[6]; bf16x8 kfr[6];
#define H2_RDV(i) asm volatile("ds_read_b64_tr_b16 %0, %2 offset:%3\n\tds_read_b64_tr_b16 %1, %2 offset:%4" : "=&v"(vlo[(i) % 6]), "=&v"(vhi[(i) % 6]) : "v"(vaddr), "i"(((i) & 1) * 4096 + ((i) >> 1) * 1024), "i"(((i) & 1) * 4096 + ((i) >> 1) * 1024 + 512))
#define H2_RDK(i) asm volatile("ds_read_b128 %0, %1 offset:%2" : "=v"(kfr[(i) % 6]) : "v"(kaddr), "i"((((i) - 8) >> 1) * 2048 + (((i) - 8) & 1) * 512))
#define H2_WV(i, n) asm volatile("s_waitcnt %2" : "+v"(vlo[(i) % 6]), "+v"(vhi[(i) % 6]) : "i"(0xC07F | ((n) << 8)))
#define H2_WK(i, n) asm volatile("s_waitcnt %1" : "+v"(kfr[(i) % 6]) : "i"(0xC07F | ((n) << 8)))
#define H2_MV(g) do { const bf16x8 vf = (bf16x8){vlo[(g) % 6][0], vlo[(g) % 6][1], vlo[(g) % 6][2], vlo[(g) % 6][3], vhi[(g) % 6][0], vhi[(g) % 6][1], vhi[(g) % 6][2], vhi[(g) % 6][3]}; \
        st.ot[(g) & 1] = __builtin_amdgcn_mfma_f32_32x32x16_bf16(vf, __builtin_bit_cast(bf16x8, st.pw[(g) >> 1]), st.ot[(g) & 1], 0, 0, 0); \
        if (ONES && ((g) & 1)) st.accl = __builtin_amdgcn_mfma_f32_32x32x16_bf16(ones, __builtin_bit_cast(bf16x8, st.pw[(g) >> 1]), st.accl, 0, 0, 0); } while (0)
#define H2_MK(g) do { if ((((g) - 8) & 1) == 0) s0 = __builtin_amdgcn_mfma_f32_32x32x16_bf16(kfr[(g) % 6], st.qf[((g) - 8) >> 1], (g) < 10 ? st.negm : s0, 0, 0, 0); \
        else s1 = __builtin_amdgcn_mfma_f32_32x32x16_bf16(kfr[(g) % 6], st.qf[((g) - 8) >> 1], (g) < 10 ? st.negm : s1, 0, 0, 0); } while (0)
    __builtin_amdgcn_s_setprio(1);
    H2_RDV(0); H2_RDV(1); H2_RDV(2); H2_RDV(3); H2_RDV(4);
    H2_RDV(5);  H2_WV(0, 10); H2_MV(0);  MLA_SB();
    H2_RDV(6);  H2_WV(1, 10); H2_MV(1);  MLA_SB();
    H2_RDV(7);  H2_WV(2, 10); H2_MV(2);  MLA_SB();
    H2_RDK(8);  H2_WV(3, 9);  H2_MV(3);  MLA_SB();
    H2_RDK(9);  H2_WV(4, 8);  H2_MV(4);  MLA_SB();
    H2_RDK(10); H2_WV(5, 7);  H2_MV(5);  MLA_SB();
    H2_RDK(11); H2_WV(6, 6);  H2_MV(6);  MLA_SB();
    H2_RDK(12); H2_WV(7, 5);  H2_MV(7);  MLA_SB();
    H2_RDK(13); H2_WK(8, 5);  H2_MK(8);  MLA_SB();
    H2_RDK(14); H2_WK(9, 5);  H2_MK(9);  MLA_SB();
    H2_RDK(15); H2_WK(10, 5); H2_MK(10); MLA_SB();
    H2_RDK(16); H2_WK(11, 5); H2_MK(11); MLA_SB();
    H2_RDK(17); H2_WK(12, 5); H2_MK(12); MLA_SB();
    H2_RDK(18); H2_WK(13, 5); H2_MK(13); MLA_SB();
    H2_RDK(19); H2_WK(14, 5); H2_MK(14); MLA_SB();
    H2_WK(15, 4); H2_MK(15); MLA_SB();
    H2_WK(16, 3); H2_MK(16); MLA_SB();
    H2_WK(17, 2); H2_MK(17); MLA_SB();
    H2_WK(18, 1); H2_MK(18); MLA_SB();
    H2_WK(19, 0); H2_MK(19); MLA_SB();
    __builtin_amdgcn_s_setprio(0);
#undef H2_RDV
#undef H2_RDK
#undef H2_WV
#undef H2_WK
#undef H2_MV
#undef H2_MK
}

template <bool SAFE>
__device__ __forceinline__ bool unit(int h, int q0, const bf16* __restrict__ Q1, const bf16* __restrict__ K1, const bf16* __restrict__ V1, bf16* __restrict__ O,
                                     LAS unsigned char* lds, const float clo, const float chi, int wave, int lane, float* dbg_tp = nullptr) {
    const int r32 = lane & 31, hi = lane >> 5, grp = wave >> 2;
    St st;
    st.tbl = (const LAS float*)(lds + L_TBL); st.clo = clo; st.chi = chi;
    st.qrow = q0 + 32 * wave + r32;
    const unsigned koff0 = (unsigned)(lane * KPITCH + h * 96 + wave * 8) * 2u, koff1 = (unsigned)(lane * KPITCH + h * 96 + (8 + (wave & 3)) * 8) * 2u;
    const unsigned voff = (unsigned)((16 * (wave & 3) + (lane >> 2)) * D + h * 64 + (wave >> 2) * 32 + (lane & 3) * 8) * 2u;
#define MLA_DMA_K(t, slot) do { const char* kt_ = sgpr_ptr((const char*)K1 + (size_t)(t) * (64 * KPITCH * 2)); \
        __builtin_amdgcn_global_load_lds((const unsigned*)(kt_ + koff0), (LAS unsigned*)(lds + L_K + (slot) * KSLOT + wave * 1024), 16, 0, 0); \
        if (wave < 4) __builtin_amdgcn_global_load_lds((const unsigned*)(kt_ + koff1), (LAS unsigned*)(lds + L_K + (slot) * KSLOT + (8 + wave) * 1024), 16, 0, 0); } while (0)
#define MLA_DMA_V(t, slot) __builtin_amdgcn_global_load_lds((const unsigned*)(sgpr_ptr((const char*)V1 + (size_t)(t) * (64 * D * 2)) + voff), (LAS unsigned*)(lds + L_V + (slot) * VSLOT + wave * 1024), 16, 0, 0)
    MLA_DMA_K(0, 0); MLA_DMA_K(1, 1); MLA_DMA_V(0, 0); MLA_DMA_K(2, 2); MLA_DMA_V(1, 1);
    { const bf16* qp = Q1 + (size_t)st.qrow * NQ1 + h * 96 + 8 * hi;
#pragma unroll
      for (int d0 = 0; d0 < 6; ++d0) st.qf[d0] = *(const bf16x8*)(qp + 16 * d0); }
    st.l = 0.f;
#pragma unroll
    for (int r = 0; r < 16; ++r) { st.ot[0][r] = 0.f; st.ot[1][r] = 0.f; st.accl[r] = 0.f; }
    st.kfb = lds + L_K + hi * 1024 + r32 * 16;
    st.vfb = lds + L_V + (4 * hi + ((lane & 15) >> 2)) * 64 + ((lane >> 4) & 1) * 32 + (lane & 3) * 8;
    st.tl_end = (q0 - 622 >= 0) ? (q0 - 622) / 64 + 1 : 0;
    st.tr_beg = (q0 + 814 + 63) / 64;
    f32x16 s0, s1;
    MLA_WAITBAR();
    { const LAS unsigned char* kb = st.kfb;
#pragma unroll
      for (int r = 0; r < 16; ++r) { s0[r] = 0.f; s1[r] = 0.f; }
#pragma unroll
      for (int d0 = 0; d0 < 6; ++d0) { const bf16x8 a0 = *(const LAS bf16x8*)(kb + d0 * 2048), a1 = *(const LAS bf16x8*)(kb + d0 * 2048 + 512);
          s0 = __builtin_amdgcn_mfma_f32_32x32x16_bf16(a0, st.qf[d0], s0, 0, 0, 0); s1 = __builtin_amdgcn_mfma_f32_32x32x16_bf16(a1, st.qf[d0], s1, 0, 0, 0); }
      float mx = s0[0];
#pragma unroll
      for (int r = 0; r < 16; ++r) mx = fmaxf(mx, fmaxf(s0[r], s1[r]));
      mx = fmaxf(mx, __shfl_xor(mx, 32));
      st.m = mx + tile_cb(st, 0);
#pragma unroll
      for (int r = 0; r < 16; ++r) { s0[r] -= mx; s1[r] -= mx; }
      st.cbn = 1e30f; }
    MLA_BAR();
#define MLA_STAGE(t) do { if ((t) + 3 < NT) MLA_DMA_K((t) + 3, ((t) + 3) & 3); if ((t) + 2 < NT) MLA_DMA_V((t) + 2, ((t) + 2) & 3); } while (0)
#ifdef TIMING_SEL
    unsigned long long ta_[6] = {0, 0, 0, 0, 0, 0};
#define TS(x) const unsigned long long x = __builtin_amdgcn_s_memtime()
#define TACC(i, a, b) ta_[i] += (b) - (a)
#else
#define TS(x)
#define TACC(i, a, b)
#endif
    if (grp == 0) {
        MLA_STAGE(0);
        for (int t = 0; t < NT; ++t) {
            TS(t1_);
            h1<SAFE, false>(st, s0, s1, t, lane); TS(t2_);
            if (t + 3 < NT) MLA_WAITBAR_N(6); else MLA_WAITBAR();
            TS(t3_); h2<false>(st, s0, s1, (t + 1) & 3, t & 3); TS(t4_);
            MLA_STAGE(t + 1); TS(t0_);
            MLA_BAR(); TS(t5_);
            TACC(2, t4_, t0_); TACC(0, t1_, t2_); TACC(1, t2_, t3_); TACC(3, t3_, t4_); TACC(4, t0_, t5_);
        }
    } else {
        for (int t = 0; t < NT; ++t) {
            TS(t0_); TS(t1_);
            if (t > 0) h2<true>(st, s0, s1, t & 3, (t - 1) & 3);
            TS(t2_); if (t + 3 < NT) MLA_WAITBAR_N(2); else MLA_WAITBAR();
            TS(t3_); MLA_STAGE(t);
            h1<SAFE, true>(st, s0, s1, t, lane); TS(t4_);
            MLA_BAR(); TS(t5_);
            TACC(2, t0_, t1_); TACC(3, t1_, t2_); TACC(1, t2_, t3_); TACC(0, t3_, t4_); TACC(4, t4_, t5_);
        }
        h2<true>(st, s0, s1, NT & 3, (NT - 1) & 3);
    }
#undef MLA_STAGE
#ifdef TIMING_SEL
    if (blockIdx.x == 0 && lane == 0 && (wave == 0 || wave == 4)) { float* tp = dbg_tp + (wave >> 2) * 8;
        for (int i = 0; i < 5; ++i) atomicAdd(tp + i, (float)ta_[i]); }
#endif
    float l = st.l; l += __shfl_xor(l, 32);
    if (grp == 1) l = st.accl[0];
    bool ok = true;
    if (!SAFE) { const bool bad = !(l > 0.f && l < 1.0e37f);
        LAS unsigned* flag = (LAS unsigned*)(lds + L_FLAG);
        if (lane == 0) flag[wave] = __any(bad) ? 1u : 0u;
        else (void)__any(bad);
        MLA_BAR();
        unsigned f = 0;
#pragma unroll
        for (int i = 0; i < 8; ++i) f |= flag[i];
        ok = (f == 0u); }
    const float inv = 1.0f / l;
    LAS bf16* stg = (LAS bf16*)(lds + L_OST) + wave * 2048;
#pragma unroll
    for (int db = 0; db < 2; ++db)
#pragma unroll
        for (int g = 0; g < 4; ++g) { u32x2 w; w.x = cvtpk(st.ot[db][4 * g] * inv, st.ot[db][4 * g + 1] * inv); w.y = cvtpk(st.ot[db][4 * g + 2] * inv, st.ot[db][4 * g + 3] * inv);
            *(LAS u32x2*)(stg + r32 * 64 + 32 * db + 8 * g + 4 * hi) = w; }
    asm volatile("s_waitcnt lgkmcnt(0)" ::: "memory");
    bf16* Ow = O + (size_t)(q0 + 32 * wave) * D + h * 64;
#pragma unroll
    for (int i = 0; i < 4; ++i) { const int row = i * 8 + (lane >> 3), ch = lane & 7; const u32x4 v = *(const LAS u32x4*)(stg + row * 64 + ch * 8); *(u32x4*)(Ow + (size_t)row * D + ch * 8) = v; }
    MLA_WAITBAR();
#undef MLA_DMA_K
#undef MLA_DMA_V
    return ok;
}
}

namespace mla {
struct Sc { f32x4 v[4][2]; };
struct St2 {
    bf16x8 qf[2][3]; f32x4 ot[4][2]; f32x4 accl[2]; f32x4 negm[2]; u32x4 pw[2][2]; float m[2], l[2], cbn; int qrow;
    const LAS unsigned char* kfb; const LAS unsigned char* vfb; const LAS float* tbl;
    int tl_end, tr_beg; float clo, chi;
};
__device__ __forceinline__ float tile_cb2(const St2& st, int t) { return t < st.tl_end ? st.clo : (t >= st.tr_beg ? st.chi : 0.f); }
#define MFMA16(a, b, c) __builtin_amdgcn_mfma_f32_16x16x32_bf16(a, b, c, 0, 0, 0)

template <bool SAFE, bool ONES>
__device__ __forceinline__ void h1x(St2& st, Sc& sc, int t, int lane) {
    const int g = lane >> 4;
    if (SAFE) asm volatile("s_nop 15\n\ts_nop 7" : "+v"(sc.v[0][0]), "+v"(sc.v[0][1]), "+v"(sc.v[1][0]), "+v"(sc.v[1][1]), "+v"(sc.v[2][0]), "+v"(sc.v[2][1]), "+v"(sc.v[3][0]), "+v"(sc.v[3][1]));
    if (t >= st.tl_end && t < st.tr_beg) {
#pragma unroll
        for (int qb = 0; qb < 2; ++qb) { const LAS float* tp = st.tbl + (64 * t + 4 * g - (st.qrow + 16 * qb) + 960);
#pragma unroll
            for (int kb = 0; kb < 4; ++kb) {
#pragma unroll
                for (int r = 0; r < 4; ++r) sc.v[kb][qb][r] += tp[16 * kb + r];
                if (kb & 1) asm volatile("" ::: "memory"); } }
    }
    bool resc = false;
    if (SAFE) {
        float mx[2];
#pragma unroll
        for (int qb = 0; qb < 2; ++qb) {
            float a = max3f(sc.v[0][qb][0], sc.v[0][qb][1], sc.v[0][qb][2]), b = max3f(sc.v[0][qb][3], sc.v[1][qb][0], sc.v[1][qb][1]);
            a = max3f(a, sc.v[1][qb][2], sc.v[1][qb][3]); b = max3f(b, sc.v[2][qb][0], sc.v[2][qb][1]); a = max3f(a, sc.v[2][qb][2], sc.v[2][qb][3]);
            b = max3f(b, sc.v[3][qb][0], sc.v[3][qb][1]); a = max3f(a, sc.v[3][qb][2], sc.v[3][qb][3]);
            float v = fmaxf(a, b); v = fmaxf(v, __shfl_xor(v, 16)); v = fmaxf(v, __shfl_xor(v, 32)); mx[qb] = v; }
        if (__any(mx[0] > THR || mx[1] > THR)) { resc = true;
#pragma unroll
            for (int qb = 0; qb < 2; ++qb) { const float dl = fmaxf(mx[qb], 0.f), alpha = __builtin_amdgcn_exp2f(-dl); st.m[qb] += dl; st.l[qb] *= alpha;
#pragma unroll
                for (int kb = 0; kb < 4; ++kb) { sc.v[kb][qb] -= dl; st.ot[kb][qb] *= alpha; }
                if (ONES) st.accl[qb] *= alpha; } }
    }
    { const float cbn = tile_cb2(st, t + 1); if (resc || cbn != st.cbn) { st.cbn = cbn;
#pragma unroll
        for (int qb = 0; qb < 2; ++qb) { const float v = cbn - st.m[qb]; st.negm[qb] = (f32x4){v, v, v, v}; }
        asm volatile("" : "+v"(st.negm[0]), "+v"(st.negm[1])); } }
#pragma unroll
    for (int r = 0; r < 4; ++r)
#pragma unroll
        for (int kb = 0; kb < 4; ++kb) { sc.v[kb][0][r] = __builtin_amdgcn_exp2f(sc.v[kb][0][r]); sc.v[kb][1][r] = __builtin_amdgcn_exp2f(sc.v[kb][1][r]); }
    if (!ONES) {
#pragma unroll
        for (int qb = 0; qb < 2; ++qb) { const f32x4 tt = (sc.v[0][qb] + sc.v[1][qb]) + (sc.v[2][qb] + sc.v[3][qb]); st.l[qb] += (tt[0] + tt[1]) + (tt[2] + tt[3]); } }
#pragma unroll
    for (int kp = 0; kp < 2; ++kp)
#pragma unroll
        for (int qb = 0; qb < 2; ++qb) { st.pw[kp][qb].x = cvtpk(sc.v[2 * kp][qb][0], sc.v[2 * kp][qb][1]); st.pw[kp][qb].y = cvtpk(sc.v[2 * kp][qb][2], sc.v[2 * kp][qb][3]);
            st.pw[kp][qb].z = cvtpk(sc.v[2 * kp + 1][qb][0], sc.v[2 * kp + 1][qb][1]); st.pw[kp][qb].w = cvtpk(sc.v[2 * kp + 1][qb][2], sc.v[2 * kp + 1][qb][3]); }
    asm volatile("" : "+v"(st.pw[0][0]), "+v"(st.pw[0][1]), "+v"(st.pw[1][0]), "+v"(st.pw[1][1]));
}

template <bool ONES>
__device__ __forceinline__ void h2x(St2& st, Sc& sc, int kslot, int vslot) {
    const bf16x8 ones = (bf16x8){16256, 16256, 16256, 16256, 16256, 16256, 16256, 16256};
    const unsigned kaddr = (unsigned)(uintptr_t)(st.kfb + kslot * KSLOT), vaddr = (unsigned)(uintptr_t)(st.vfb + vslot * VSLOT);
    s16x4 vlo[6], vhi[6]; bf16x8 kfr[6];
#define X2_RDV(i) asm volatile("ds_read_b64_tr_b16 %0, %2 offset:%3\n\tds_read_b64_tr_b16 %1, %2 offset:%4" : "=&v"(vlo[(i) % 6]), "=&v"(vhi[(i) % 6]) : "v"(vaddr), "i"(((i) & 3) * 2048 + ((i) >> 2) * 1024), "i"(((i) & 3) * 2048 + ((i) >> 2) * 1024 + 512))
#define X2_RDK(i) asm volatile("ds_read_b128 %0, %1 offset:%2" : "=v"(kfr[(i) % 6]) : "v"(kaddr), "i"((((i) - 8) >> 2) * 4096 + (((i) - 8) & 3) * 256))
#define X2_WV(i, n) asm volatile("s_waitcnt %2" : "+v"(vlo[(i) % 6]), "+v"(vhi[(i) % 6]) : "i"(0xC07F | ((n) << 8)))
#define X2_WK(i, n) asm volatile("s_waitcnt %1" : "+v"(kfr[(i) % 6]) : "i"(0xC07F | ((n) << 8)))
#define X2_MV(g_) do { const bf16x8 vf = (bf16x8){vlo[(g_) % 6][0], vlo[(g_) % 6][1], vlo[(g_) % 6][2], vlo[(g_) % 6][3], vhi[(g_) % 6][0], vhi[(g_) % 6][1], vhi[(g_) % 6][2], vhi[(g_) % 6][3]}; \
        st.ot[(g_) & 3][0] = MFMA16(vf, __builtin_bit_cast(bf16x8, st.pw[(g_) >> 2][0]), st.ot[(g_) & 3][0]); st.ot[(g_) & 3][1] = MFMA16(vf, __builtin_bit_cast(bf16x8, st.pw[(g_) >> 2][1]), st.ot[(g_) & 3][1]); \
        if (ONES && ((g_) & 1)) st.accl[((g_) >> 1) & 1] = MFMA16(ones, __builtin_bit_cast(bf16x8, st.pw[(g_) >> 2][((g_) >> 1) & 1]), st.accl[((g_) >> 1) & 1]); } while (0)
#define X2_MK(g_) do { sc.v[((g_) - 8) & 3][0] = MFMA16(kfr[(g_) % 6], st.qf[0][((g_) - 8) >> 2], (g_) < 12 ? st.negm[0] : sc.v[((g_) - 8) & 3][0]); \
        sc.v[((g_) - 8) & 3][1] = MFMA16(kfr[(g_) % 6], st.qf[1][((g_) - 8) >> 2], (g_) < 12 ? st.negm[1] : sc.v[((g_) - 8) & 3][1]); } while (0)
    __builtin_amdgcn_s_setprio(1);
    X2_RDV(0); X2_RDV(1); X2_RDV(2); X2_RDV(3); X2_RDV(4);
    X2_RDV(5);  X2_WV(0, 10); X2_MV(0);  MLA_SB();
    X2_RDV(6);  X2_WV(1, 10); X2_MV(1);  MLA_SB();
    X2_RDV(7);  X2_WV(2, 10); X2_MV(2);  MLA_SB();
    X2_RDK(8);  X2_WV(3, 9);  X2_MV(3);  MLA_SB();
    X2_RDK(9);  X2_WV(4, 8);  X2_MV(4);  MLA_SB();
    X2_RDK(10); X2_WV(5, 7);  X2_MV(5);  MLA_SB();
    X2_RDK(11); X2_WV(6, 6);  X2_MV(6);  MLA_SB();
    X2_RDK(12); X2_WV(7, 5);  X2_MV(7);  MLA_SB();
    X2_RDK(13); X2_WK(8, 5);  X2_MK(8);  MLA_SB();
    X2_RDK(14); X2_WK(9, 5);  X2_MK(9);  MLA_SB();
    X2_RDK(15); X2_WK(10, 5); X2_MK(10); MLA_SB();
    X2_RDK(16); X2_WK(11, 5); X2_MK(11); MLA_SB();
    X2_RDK(17); X2_WK(12, 5); X2_MK(12); MLA_SB();
    X2_RDK(18); X2_WK(13, 5); X2_MK(13); MLA_SB();
    X2_RDK(19); X2_WK(14, 5); X2_MK(14); MLA_SB();
    X2_WK(15, 4); X2_MK(15); MLA_SB();
    X2_WK(16, 3); X2_MK(16); MLA_SB();
    X2_WK(17, 2); X2_MK(17); MLA_SB();
    X2_WK(18, 1); X2_MK(18); MLA_SB();
    X2_WK(19, 0); X2_MK(19); MLA_SB();
    __builtin_amdgcn_s_setprio(0);
#undef X2_RDV
#undef X2_RDK
#undef X2_WV
#undef X2_WK
#undef X2_MV
#undef X2_MK
}

template <bool SAFE>
__device__ __forceinline__ bool unitx(int h, int q0, const bf16* __restrict__ Q1, const bf16* __restrict__ K1, const bf16* __restrict__ V1, bf16* __restrict__ O,
                                      LAS unsigned char* lds, const float clo, const float chi, int wave, int lane) {
    const int q16 = lane & 15, g = lane >> 4, grp = wave >> 2;
    St2 st;
    st.tbl = (const LAS float*)(lds + L_TBL); st.clo = clo; st.chi = chi;
    st.qrow = q0 + 32 * wave + q16;
    const unsigned koff0 = (unsigned)(lane * KPITCH + h * 96 + wave * 8) * 2u, koff1 = (unsigned)(lane * KPITCH + h * 96 + (8 + (wave & 3)) * 8) * 2u;
    const unsigned voff = (unsigned)((32 * (wave & 1) + (lane >> 1)) * D + h * 64 + (wave >> 1) * 16 + (lane & 1) * 8) * 2u;
#define MLA_DMA_K(t, slot) do { const char* kt_ = sgpr_ptr((const char*)K1 + (size_t)(t) * (64 * KPITCH * 2)); \
        __builtin_amdgcn_global_load_lds((const unsigned*)(kt_ + koff0), (LAS unsigned*)(lds + L_K + (slot) * KSLOT + wave * 1024), 16, 0, 0); \
        if (wave < 4) __builtin_amdgcn_global_load_lds((const unsigned*)(kt_ + koff1), (LAS unsigned*)(lds + L_K + (slot) * KSLOT + (8 + wave) * 1024), 16, 0, 0); } while (0)
#define MLA_DMA_V(t, slot) __builtin_amdgcn_global_load_lds((const unsigned*)(sgpr_ptr((const char*)V1 + (size_t)(t) * (64 * D * 2)) + voff), (LAS unsigned*)(lds + L_V + (slot) * VSLOT + wave * 1024), 16, 0, 0)
    MLA_DMA_K(0, 0); MLA_DMA_K(1, 1); MLA_DMA_V(0, 0); MLA_DMA_K(2, 2); MLA_DMA_V(1, 1);
#pragma unroll
    for (int qb = 0; qb < 2; ++qb) { const bf16* qp = Q1 + (size_t)(st.qrow + 16 * qb) * NQ1 + h * 96 + 8 * g;
#pragma unroll
        for (int db = 0; db < 3; ++db) st.qf[qb][db] = *(const bf16x8*)(qp + 32 * db); }
    st.l[0] = 0.f; st.l[1] = 0.f;
#pragma unroll
    for (int i = 0; i < 4; ++i) { st.ot[i][0] = (f32x4){0.f, 0.f, 0.f, 0.f}; st.ot[i][1] = (f32x4){0.f, 0.f, 0.f, 0.f}; }
    st.accl[0] = (f32x4){0.f, 0.f, 0.f, 0.f}; st.accl[1] = (f32x4){0.f, 0.f, 0.f, 0.f};
    st.kfb = lds + L_K + g * 1024 + q16 * 16;
    st.vfb = lds + L_V + (4 * g + (q16 >> 2)) * 32 + (lane & 3) * 8;
    st.tl_end = (q0 - 622 >= 0) ? (q0 - 622) / 64 + 1 : 0;
    st.tr_beg = (q0 + 814 + 63) / 64;
    Sc sc;
    MLA_WAITBAR();
    { const LAS unsigned char* kb_ = st.kfb;
#pragma unroll
      for (int kb = 0; kb < 4; ++kb) { sc.v[kb][0] = (f32x4){0.f, 0.f, 0.f, 0.f}; sc.v[kb][1] = (f32x4){0.f, 0.f, 0.f, 0.f}; }
#pragma unroll
      for (int db = 0; db < 3; ++db)
#pragma unroll
          for (int kb = 0; kb < 4; ++kb) { const bf16x8 a = *(const LAS bf16x8*)(kb_ + db * 4096 + kb * 256);
              sc.v[kb][0] = MFMA16(a, st.qf[0][db], sc.v[kb][0]); sc.v[kb][1] = MFMA16(a, st.qf[1][db], sc.v[kb][1]); }
      const float cb0 = tile_cb2(st, 0);
#pragma unroll
      for (int qb = 0; qb < 2; ++qb) { float mx = sc.v[0][qb][0];
#pragma unroll
          for (int kb = 0; kb < 4; ++kb)
#pragma unroll
              for (int r = 0; r < 4; ++r) mx = fmaxf(mx, sc.v[kb][qb][r]);
          mx = fmaxf(mx, __shfl_xor(mx, 16)); mx = fmaxf(mx, __shfl_xor(mx, 32));
          st.m[qb] = mx + cb0;
#pragma unroll
          for (int kb = 0; kb < 4; ++kb) sc.v[kb][qb] -= mx; }
      st.cbn = 1e30f; }
    MLA_BAR();
#define MLA_STAGE(t) do { if ((t) + 3 < NT) MLA_DMA_K((t) + 3, ((t) + 3) & 3); if ((t) + 2 < NT) MLA_DMA_V((t) + 2, ((t) + 2) & 3); } while (0)
    if (grp == 0) {
        MLA_STAGE(0);
        for (int t = 0; t < NT; ++t) {
            h1x<SAFE, false>(st, sc, t, lane);
            if (t + 3 < NT) MLA_WAITBAR_N(6); else MLA_WAITBAR();
            h2x<false>(st, sc, (t + 1) & 3, t & 3);
            MLA_STAGE(t + 1);
            MLA_BAR();
        }
    } else {
        for (int t = 0; t < NT; ++t) {
            if (t > 0) h2x<true>(st, sc, t & 3, (t - 1) & 3);
            if (t + 3 < NT) MLA_WAITBAR_N(2); else MLA_WAITBAR();
            MLA_STAGE(t);
            h1x<SAFE, true>(st, sc, t, lane);
            MLA_BAR();
        }
        h2x<true>(st, sc, NT & 3, (NT - 1) & 3);
    }
#undef MLA_STAGE
    float l[2];
#pragma unroll
    for (int qb = 0; qb < 2; ++qb) { float v = st.l[qb]; v += __shfl_xor(v, 16); v += __shfl_xor(v, 32); l[qb] = grp == 1 ? st.accl[qb][0] : v; }
    bool ok = true;
    if (!SAFE) { const bool bad = !(l[0] > 0.f && l[0] < 1.0e37f) || !(l[1] > 0.f && l[1] < 1.0e37f);
        LAS unsigned* flag = (LAS unsigned*)(lds + L_FLAG);
        if (lane == 0) flag[wave] = __any(bad) ? 1u : 0u;
        else (void)__any(bad);
        MLA_BAR();
        unsigned f = 0;
#pragma unroll
        for (int i = 0; i < 8; ++i) f |= flag[i];
        ok = (f == 0u); }
    LAS bf16* stg = (LAS bf16*)(lds + L_OST) + wave * 2048;
#pragma unroll
    for (int qb = 0; qb < 2; ++qb) { const float inv = 1.0f / l[qb];
#pragma unroll
        for (int dblk = 0; dblk < 4; ++dblk) { u32x2 w; w.x = cvtpk(st.ot[dblk][qb][0] * inv, st.ot[dblk][qb][1] * inv); w.y = cvtpk(st.ot[dblk][qb][2] * inv, st.ot[dblk][qb][3] * inv);
            *(LAS u32x2*)(stg + (16 * qb + q16) * 64 + 16 * dblk + 4 * g) = w; } }
    asm volatile("s_waitcnt lgkmcnt(0)" ::: "memory");
    bf16* Ow = O + (size_t)(q0 + 32 * wave) * D + h * 64;
#pragma unroll
    for (int i = 0; i < 4; ++i) { const int row = i * 8 + (lane >> 3), ch = lane & 7; const u32x4 v = *(const LAS u32x4*)(stg + row * 64 + ch * 8); *(u32x4*)(Ow + (size_t)row * D + ch * 8) = v; }
    MLA_WAITBAR();
#undef MLA_DMA_K
#undef MLA_DMA_V
    return ok;
}
}

__device__ __forceinline__ void ffn_up_phase(LAS unsigned char* lds, const bf16* Xb, const bf16* Wgu, bf16* act, const float* ss, unsigned char* ws, int which, int G, int bx) {
    pg8::Gemm g{Xb, Wgu, S, 2 * FF, D, D}; pg8::StaticOrder So; So.init(S, 2 * FF, G, bx);
    const pg8::EpiSwiGLU E{act, ss};
    const int full = (So.nwg / G) * G, tail = So.nwg - full;
    const bool split = (tail * 2 == G) && (WS_V1 + (size_t)tail * 262144 <= WS_SAVE);
    if (split) So.hi = full;
    pg8::gemm_phase<pg8::EpiSwiGLU, true>(lds, g, So, E);
    if (split) {
        const int cc = bx < tail ? bx : bx - tail; const bool helper = bx >= tail;
        const pg8::Gemm g2{Xb + (helper ? D / 2 : 0), Wgu + (helper ? D / 2 : 0), S, 2 * FF, D / 2, D, D};
        pg8::StaticOrder So2; So2.init(S, 2 * FF, G, cc); So2.lo = full;
        float* part = (float*)(ws + WS_V1) + (size_t)cc * 65536; unsigned* fl = (unsigned*)(ws + CTL_SPLIT) + which * 2048 + cc * 16;
        pg8::gemm_phase<pg8::EpiSplit<pg8::EpiSwiGLU>, true>(lds, g2, So2, pg8::EpiSplit<pg8::EpiSwiGLU>{E, part, fl, helper});
    }
}

constexpr int NWAVES = 8;
__global__ void __launch_bounds__(NWAVES * 64, 2) fwd_kernel(Args args) {
    extern __shared__ __attribute__((aligned(16))) unsigned char lds_raw[];
    LAS unsigned char* lds = (LAS unsigned char*)lds_raw;
    volatile LAS unsigned* MISC = (volatile LAS unsigned*)(lds + MISC_OFF);
    const int tid = threadIdx.x, lane = tid & 63, wave = __builtin_amdgcn_readfirstlane(tid >> 6);
    const int G = gridDim.x; const int bx = blockIdx.x;
    const int vcu = (G % 8 == 0) ? (bx % 8) * (G / 8) + bx / 8 : bx;
    unsigned char* ws = args.ws;
    float* const out = args.out;
    const int lo = args.ph_lo, hi_ph = args.ph_hi;
    for (int u = tid; u < (LDS_BYTES - LDSCTL_OFF) / 4; u += NWAVES * 64) ((LAS unsigned*)(lds + LDSCTL_OFF))[u] = 0u;
    __syncthreads();
    const bool multi = (hi_ph - lo) > 1;
    XcdBarrier bar; bar.bar = (unsigned*)(ws + CTL_BAR); bar.x = 0; bar.st = nullptr;
    if (multi) bar = xcd_barrier_post((unsigned*)(ws + CTL_BAR), MISC + 8);
#ifndef PHASE_MASK
#define PHASE_MASK 0x1fff
#endif
#define IN(k) ((((PHASE_MASK) >> (k)) & 1) && lo <= (k) && (k) < hi_ph)
#ifndef REPEAT_MASK
#define REPEAT_MASK 0
#endif
#define REPS(k) ((((REPEAT_MASK) >> (k)) & 1) ? 2 : 1)
#define SEAM(k) do { if (IN(k) && IN((k) + 1)) xcd_barrier(bar); } while (0)

    float* const SS = (float*)(ws + CTL_SS);
    float* const SS0 = SS, * const SS1 = SS + S, * const SS2 = SS + 2 * S, * const SS3 = SS + 3 * S, * const SS4 = SS + 4 * S, * const SSQ = SS + 5 * S, * const SSKV = SS + 6 * S;
    bf16* const XB = (bf16*)(ws + WS_XB); bf16* const OB = (bf16*)(ws + WS_O); bf16* const BIG = (bf16*)(ws + WS_BIG);
    bf16* const Q1 = (bf16*)(ws + WS_Q1); bf16* const K1 = (bf16*)(ws + WS_K1); bf16* const V1 = (bf16*)(ws + WS_V1);
    const float* const ROPE = (const float*)(ws + WS_ROPE);
    const int gw = vcu * NWAVES + wave, NGW = G * NWAVES;

    if (IN(0)) {
        LAS float* scr = (LAS float*)(lds + wave * 16384);
        const float* an0 = args.in[I_ANORM], * an1 = args.in[I_ANORM] + D, * fn0 = args.in[I_FNORM], * fn1 = args.in[I_FNORM] + D;
        constexpr int NITEMS = 1536 + 512 + 1408 * 3 + 272 + 288 + 64 + 64 + 512 + 1408 * 3;
        for (int it = gw; it < NITEMS; it += NGW) {
            int r = it;
            if (p0_matrix<0>(r, args.in[I_EWIN], D, NQKV, an0, (bf16*)(ws + W_IN0), D, 0, scr, lane)) continue;
            if (p0_matrix<0>(r, args.in[I_EWOUT], D, D, nullptr, (bf16*)(ws + W_OUT0), D, 0, scr, lane)) continue;
            if (p0_matrix<1>(r, args.in[I_WG], D, FF, fn0, (bf16*)(ws + W_GU0), D, 0, scr, lane)) continue;
            if (p0_matrix<2>(r, args.in[I_WU], D, FF, fn0, (bf16*)(ws + W_GU0), D, 0, scr, lane)) continue;
            if (p0_matrix<0>(r, args.in[I_WD], FF, D, nullptr, (bf16*)(ws + W_D0), FF, 0, scr, lane)) continue;
            if (p0_matrix<0>(r, args.in[I_OWIN], D, NIN1, an1, (bf16*)(ws + W_IN1), D, 0, scr, lane)) continue;
            if (p0_matrix<0>(r, args.in[I_WUQ], QL, NQ1, args.in[I_QNORM], (bf16*)(ws + W_UQ), QL, 0, scr, lane)) continue;
            if (p0_matrix<0>(r, args.in[I_WUK], KVL, D, args.in[I_KVNORM], (bf16*)(ws + W_UKV), KVLP, 0, scr, lane)) continue;
            if (p0_matrix<0>(r, args.in[I_WUV], KVL, D, args.in[I_KVNORM], (bf16*)(ws + W_UKV), KVLP, 1024, scr, lane)) continue;
            if (p0_matrix<0>(r, args.in[I_OWOUT], D, D, nullptr, (bf16*)(ws + W_OUT1), D, 0, scr, lane)) continue;
            if (p0_matrix<1>(r, args.in[I_WG] + (size_t)D * FF, D, FF, fn1, (bf16*)(ws + W_GU1), D, 0, scr, lane)) continue;
            if (p0_matrix<2>(r, args.in[I_WU] + (size_t)D * FF, D, FF, fn1, (bf16*)(ws + W_GU1), D, 0, scr, lane)) continue;
            p0_matrix<0>(r, args.in[I_WD] + (size_t)FF * D, FF, D, nullptr, (bf16*)(ws + W_D1), FF, 0, scr, lane);
        }
        const int gt = vcu * (NWAVES * 64) + tid, NGT = G * NWAVES * 64;
        for (int i = gt; i < (NIN1P - NIN1) * D / 8; i += NGT) ((u32x4*)(ws + W_IN1 + (size_t)NIN1 * D * 2))[i] = (u32x4){0u, 0u, 0u, 0u};
        for (int i = gt; i < NKV1 * 16; i += NGT) { const int row = i >> 4, c = i & 15; *(u32x4*)(ws + W_UKV + ((size_t)row * KVLP + KVL + c * 8) * 2) = (u32x4){0u, 0u, 0u, 0u}; }
        for (int mrow = gw * 4; mrow < S; mrow += NGW * 4) {
            f32x4 v[4][4];
#pragma unroll
            for (int rr = 0; rr < 4; ++rr) { const f32x4* xr = (const f32x4*)(args.in[I_X] + (size_t)(mrow + rr) * D) + lane;
#pragma unroll
                for (int j = 0; j < 4; ++j) v[rr][j] = xr[64 * j]; }
#pragma unroll
            for (int rr = 0; rr < 4; ++rr) { float s2 = 0.f; unsigned long long* o8 = (unsigned long long*)(XB + (size_t)(mrow + rr) * D) + lane;
#pragma unroll
                for (int j = 0; j < 4; ++j) { const f32x4 w = v[rr][j]; s2 += (w.x * w.x + w.y * w.y) + (w.z * w.z + w.w * w.w);
                    o8[64 * j] = (unsigned long long)cvtpk(w.x, w.y) | ((unsigned long long)cvtpk(w.z, w.w) << 32); }
                s2 = wave_sum(s2);
                if (lane == 0) SS0[mrow + rr] = s2; }
        }
        float* rope = (float*)(ws + WS_ROPE);
        for (int i = gt; i < S * 16; i += NGT) { const int pos = i >> 4, fi = i & 15; const float fr = powf(10000.0f, -(float)fi / 16.0f), ang = (float)pos * fr;
            rope[2 * i] = cosf(ang); rope[2 * i + 1] = sinf(ang); }
        const float* t5 = args.in[I_T5];
        float* tdil = (float*)(ws + WS_TDIL);
        for (int i = gt; i < 8 * 2368; i += NGT) { const int h = i / 2368, d = i % 2368 - 1152, n = d < 0 ? -d : d; int mult = 0;
            if (n <= 64) ++mult; if ((d & 3) == 0 && n <= 256) ++mult; if ((d & 15) == 0 && n <= 1024) ++mult;
            tdil[i] = mult ? (t5[t5_bucket_precise(d) * 16 + h] + logf((float)mult)) * LOG2E : NEGB; }
        float* tmla = (float*)(ws + WS_TMLA);
        for (int i = gt; i < 16 * 1984; i += NGT) { const int h = i / 1984; int d = i % 1984 - 960; d = d > 960 ? 960 : d; tmla[i] = t5[t5_bucket_precise(d) * 16 + h] * LOG2E; }
        float* trpb = (float*)(ws + WS_TRPB);
        for (int i = gt; i < 8 * 465; i += NGT) trpb[i] = args.in[I_RPB][i] * LOG2E;
    }
    SEAM(0);

    if (IN(1)) for (int rep_ = 0; rep_ < REPS(1); ++rep_) {
        pg8::Gemm g{XB, (const bf16*)(ws + W_IN0), S, NQKV, D, D}; pg8::StaticOrder So; So.init(S, NQKV, G, bx);
        pg8::EpiRowScale E{BIG, NQKV, SS0, 1.0f / D, 1};
        pg8::gemm_phase<pg8::EpiRowScale, true>(lds, g, So, E);
    }
    SEAM(1);

    if (IN(2)) for (int rep_ = 0; rep_ < REPS(2); ++rep_) {
        const int hd = vcu >> 5;
        LAS float* tdl = (LAS float*)(lds + 132096); LAS float* trp = (LAS float*)(lds + 132096 + 9472);
        for (int i = tid; i < 2368; i += NWAVES * 64) tdl[(i & 3) * 592 + (i >> 2)] = ((const float*)(ws + WS_TDIL))[hd * 2368 + i];
        for (int i = tid; i < 465; i += NWAVES * 64) trp[i] = ((const float*)(ws + WS_TRPB))[hd * 465 + i];
        __syncthreads();
        LAS unsigned char* wl = lds + wave * wattn::WREG;
        const int r32 = lane & 31;
        for (int rd = 0; rd < 2; ++rd) {
            const int blk = rd * 64 + 2 * (vcu & 31) + (wave >> 2), t0 = blk * 128, w = wave & 3;
            wattn::DilF f{t0, w, (t0 < 1152) || (t0 + 128 + 1152 > S), tdl};
            const int tq = t0 + w + 4 * r32;
            if (!wattn::run_unit<false>(f, BIG + (size_t)tq * NQKV + hd * 64, (const char*)(BIG + 512 + hd * 64), OB + (size_t)tq * D + hd * 64, wl, lane))
                (void)wattn::run_unit<true>(f, BIG + (size_t)tq * NQKV + hd * 64, (const char*)(BIG + 512 + hd * 64), OB + (size_t)tq * D + hd * 64, wl, lane);
        }
        for (int rn = 0; rn < 2; ++rn) {
            const int gr0 = rn * 128 + 4 * (vcu & 31);
            if (!wattn::na_coop<false>(gr0, BIG + 1536 + hd * 64, (const char*)(BIG + 2048 + hd * 64), OB + 512 + hd * 64, trp, lds, wave, lane))
                (void)wattn::na_coop<true>(gr0, BIG + 1536 + hd * 64, (const char*)(BIG + 2048 + hd * 64), OB + 512 + hd * 64, trp, lds, wave, lane);
        }
        __syncthreads();
    }
    SEAM(2);

    if (IN(3)) {
        pg8::Gemm g{OB, (const bf16*)(ws + W_OUT0), S, D, D, D}; pg8::StaticOrder So; So.init(S, D, G, bx);
#if DBG_CHECK
        pg8::EpiResid E{args.in[I_X], nullptr, out, XB, SS1};
#else
        pg8::EpiResid E{args.in[I_X], nullptr, nullptr, XB, SS1};
#endif
        pg8::gemm_phase<pg8::EpiResid, true>(lds, g, So, E);
    }
    SEAM(3);
    if (IN(4)) for (int rep_ = 0; rep_ < REPS(4); ++rep_) {
        ffn_up_phase(lds, XB, (const bf16*)(ws + W_GU0), BIG, SS1, ws, 0, G, bx);
    }
    SEAM(4);
    if (IN(5)) {
        pg8::Gemm g{BIG, (const bf16*)(ws + W_D0), S, D, FF, FF}; pg8::StaticOrder So; So.init(S, D, G, bx);
#if DBG_CHECK
        pg8::EpiResid E{out, nullptr, out, XB, SS2};
#else
        pg8::EpiResid E{nullptr, XB, nullptr, XB, SS2};
#endif
        pg8::gemm_phase<pg8::EpiResid, true>(lds, g, So, E);
    }
    SEAM(5);
    if (IN(6)) {
        pg8::Gemm g{XB, (const bf16*)(ws + W_IN1), S, NIN1P, D, D}; pg8::StaticOrder So; So.init(S, NIN1P, G, bx);
        pg8::EpiMlaIn E{OB, SS2, SSQ, SSKV, K1, ROPE};
        pg8::gemm_phase<pg8::EpiMlaIn, true>(lds, g, So, E);
    }
    SEAM(6);
    if (IN(7)) for (int rep_ = 0; rep_ < REPS(7); ++rep_) {
        { pg8::Gemm g{OB, (const bf16*)(ws + W_UQ), S, NQ1, QL, NIN1P}; pg8::StaticOrder So; So.init(S, NQ1, G, bx);
          pg8::EpiMlaQ E{Q1, SSQ, ROPE};
          pg8::gemm_phase<pg8::EpiMlaQ, true>(lds, g, So, E); }
        { pg8::Gemm g{OB + QL, (const bf16*)(ws + W_UKV), S, NKV1, KVLP, NIN1P}; pg8::StaticOrder So; So.init(S, NKV1, G, bx);
          pg8::EpiMlaKV E{K1, V1, SSKV};
          pg8::gemm_phase<pg8::EpiMlaKV, true>(lds, g, So, E); }
    }
    SEAM(7);
    if (IN(8)) for (int rep_ = 0; rep_ < REPS(8); ++rep_) {
        const int hm = vcu >> 4;
        LAS float* tml = (LAS float*)(lds + mla::L_TBL);
        const float* tg = (const float*)(ws + WS_TMLA) + hm * 1984;
        for (int i = tid; i < 1921; i += NWAVES * 64) tml[i] = tg[i];
        const float clo = tg[0], chi = tg[1920];
        __syncthreads();
        for (int rd = 0; rd < 4; ++rd) { const int q0 = ((vcu & 15) * 4 + rd) * 256;
            if (!mla::unitx<false>(hm, q0, Q1, K1, V1, OB, lds, clo, chi, wave, lane)) (void)mla::unitx<true>(hm, q0, Q1, K1, V1, OB, lds, clo, chi, wave, lane); }
        __syncthreads();
    }
    SEAM(8);
    if (IN(9)) {
        pg8::Gemm g{OB, (const bf16*)(ws + W_OUT1), S, D, D, D}; pg8::StaticOrder So; So.init(S, D, G, bx);
#if DBG_CHECK
        pg8::EpiResid E{out, nullptr, out, XB, SS3};
#else
        pg8::EpiResid E{nullptr, XB, nullptr, XB, SS3};
#endif
        pg8::gemm_phase<pg8::EpiResid, true>(lds, g, So, E);
    }
    SEAM(9);
    if (IN(10)) for (int rep_ = 0; rep_ < REPS(10); ++rep_) {
        ffn_up_phase(lds, XB, (const bf16*)(ws + W_GU1), BIG, SS3, ws, 1, G, bx);
    }
    SEAM(10);
#if DBG_CHECK || !defined(FUSE_FINAL_NORM)
    if (IN(11)) {
        pg8::Gemm g{BIG, (const bf16*)(ws + W_D1), S, D, FF, FF}; pg8::StaticOrder So; So.init(S, D, G, bx);
        pg8::EpiResid E{out, nullptr, out, XB, SS4};
        pg8::gemm_phase<pg8::EpiResid, true>(lds, g, So, E);
    }
    SEAM(11);
    if (IN(12)) {
        const f32x4* gf = (const f32x4*)args.in[I_FINAL] + lane;
        for (int mrow = gw; mrow < S; mrow += NGW) {
            f32x4* xr = (f32x4*)(out + (size_t)mrow * D) + lane; f32x4 v[4]; float s2 = 0.f;
#pragma unroll
            for (int j = 0; j < 4; ++j) { v[j] = xr[64 * j]; s2 += (v[j].x * v[j].x + v[j].y * v[j].y) + (v[j].z * v[j].z + v[j].w * v[j].w); }
            const float rs = 1.0f / sqrtf(wave_sum(s2) * (1.0f / D) + RMS_EPS);
#pragma unroll
            for (int j = 0; j < 4; ++j) xr[64 * j] = v[j] * rs * gf[64 * j];
        }
    }
#else
    if (IN(11)) {
        pg8::Gemm g{BIG, (const bf16*)(ws + W_D1), S, D, FF, FF}; pg8::StaticOrder So; So.init(S, D, G, bx);
        pg8::EpiFinal E{nullptr, XB, out, SS4, (unsigned*)(ws + CTL_PANEL), args.in[I_FINAL]};
        pg8::gemm_phase<pg8::EpiFinal, true>(lds, g, So, E);
    }
#endif
#ifdef TIMING_SEL
    if (IN(12)) { __syncthreads(); if (blockIdx.x == 0) { const float* tp = (const float*)(ws + CTL_STATS); const float A = rintf(tp[TIMING_SEL] * (1.0f / 1024.0f) * (1.0f / 32.0f)) * 32.0f, B = rintf(tp[TIMING_SEL2] * (1.0f / 1024.0f) * (1.0f / 32.0f)) * 0.32f;
        if (tid == 0) out[0] += A; for (int i = tid; i < 16384; i += NWAVES * 64) if (i) out[(size_t)i * 1024] += B; } }
#endif
#undef IN
#undef SEAM
}

#if DBG_CHECK
namespace dbg {
constexpr int NSAMP = 1024;
__device__ __forceinline__ int srow(int i) { return 16 * i + ((i * 5) & 15); }
__device__ __forceinline__ void accum(float err, float ref, float* stats, int slot) {
    __shared__ float se[8], sr[8];
    err = wave_sum(err); ref = wave_sum(ref);
    const int w = threadIdx.x >> 6;
    if ((threadIdx.x & 63) == 0) { se[w] = err; sr[w] = ref; }
    __syncthreads();
    if (threadIdx.x == 0) { float e = 0.f, r = 0.f; for (int i = 0; i < (int)(blockDim.x >> 6); ++i) { e += se[i]; r += sr[i]; } atomicAdd(stats + 2 * slot, e); atomicAdd(stats + 2 * slot + 1, r); }
    __syncthreads();
}
__global__ void k_rowrstd(const float* src, int ld, int ncols, int compact, float* outv) {
    const int i = blockIdx.x, m = compact ? i : srow(i); float s = 0.f;
    for (int k = threadIdx.x; k < ncols; k += 64) { const float v = src[(size_t)m * ld + k]; s += v * v; }
    s = wave_sum(s);
    if (threadIdx.x == 0) outv[i] = 1.0f / sqrtf(s / ncols + RMS_EPS);
}
__global__ void k_rowrstd_bf(const bf16* src, int ld, int ncols, float* outv) {
    const int i = blockIdx.x, m = srow(i); float s = 0.f;
    for (int k = threadIdx.x; k < ncols; k += 64) { const float v = bf2f(src[(size_t)m * ld + k]); s += v * v; }
    s = wave_sum(s);
    if (threadIdx.x == 0) outv[i] = 1.0f / sqrtf(s / ncols + RMS_EPS);
}
__global__ void k_save_rows(const float* src, float* dst) {
    const int i = blockIdx.x, m = srow(i);
    for (int k = threadIdx.x; k < D; k += blockDim.x) dst[(size_t)i * D + k] = src[(size_t)m * D + k];
}
template <int ABF, int GOTBF>
__global__ void k_chk_lin(const void* A, int lda, int acomp, const float* rs, const float* gain, const float* W, int ldw, int K, int N,
                          const float* resid, int ldr, int rcomp, const void* got, int ldg, float gscale, float* stats, int slot) {
    const int i = blockIdx.y, m = srow(i), n = blockIdx.x * 256 + threadIdx.x;
    float err = 0.f, ref2 = 0.f;
    if (n < N) {
        const size_t arow = (size_t)(acomp ? i : m) * lda; float acc = 0.f;
        for (int k = 0; k < K; ++k) { const float a = ABF ? bf2f(((const bf16*)A)[arow + k]) : ((const float*)A)[arow + k]; acc += a * (gain ? gain[k] : 1.0f) * W[(size_t)k * ldw + n]; }
        float ref = acc * (rs ? rs[i] : 1.0f);
        if (resid) ref += resid[(size_t)(rcomp ? i : m) * ldr + n];
        float g = (GOTBF ? bf2f(((const bf16*)got)[(size_t)m * ldg + n]) : ((const float*)got)[(size_t)m * ldg + n]) * gscale;
        if (slot == 1 && (n < 512 || (n >= 1536 && n < 2048))) g *= (1.0f / C2_LOCAL);
        err = (g - ref) * (g - ref); ref2 = ref * ref;
    }
    accum(err, ref2, stats, slot);
}
__global__ void k_chk_swiglu(const float* X, const float* rs, const float* gain, const float* Wg, const float* Wu, const bf16* got, float* stats, int slot) {
    const int i = blockIdx.y, m = srow(i), n = blockIdx.x * 256 + threadIdx.x;
    float a = 0.f, b = 0.f;
    for (int k = 0; k < D; ++k) { const float h = X[(size_t)m * D + k] * gain[k]; a += h * Wg[(size_t)k * FF + n]; b += h * Wu[(size_t)k * FF + n]; }
    a *= rs[i]; b *= rs[i];
    const float ref = a / (1.0f + expf(-a)) * b, g = bf2f(got[(size_t)m * FF + n]);
    accum((g - ref) * (g - ref), ref * ref, stats, slot);
}
__global__ void k_chk_krope(const float* X, const float* rs, const float* gain, const float* Win1, const bf16* K1, float* stats, int slot) {
    const int si = blockIdx.x, m = srow(si), i = threadIdx.x & 31, f = i & 15;
    float x1 = 0.f, x2 = 0.f;
    for (int k = 0; k < D; ++k) { const float h = X[(size_t)m * D + k] * gain[k]; x1 += h * Win1[(size_t)k * NIN1 + 512 + f]; x2 += h * Win1[(size_t)k * NIN1 + 528 + f]; }
    x1 *= rs[si]; x2 *= rs[si];
    const float fr = powf(10000.0f, -(float)f / 16.0f), ang = (float)m * fr, c = cosf(ang), sn = sinf(ang);
    const float ref = (i < 16) ? (x1 * c - x2 * sn) : (x1 * sn + x2 * c);
    float err = 0.f, r2 = 0.f;
    for (int h = (threadIdx.x >> 5) * 8; h < (threadIdx.x >> 5) * 8 + 8; ++h) { const float g = bf2f(K1[(size_t)m * KPITCH + h * 96 + 64 + i]); err += (g - ref) * (g - ref); r2 += ref * ref; }
    accum(err, r2, stats, slot);
}
__global__ void k_chk_q(const bf16* P, const float* rsq, const float* qnorm, const float* Wuq, const bf16* Q1, float* stats, int slot) {
    const int si = blockIdx.y, m = srow(si), n = blockIdx.x * 256 + threadIdx.x, off = n % 96;
    const bool rope = off >= 64; const int f = (off - 64) & 15; const int n1 = n - off + 64 + f, n2 = n1 + 16;
    float a = 0.f, b = 0.f;
    for (int k = 0; k < QL; ++k) { const float c = bf2f(P[(size_t)m * NIN1P + k]) * qnorm[k];
        if (rope) { a += c * Wuq[(size_t)k * NQ1 + n1]; b += c * Wuq[(size_t)k * NQ1 + n2]; } else a += c * Wuq[(size_t)k * NQ1 + n]; }
    a *= rsq[si]; b *= rsq[si];
    float ref = a;
    if (rope) { const float fr = powf(10000.0f, -(float)f / 16.0f), ang = (float)m * fr, c = cosf(ang), sn = sinf(ang); ref = (off < 80) ? (a * c - b * sn) : (a * sn + b * c); }
    const float g = bf2f(Q1[(size_t)m * NQ1 + n]) / C2_MLA;
    accum((g - ref) * (g - ref), ref * ref, stats, slot);
}
__global__ void k_chk_kv(const bf16* P, const float* rskv, const float* kvnorm, const float* W, const bf16* got, int iskf, float* stats, int slot) {
    const int si = blockIdx.y, m = srow(si), n = blockIdx.x * 256 + threadIdx.x;
    float a = 0.f;
    for (int k = 0; k < KVL; ++k) a += bf2f(P[(size_t)m * NIN1P + QL + k]) * kvnorm[k] * W[(size_t)k * D + n];
    a *= rskv[si];
    const float g = iskf ? bf2f(got[(size_t)m * KPITCH + (n >> 6) * 96 + (n & 63)]) : bf2f(got[(size_t)m * D + n]);
    accum((g - a) * (g - a), a * a, stats, slot);
}
__device__ __forceinline__ int ltok(int i) { if (i < 4) return i; if (i < 8) return S - 1 - (i - 4); return 32 * i + ((i * 13) & 31); }
__global__ void __launch_bounds__(64) k_chk_local(const bf16* QKV, const float* t5, const float* rpb, const bf16* O, float* stats, int slot) {
    const int idx = blockIdx.x * 64 + threadIdx.x, i = idx >> 4, h = idx & 15, t = ltok(i);
    float q[64], o[64];
    float err = 0.f, r2 = 0.f;
    if (h < 8) {
        const bf16* qp = QKV + (size_t)t * NQKV + h * 64;
        _Pragma("unroll") for (int d = 0; d < 64; ++d) { q[d] = bf2f(qp[d]) * (1.0f / C2_LOCAL); o[d] = 0.f; }
        float mb[3], denb[3];
        _Pragma("unroll") for (int b = 0; b < 3; ++b) { const int dil = b == 0 ? 1 : (b == 1 ? 4 : 16); float mx = -3e38f;
            for (int j = -64; j <= 64; ++j) { const int u = t + dil * j; if (u < 0 || u >= S) continue;
                const bf16* kp = QKV + (size_t)u * NQKV + 512 + h * 64; float sc = 0.f; _Pragma("unroll") for (int d = 0; d < 64; ++d) sc += q[d] * bf2f(kp[d]);
                sc = sc * 0.125f + t5[t5_bucket_precise(dil * j) * 16 + h]; mx = fmaxf(mx, sc); }
            float den = 0.f;
            for (int j = -64; j <= 64; ++j) { const int u = t + dil * j; if (u < 0 || u >= S) continue;
                const bf16* kp = QKV + (size_t)u * NQKV + 512 + h * 64; float sc = 0.f; _Pragma("unroll") for (int d = 0; d < 64; ++d) sc += q[d] * bf2f(kp[d]);
                sc = sc * 0.125f + t5[t5_bucket_precise(dil * j) * 16 + h]; den += expf(sc - mx); }
            mb[b] = mx; denb[b] = den; }
        float lse[3], M = -3e38f; _Pragma("unroll") for (int b = 0; b < 3; ++b) { lse[b] = mb[b] + logf(denb[b]); M = fmaxf(M, lse[b]); }
        float wsum = 0.f, wb[3]; _Pragma("unroll") for (int b = 0; b < 3; ++b) { wb[b] = expf(lse[b] - M); wsum += wb[b]; }
        _Pragma("unroll") for (int b = 0; b < 3; ++b) { const int dil = b == 0 ? 1 : (b == 1 ? 4 : 16); const float coef = wb[b] / wsum / denb[b];
            for (int j = -64; j <= 64; ++j) { const int u = t + dil * j; if (u < 0 || u >= S) continue;
                const bf16* kp = QKV + (size_t)u * NQKV + 512 + h * 64; const bf16* vp = QKV + (size_t)u * NQKV + 1024 + h * 64; float sc = 0.f; _Pragma("unroll") for (int d = 0; d < 64; ++d) sc += q[d] * bf2f(kp[d]);
                sc = sc * 0.125f + t5[t5_bucket_precise(dil * j) * 16 + h]; const float p = expf(sc - mb[b]) * coef;
                _Pragma("unroll") for (int d = 0; d < 64; ++d) o[d] += p * bf2f(vp[d]); } }
        const bf16* op = O + (size_t)t * D + h * 64;
        _Pragma("unroll") for (int d = 0; d < 64; ++d) { const float g = bf2f(op[d]); err += (g - o[d]) * (g - o[d]); r2 += o[d] * o[d]; }
    } else {
        const int hb = h - 8, r = t >> 6, c = t & 63;
        int r0 = r - 4; r0 = r0 < 0 ? 0 : (r0 > 248 ? 248 : r0); int c0 = c - 8; c0 = c0 < 0 ? 0 : (c0 > 48 ? 48 : c0);
        const bf16* qp = QKV + (size_t)t * NQKV + 1536 + hb * 64;
        _Pragma("unroll") for (int d = 0; d < 64; ++d) { q[d] = bf2f(qp[d]) * (1.0f / C2_LOCAL); o[d] = 0.f; }
        float mx = -3e38f;
        for (int kr = 0; kr < 8; ++kr) for (int kc = c0; kc < c0 + 16; ++kc) { const int u = (r0 + kr) * 64 + kc;
            const bf16* kp = QKV + (size_t)u * NQKV + 2048 + hb * 64; float sc = 0.f; _Pragma("unroll") for (int d = 0; d < 64; ++d) sc += q[d] * bf2f(kp[d]);
            sc = sc * 0.125f + rpb[(hb * 15 + (r0 + kr - r + 7)) * 31 + (kc - c + 15)]; mx = fmaxf(mx, sc); }
        float den = 0.f;
        for (int kr = 0; kr < 8; ++kr) for (int kc = c0; kc < c0 + 16; ++kc) { const int u = (r0 + kr) * 64 + kc;
            const bf16* kp = QKV + (size_t)u * NQKV + 2048 + hb * 64; const bf16* vp = QKV + (size_t)u * NQKV + 2560 + hb * 64; float sc = 0.f; _Pragma("unroll") for (int d = 0; d < 64; ++d) sc += q[d] * bf2f(kp[d]);
            sc = sc * 0.125f + rpb[(hb * 15 + (r0 + kr - r + 7)) * 31 + (kc - c + 15)]; const float p = expf(sc - mx); den += p;
            _Pragma("unroll") for (int d = 0; d < 64; ++d) o[d] += p * bf2f(vp[d]); }
        const bf16* op = O + (size_t)t * D + 512 + hb * 64;
        _Pragma("unroll") for (int d = 0; d < 64; ++d) { const float g = bf2f(op[d]); const float rf = o[d] / den; err += (g - rf) * (g - rf); r2 += rf * rf; }
    }
    accum(err, r2, stats, slot);
}
__global__ void __launch_bounds__(256) k_chk_mla(const bf16* Q1, const bf16* K1, const bf16* V1, const float* t5, const bf16* O, float* stats, int slot) {
    const int i = blockIdx.x >> 4, h = blockIdx.x & 15, t = 256 * i + ((i * 37) & 255), tid = threadIdx.x;
    __shared__ float qs[96], red[8], so[64];
    if (tid < 96) qs[tid] = bf2f(Q1[(size_t)t * NQ1 + h * 96 + tid]);
    if (tid < 64) so[tid] = 0.f;
    __syncthreads();
    float mx = -3e38f;
    for (int k = tid; k < S; k += 256) { const bf16* kp = K1 + (size_t)k * KPITCH + h * 96; float sc = 0.f; _Pragma("unroll") for (int d = 0; d < 96; ++d) sc += qs[d] * bf2f(kp[d]);
        sc += t5[t5_bucket_precise(k - t) * 16 + h] * LOG2E; mx = fmaxf(mx, sc); }
    for (int o = 1; o < 64; o <<= 1) mx = fmaxf(mx, __shfl_xor(mx, o));
    if ((tid & 63) == 0) red[tid >> 6] = mx;
    __syncthreads();
    mx = fmaxf(fmaxf(red[0], red[1]), fmaxf(red[2], red[3]));
    __syncthreads();
    float den = 0.f, o[64];
    _Pragma("unroll") for (int d = 0; d < 64; ++d) o[d] = 0.f;
    for (int k = tid; k < S; k += 256) { const bf16* kp = K1 + (size_t)k * KPITCH + h * 96; const bf16* vp = V1 + (size_t)k * D + h * 64; float sc = 0.f; _Pragma("unroll") for (int d = 0; d < 96; ++d) sc += qs[d] * bf2f(kp[d]);
        sc += t5[t5_bucket_precise(k - t) * 16 + h] * LOG2E; const float p = exp2f(sc - mx); den += p;
        _Pragma("unroll") for (int d = 0; d < 64; ++d) o[d] += p * bf2f(vp[d]); }
    den = wave_sum(den);
    if ((tid & 63) == 0) red[4 + (tid >> 6)] = den;
    _Pragma("unroll") for (int d = 0; d < 64; ++d) { const float v = wave_sum(o[d]); if ((tid & 63) == 0) atomicAdd(&so[d], v); }
    __syncthreads();
    den = red[4] + red[5] + red[6] + red[7];
    float err = 0.f, r2 = 0.f;
    if (tid < 64) { const float rf = so[tid] / den, g = bf2f(O[(size_t)t * D + h * 64 + tid]); err = (g - rf) * (g - rf); r2 = rf * rf; }
    accum(err, r2, stats, slot);
}
__global__ void k_chk_final(const float* save, const float* rs, const float* gf, const float* outp, float* stats, int slot) {
    const int i = blockIdx.x, m = srow(i); float err = 0.f, r2 = 0.f;
    for (int k = threadIdx.x; k < D; k += 256) { const float ref = save[(size_t)i * D + k] * rs[i] * gf[k], g = outp[(size_t)m * D + k]; err += (g - ref) * (g - ref); r2 += ref * ref; }
    accum(err, r2, stats, slot);
}
__global__ void k_finalize(const float* stats, float* outp, float tol, int magslot) {
    if (threadIdx.x != 0 || blockIdx.x != 0) return;
    int fail = 0; float relf = 0.f;
    for (int s = 1; s <= 16; ++s) { const float e = stats[2 * s], r = stats[2 * s + 1]; const float rel = sqrtf(e / fmaxf(r, 1e-30f)); const bool bad = !(rel <= tol) || !(r > 0.f);
        if (bad && !fail) { fail = s; relf = rel; } }
    if (magslot > 0) { const float e = stats[2 * magslot], r = stats[2 * magslot + 1]; outp[0] += 1.0e4f * fminf(sqrtf(e / fmaxf(r, 1e-30f)), 10.f) + 1.0f; }
    else if (fail) outp[0] += 100.0f + 10.0f * fail;
}
}

#endif

extern "C" void kernel_launch(void* const* d_in, const int* in_sizes, int n_in, void* d_out, int out_size, void* d_ws, size_t ws_size, hipStream_t stream) {
    static int grid = 0;
    if (grid == 0) {
        if (n_in != 18 || in_sizes[0] != S * D || out_size != S * D || ws_size < WS_END) { fprintf(stderr, "kernel_launch: unexpected shapes (n_in %d, in0 %d, out %d, ws %zu)\n", n_in, n_in > 0 ? in_sizes[0] : -1, out_size, ws_size); grid = -1; return; }
        int dev = 0, cus = 0, per_cu = 0;
        if (hipGetDevice(&dev) != hipSuccess || hipDeviceGetAttribute(&cus, hipDeviceAttributeMultiprocessorCount, dev) != hipSuccess) { grid = -1; return; }
        if (hipFuncSetAttribute((const void*)fwd_kernel, hipFuncAttributeMaxDynamicSharedMemorySize, LDS_BYTES) != hipSuccess) { fprintf(stderr, "kernel_launch: hipFuncSetAttribute failed\n"); grid = -1; return; }
        if (hipOccupancyMaxActiveBlocksPerMultiprocessor(&per_cu, (const void*)fwd_kernel, NWAVES * 64, LDS_BYTES) != hipSuccess || per_cu < 1) fprintf(stderr, "kernel_launch: occupancy query reports %d\n", per_cu);
        (void)hipGetLastError();
        grid = cus;
        if (grid != 256) fprintf(stderr, "kernel_launch: %d CUs; this kernel's unit maps assume 256\n", grid);
    }
    if (grid < 0) return;
    (void)hipMemsetAsync((char*)d_ws + WS_CTL, 0, CTL_ZERO_BYTES, stream);
    Args a{};
    for (int i = 0; i < 18; ++i) a.in[i] = (const float*)d_in[i];
    a.out = (float*)d_out; a.ws = (unsigned char*)d_ws;
#if DBG_CHECK
    {
        using namespace dbg;
        unsigned char* ws = (unsigned char*)d_ws; float* outp = (float*)d_out;
        float* stats = (float*)(ws + CTL_STATS); float* rstd = (float*)(ws + CTL_RSTD); float* rstd2 = rstd + 1024; float* save = (float*)(ws + WS_SAVE);
        bf16* XBp = (bf16*)(ws + WS_XB); bf16* OBp = (bf16*)(ws + WS_O); bf16* BIGp = (bf16*)(ws + WS_BIG); bf16* Q1p = (bf16*)(ws + WS_Q1); bf16* K1p = (bf16*)(ws + WS_K1); bf16* V1p = (bf16*)(ws + WS_V1);
        const float* x = a.in[I_X];
        for (int ph = 0; ph < NPH; ++ph) {
            if (ph == 5 || ph == 9 || ph == 11 || ph == 12) hipLaunchKernelGGL(k_save_rows, dim3(NSAMP), dim3(256), 0, stream, (const float*)outp, save);
            a.ph_lo = ph; a.ph_hi = ph + 1;
            hipLaunchKernelGGL(fwd_kernel, dim3(grid), dim3(NWAVES * 64), LDS_BYTES, stream, a);
            switch (ph) {
            case 1: hipLaunchKernelGGL(k_rowrstd, dim3(NSAMP), dim3(64), 0, stream, x, D, D, 0, rstd);
                hipLaunchKernelGGL((k_chk_lin<0, 1>), dim3(12, NSAMP), dim3(256), 0, stream, (const void*)x, D, 0, (const float*)rstd, a.in[I_ANORM], a.in[I_EWIN], NQKV, D, NQKV, (const float*)nullptr, 0, 0, (const void*)BIGp, NQKV, 1.0f, stats, 1); break;
            case 2: hipLaunchKernelGGL(k_chk_local, dim3(512 * 16 / 64), dim3(64), 0, stream, (const bf16*)BIGp, a.in[I_T5], a.in[I_RPB], (const bf16*)OBp, stats, 2); break;
            case 3: hipLaunchKernelGGL((k_chk_lin<1, 0>), dim3(4, NSAMP), dim3(256), 0, stream, (const void*)OBp, D, 0, (const float*)nullptr, (const float*)nullptr, a.in[I_EWOUT], D, D, D, x, D, 0, (const void*)outp, D, 1.0f, stats, 3);
                hipLaunchKernelGGL((k_chk_lin<1, 1>), dim3(4, NSAMP), dim3(256), 0, stream, (const void*)OBp, D, 0, (const float*)nullptr, (const float*)nullptr, a.in[I_EWOUT], D, D, D, x, D, 0, (const void*)XBp, D, 1.0f, stats, 16); break;
            case 4: hipLaunchKernelGGL(k_rowrstd, dim3(NSAMP), dim3(64), 0, stream, (const float*)outp, D, D, 0, rstd);
                hipLaunchKernelGGL(k_chk_swiglu, dim3(11, NSAMP), dim3(256), 0, stream, (const float*)outp, (const float*)rstd, a.in[I_FNORM], a.in[I_WG], a.in[I_WU], (const bf16*)BIGp, stats, 4); break;
            case 5: hipLaunchKernelGGL((k_chk_lin<1, 0>), dim3(4, NSAMP), dim3(256), 0, stream, (const void*)BIGp, FF, 0, (const float*)nullptr, (const float*)nullptr, a.in[I_WD], D, FF, D, (const float*)save, D, 1, (const void*)outp, D, 1.0f, stats, 5); break;
            case 6: hipLaunchKernelGGL(k_rowrstd, dim3(NSAMP), dim3(64), 0, stream, (const float*)outp, D, D, 0, rstd);
                hipLaunchKernelGGL((k_chk_lin<0, 1>), dim3(2, NSAMP), dim3(256), 0, stream, (const void*)outp, D, 0, (const float*)rstd, a.in[I_ANORM] + D, a.in[I_OWIN], NIN1, D, 512, (const float*)nullptr, 0, 0, (const void*)OBp, NIN1P, 1.0f, stats, 6);
                hipLaunchKernelGGL(k_chk_krope, dim3(NSAMP), dim3(64), 0, stream, (const float*)outp, (const float*)rstd, a.in[I_ANORM] + D, a.in[I_OWIN], (const bf16*)K1p, stats, 7); break;
            case 7: hipLaunchKernelGGL(k_rowrstd_bf, dim3(NSAMP), dim3(64), 0, stream, (const bf16*)OBp, NIN1P, QL, rstd);
                hipLaunchKernelGGL(k_rowrstd_bf, dim3(NSAMP), dim3(64), 0, stream, (const bf16*)OBp + QL, NIN1P, KVL, rstd2);
                hipLaunchKernelGGL(k_chk_q, dim3(6, NSAMP), dim3(256), 0, stream, (const bf16*)OBp, (const float*)rstd, a.in[I_QNORM], a.in[I_WUQ], (const bf16*)Q1p, stats, 8);
                hipLaunchKernelGGL(k_chk_kv, dim3(4, NSAMP), dim3(256), 0, stream, (const bf16*)OBp, (const float*)rstd2, a.in[I_KVNORM], a.in[I_WUK], (const bf16*)K1p, 1, stats, 9);
                hipLaunchKernelGGL(k_chk_kv, dim3(4, NSAMP), dim3(256), 0, stream, (const bf16*)OBp, (const float*)rstd2, a.in[I_KVNORM], a.in[I_WUV], (const bf16*)V1p, 0, stats, 10); break;
            case 8: hipLaunchKernelGGL(k_chk_mla, dim3(64 * 16), dim3(256), 0, stream, (const bf16*)Q1p, (const bf16*)K1p, (const bf16*)V1p, a.in[I_T5], (const bf16*)OBp, stats, 11); break;
            case 9: hipLaunchKernelGGL((k_chk_lin<1, 0>), dim3(4, NSAMP), dim3(256), 0, stream, (const void*)OBp, D, 0, (const float*)nullptr, (const float*)nullptr, a.in[I_OWOUT], D, D, D, (const float*)save, D, 1, (const void*)outp, D, 1.0f, stats, 12); break;
            case 10: hipLaunchKernelGGL(k_rowrstd, dim3(NSAMP), dim3(64), 0, stream, (const float*)outp, D, D, 0, rstd);
                hipLaunchKernelGGL(k_chk_swiglu, dim3(11, NSAMP), dim3(256), 0, stream, (const float*)outp, (const float*)rstd, a.in[I_FNORM] + D, a.in[I_WG] + (size_t)D * FF, a.in[I_WU] + (size_t)D * FF, (const bf16*)BIGp, stats, 13); break;
            case 11: hipLaunchKernelGGL((k_chk_lin<1, 0>), dim3(4, NSAMP), dim3(256), 0, stream, (const void*)BIGp, FF, 0, (const float*)nullptr, (const float*)nullptr, a.in[I_WD] + (size_t)FF * D, D, FF, D, (const float*)save, D, 1, (const void*)outp, D, 1.0f, stats, 14); break;
            case 12: hipLaunchKernelGGL(k_rowrstd, dim3(NSAMP), dim3(64), 0, stream, (const float*)save, D, D, 1, rstd);
                hipLaunchKernelGGL(k_chk_final, dim3(NSAMP), dim3(256), 0, stream, (const float*)save, (const float*)rstd, a.in[I_FINAL], (const float*)outp, stats, 15); break;
            default: break;
            }
        }
        hipLaunchKernelGGL(k_finalize, dim3(1), dim3(64), 0, stream, (const float*)stats, outp, DBG_TOL, DBG_MAGSLOT);
    }
#else
    a.ph_lo = 0; a.ph_hi = NPH;
    hipLaunchKernelGGL(fwd_kernel, dim3(grid), dim3(NWAVES * 64), LDS_BYTES, stream, a);
#endif
}
```

```cpp
#include <hip/hip_runtime.h>
#include <cstdio>
#include <cstdint>

#ifndef DBG_CHECK
#define DBG_CHECK 0
#endif
#ifndef DBG_CHECK_NOFUSE
#define FUSE_FINAL_NORM 1
#endif
#ifndef DBG_TOL
#define DBG_TOL 0.03f
#endif
#ifndef DBG_MAGSLOT
#define DBG_MAGSLOT 0
#endif

#define LAS __attribute__((address_space(3)))
#define GAS __attribute__((address_space(1)))
typedef unsigned short bf16;
typedef short bf16x8 __attribute__((ext_vector_type(8)));
typedef short s16x4 __attribute__((ext_vector_type(4)));
typedef float f32x4 __attribute__((ext_vector_type(4)));
typedef float f32x16 __attribute__((ext_vector_type(16)));
typedef unsigned u32x4 __attribute__((ext_vector_type(4)));
typedef unsigned u32x2 __attribute__((ext_vector_type(2)));
typedef float f32x2_t __attribute__((ext_vector_type(2)));
typedef __bf16 bf16x2_t __attribute__((ext_vector_type(2)));

constexpr int S = 16384, D = 1024, FF = 2816, NQKV = 3072;
constexpr int NIN1 = 544, NIN1P = 768, QL = 384, KVL = 128, KVLP = 256, NQ1 = 1536, NKV1 = 2048, KPITCH = 1536  ;
constexpr float RMS_EPS = 1e-6f, LOG2E = 1.4426950408889634f;
constexpr float C2_LOCAL = 0.125f * LOG2E;
constexpr float C2_MLA = 0.10206207261596577f * LOG2E;
constexpr float NEGB = -1e30f;

constexpr size_t MiB = 1u << 20;
constexpr size_t WS_CTL = 0, CTL_ZERO_BYTES = 1 * MiB;
constexpr size_t CTL_BAR = 16384;
constexpr size_t CTL_PANEL = 96 * 1024;
constexpr size_t CTL_SPLIT = 112 * 1024;
constexpr size_t CTL_SS = 128 * 1024;
constexpr size_t CTL_STATS = 600 * 1024;
constexpr size_t CTL_RSTD = 640 * 1024;
constexpr size_t WS_ROPE = 1 * MiB;
constexpr size_t WS_TDIL = 3 * MiB;
constexpr size_t WS_TMLA = 3 * MiB + 128 * 1024;
constexpr size_t WS_TRPB = 3 * MiB + 256 * 1024;
constexpr size_t WS_W = 8 * MiB;
constexpr size_t W_IN0 = WS_W, W_OUT0 = W_IN0 + 6 * MiB, W_GU0 = W_OUT0 + 2 * MiB, W_D0 = W_GU0 + 11 * MiB, W_IN1 = W_D0 + 6 * MiB,
                 W_UQ = W_IN1 + 2 * MiB, W_UKV = W_UQ + 2 * MiB, W_OUT1 = W_UKV + 1 * MiB, W_GU1 = W_OUT1 + 2 * MiB, W_D1 = W_GU1 + 11 * MiB, W_END = W_D1 + 6 * MiB;
constexpr size_t WS_XB = 57 * MiB;
constexpr size_t WS_O = 89 * MiB;
constexpr size_t WS_BIG = 121 * MiB;
constexpr size_t WS_Q1 = WS_BIG, WS_K1 = WS_BIG + 48 * MiB, WS_V1 = 217 * MiB;
constexpr size_t WS_SAVE = 252 * MiB, WS_END = 256 * MiB;
static_assert(W_END <= WS_XB && WS_V1 + 32 * MiB <= WS_SAVE, "d_ws map");

constexpr int LDS_BYTES = 147456;
constexpr int MISC_OFF = 131072 + 320;
constexpr int LDSCTL_OFF = 131072;

__device__ __forceinline__ float bf2f(unsigned short b) { return __builtin_bit_cast(float, (unsigned)b << 16); }
__device__ __forceinline__ unsigned cvtpk(float lo, float hi) { f32x2_t v = {lo, hi}; bf16x2_t b = __builtin_convertvector(v, bf16x2_t); return __builtin_bit_cast(unsigned, b); }
__device__ __forceinline__ float wave_sum(float v) {
#pragma unroll
    for (int o = 1; o < 64; o <<= 1) v += __shfl_xor(v, o);
    return v;
}

namespace pg8 {
constexpr int BM = 256, BK = 64, HALF = 128, HTB = HALF * BK * 2, STAGE_BYTES = 8 * HTB, NXCD = 8, WGM = 8;
__host__ __device__ __forceinline__ int lds_byte(int r, int c) { const int st = (r >> 4) * 2 + (c >> 5), rr = r & 15, cc = c & 31, ob = rr * 64 + cc * 2; return st * 1024 + (ob ^ (((ob >> 9) & 1) << 5)); }
__host__ __device__ __forceinline__ void stage_rc(int b, int& R, int& C) { const int st = b / 1024, sb = b % 1024, swz = sb ^ (((sb >> 9) & 1) << 5); R = (st >> 1) * 16 + swz / 64; C = (st & 1) * 32 + (swz % 64) / 2; }
__host__ __device__ __forceinline__ int perm32(int rho) { const int n = rho >> 4, i = rho & 15; return 8 * (i >> 2) + 4 * n + (i & 3); }

struct Unit { int pm, pn; };
struct Gemm { const bf16* A; const bf16* Bt; int M, N, K, lda; int ldb = 0; };

struct StaticOrder {
    int nM, nN, nwg, G, c, lo, hi;
    __device__ void init(int M, int N, int G_, int c_) { nM = M / BM; nN = N / BM; nwg = nM * nN; G = G_; c = c_; lo = 0; hi = nwg; }
    __device__ bool next(int i, Unit& u) const {
        const long L = (long)lo + (long)i * G + c; if (L >= hi) return false;
        int wgid = (int)L; { const int q = nwg / NXCD, r = nwg % NXCD, xcd = wgid % NXCD, off = wgid / NXCD; wgid = (xcd < r ? xcd * (q + 1) : r * (q + 1) + (xcd - r) * q) + off; }
        const int nig = WGM * nN, gid = wgid / nig, fm = gid * WGM, gsz = (nM - fm) < WGM ? (nM - fm) : WGM;
        u.pm = fm + ((wgid % nig) % gsz); u.pn = (wgid % nig) / gsz; return true;
    }
};

typedef f32x4 Acc[2][2][4][2];

struct EpiRowScale {
    bf16* O; int ldc; const float* ss; float invk; int qscale;
    __device__ __forceinline__ void operator()(const Acc& acc, const Unit& u, int wr, int wc, int fr, int fq) const {
        const int row0 = u.pm * BM + wr * 64 + fr, col0 = u.pn * BM + wc * 32 + 8 * fq;
#pragma unroll
        for (int ai = 0; ai < 2; ++ai)
#pragma unroll
            for (int m = 0; m < 4; ++m) { const int row = row0 + ai * HALF + m * 16; const float rs = __builtin_amdgcn_rsqf(ss[row] * invk + RMS_EPS) * ((qscale && (u.pn < 2 || (u.pn & ~1) == 6)) ? C2_LOCAL : 1.0f);
                bf16* rowp = O + (size_t)row * ldc + col0;
#pragma unroll
                for (int bj = 0; bj < 2; ++bj) { const f32x4 v0 = acc[ai][bj][m][0] * rs, v1 = acc[ai][bj][m][1] * rs;
                    u32x4 w; w.x = cvtpk(v0[0], v0[1]); w.y = cvtpk(v0[2], v0[3]); w.z = cvtpk(v1[0], v1[1]); w.w = cvtpk(v1[2], v1[3]);
                    *(u32x4*)(rowp + bj * HALF) = w; } }
    }
};
struct EpiResid {
    const float* R; const bf16* R16; float* X; bf16* XB; float* ssout;
    __device__ __forceinline__ void operator()(const Acc& acc, const Unit& u, int wr, int wc, int fr, int fq) const {
        const int row0 = u.pm * BM + wr * 64 + fr, col0 = u.pn * BM + wc * 32 + 8 * fq;
#pragma unroll
        for (int ai = 0; ai < 2; ++ai)
#pragma unroll
            for (int m = 0; m < 4; ++m) { const int row = row0 + ai * HALF + m * 16; const size_t off = (size_t)row * D + col0; float sq = 0.f;
#pragma unroll
                for (int bj = 0; bj < 2; ++bj) { f32x4 r0, r1;
                    if (R) { r0 = *(const f32x4*)(R + off + bj * HALF); r1 = *(const f32x4*)(R + off + bj * HALF + 4); }
                    else { const u32x4 rb = *(const u32x4*)(R16 + off + bj * HALF);
                        r0 = (f32x4){__builtin_bit_cast(float, rb.x << 16), __builtin_bit_cast(float, rb.x & 0xffff0000u), __builtin_bit_cast(float, rb.y << 16), __builtin_bit_cast(float, rb.y & 0xffff0000u)};
                        r1 = (f32x4){__builtin_bit_cast(float, rb.z << 16), __builtin_bit_cast(float, rb.z & 0xffff0000u), __builtin_bit_cast(float, rb.w << 16), __builtin_bit_cast(float, rb.w & 0xffff0000u)}; }
                    const f32x4 v0 = acc[ai][bj][m][0] + r0, v1 = acc[ai][bj][m][1] + r1;
                    if (X) { *(f32x4*)(X + off + bj * HALF) = v0; *(f32x4*)(X + off + bj * HALF + 4) = v1; }
                    u32x4 w; w.x = cvtpk(v0[0], v0[1]); w.y = cvtpk(v0[2], v0[3]); w.z = cvtpk(v1[0], v1[1]); w.w = cvtpk(v1[2], v1[3]);
                    *(u32x4*)(XB + off + bj * HALF) = w;
                    sq += (v0[0] * v0[0] + v0[1] * v0[1]) + (v0[2] * v0[2] + v0[3] * v0[3]) + (v1[0] * v1[0] + v1[1] * v1[1]) + (v1[2] * v1[2] + v1[3] * v1[3]); }
                sq += __shfl_xor(sq, 16); sq += __shfl_xor(sq, 32);
                if (fq == 0) atomicAdd(ssout + row, sq); }
    }
};
struct EpiFinal {
    const float* R; const bf16* R16; float* OUT; float* ss; unsigned* cnt; const float* gf;
    __device__ __forceinline__ void operator()(const Acc& acc, const Unit& u, int wr, int wc, int fr, int fq) const {
        const int row0 = u.pm * BM + wr * 64 + fr, col0 = u.pn * BM + wc * 32 + 8 * fq;
        f32x4 xv[2][2][4][2];
#pragma unroll
        for (int ai = 0; ai < 2; ++ai)
#pragma unroll
            for (int m = 0; m < 4; ++m) { const int row = row0 + ai * HALF + m * 16; const size_t off = (size_t)row * D + col0; float sq = 0.f;
#pragma unroll
                for (int bj = 0; bj < 2; ++bj) { f32x4 r0, r1;
                    if (R) { r0 = *(const f32x4*)(R + off + bj * HALF); r1 = *(const f32x4*)(R + off + bj * HALF + 4); }
                    else { const u32x4 rb = *(const u32x4*)(R16 + off + bj * HALF);
                        r0 = (f32x4){__builtin_bit_cast(float, rb.x << 16), __builtin_bit_cast(float, rb.x & 0xffff0000u), __builtin_bit_cast(float, rb.y << 16), __builtin_bit_cast(float, rb.y & 0xffff0000u)};
                        r1 = (f32x4){__builtin_bit_cast(float, rb.z << 16), __builtin_bit_cast(float, rb.z & 0xffff0000u), __builtin_bit_cast(float, rb.w << 16), __builtin_bit_cast(float, rb.w & 0xffff0000u)}; }
                    const f32x4 v0 = acc[ai][bj][m][0] + r0, v1 = acc[ai][bj][m][1] + r1; xv[ai][bj][m][0] = v0; xv[ai][bj][m][1] = v1;
                    sq += (v0[0] * v0[0] + v0[1] * v0[1]) + (v0[2] * v0[2] + v0[3] * v0[3]) + (v1[0] * v1[0] + v1[1] * v1[1]) + (v1[2] * v1[2] + v1[3] * v1[3]); }
                sq += __shfl_xor(sq, 16); sq += __shfl_xor(sq, 32);
                if (fq == 0) atomicAdd(ss + row, sq); }
        asm volatile("s_waitcnt vmcnt(0)" ::: "memory");
        __syncthreads();
        unsigned* c = cnt + 64 * u.pm;
        if (threadIdx.x == 0) {
            __builtin_amdgcn_fence(__ATOMIC_RELEASE, "agent");
            asm volatile("s_waitcnt vmcnt(0)" ::: "memory");
            __hip_atomic_fetch_add(c, 1u, __ATOMIC_RELAXED, __HIP_MEMORY_SCOPE_AGENT);
            unsigned sp = 0;
            while (__hip_atomic_load(c, __ATOMIC_RELAXED, __HIP_MEMORY_SCOPE_AGENT) < 4u) { __builtin_amdgcn_s_sleep(2); if (++sp > (1u << 22)) break; }
            __builtin_amdgcn_fence(__ATOMIC_ACQUIRE, "agent");
            asm volatile("s_waitcnt vmcnt(0)" ::: "memory");
        }
        __syncthreads();
        f32x4 g0[2], g1[2];
#pragma unroll
        for (int bj = 0; bj < 2; ++bj) { g0[bj] = *(const f32x4*)(gf + col0 + bj * HALF); g1[bj] = *(const f32x4*)(gf + col0 + bj * HALF + 4); }
#pragma unroll
        for (int ai = 0; ai < 2; ++ai)
#pragma unroll
            for (int m = 0; m < 4; ++m) { const int row = row0 + ai * HALF + m * 16; const size_t off = (size_t)row * D + col0;
                const float tot = __hip_atomic_load(ss + row, __ATOMIC_RELAXED, __HIP_MEMORY_SCOPE_AGENT);
                const float rs = 1.0f / sqrtf(tot * (1.0f / D) + RMS_EPS);
#pragma unroll
                for (int bj = 0; bj < 2; ++bj) { *(f32x4*)(OUT + off + bj * HALF) = xv[ai][bj][m][0] * rs * g0[bj]; *(f32x4*)(OUT + off + bj * HALF + 4) = xv[ai][bj][m][1] * rs * g1[bj]; } }
    }
};
__device__ __forceinline__ char* uni_ptr(const void* p) { const unsigned long long b = (unsigned long long)p; const unsigned lo = __builtin_amdgcn_readfirstlane((unsigned)b), hi = __builtin_amdgcn_readfirstlane((unsigned)(b >> 32)); return (char*)(((unsigned long long)hi << 32) | lo); }
struct EpiPartStore {
    float* part; unsigned* flag;
    __device__ __forceinline__ void operator()(const Acc& acc, const Unit&, int, int, int, int) const {
        char* pb = uni_ptr(part); const unsigned lo = threadIdx.x * 16u;
        asm volatile("s_nop 15\n\ts_nop 15" ::: "memory");
#pragma unroll
        for (int ai = 0; ai < 2; ++ai)
#pragma unroll
            for (int bj = 0; bj < 2; ++bj)
#pragma unroll
                for (int m = 0; m < 4; ++m)
#pragma unroll
                    for (int n = 0; n < 2; ++n) asm volatile("global_store_dwordx4 %0, %1, %2 sc0 sc1" :: "v"(lo), "v"(acc[ai][bj][m][n]), "s"(uni_ptr(pb + (((ai * 2 + bj) * 4 + m) * 2 + n) * 8192)) : "memory");
        asm volatile("s_waitcnt vmcnt(0)" ::: "memory");
        __syncthreads();
        if (threadIdx.x == 0) __hip_atomic_store(flag, 1u, __ATOMIC_RELAXED, __HIP_MEMORY_SCOPE_AGENT);
    }
};
template <class Base>
struct EpiJoin {
    Base base; const float* part; unsigned* flag;
    __device__ __forceinline__ void operator()(const Acc& acc_, const Unit& u, int wr, int wc, int fr, int fq) const {
        if (threadIdx.x == 0) { unsigned sp = 0; while (__hip_atomic_load(flag, __ATOMIC_RELAXED, __HIP_MEMORY_SCOPE_AGENT) == 0u) { __builtin_amdgcn_s_sleep(2); if (++sp > (1u << 22)) break; } }
        __syncthreads();
        Acc& acc = const_cast<Acc&>(acc_);
        const char* pb = uni_ptr(part); const unsigned lo = threadIdx.x * 16u;
#pragma unroll
        for (int ai = 0; ai < 2; ++ai)
#pragma unroll
            for (int bj = 0; bj < 2; ++bj) {
                const char* gb = uni_ptr(pb + (ai * 2 + bj) * 65536);
                f32x4 t0, t1, t2, t3, t4, t5, t6, t7;
                asm volatile("global_load_dwordx4 %0, %8, %9 sc0 sc1\n\tglobal_load_dwordx4 %1, %8, %10 sc0 sc1\n\tglobal_load_dwordx4 %2, %8, %11 sc0 sc1\n\tglobal_load_dwordx4 %3, %8, %12 sc0 sc1\n\t"
                             "global_load_dwordx4 %4, %8, %13 sc0 sc1\n\tglobal_load_dwordx4 %5, %8, %14 sc0 sc1\n\tglobal_load_dwordx4 %6, %8, %15 sc0 sc1\n\tglobal_load_dwordx4 %7, %8, %16 sc0 sc1\n\ts_waitcnt vmcnt(0)"
                             : "=&v"(t0), "=&v"(t1), "=&v"(t2), "=&v"(t3), "=&v"(t4), "=&v"(t5), "=&v"(t6), "=&v"(t7)
                             : "v"(lo), "s"(gb), "s"(gb + 8192), "s"(gb + 16384), "s"(gb + 24576), "s"(gb + 32768), "s"(gb + 40960), "s"(gb + 49152), "s"(gb + 57344) : "memory");
                acc[ai][bj][0][0] += t0; acc[ai][bj][0][1] += t1; acc[ai][bj][1][0] += t2; acc[ai][bj][1][1] += t3; acc[ai][bj][2][0] += t4; acc[ai][bj][2][1] += t5; acc[ai][bj][3][0] += t6; acc[ai][bj][3][1] += t7; }
        base(acc, u, wr, wc, fr, fq);
    }
};
template <class Base>
struct EpiSplit {
    Base base; float* part; unsigned* flag; bool helper;
    __device__ __forceinline__ void operator()(const Acc& acc, const Unit& u, int wr, int wc, int fr, int fq) const {
        if (helper) EpiPartStore{part, flag}(acc, u, wr, wc, fr, fq); else EpiJoin<Base>{base, part, flag}(acc, u, wr, wc, fr, fq);
    }
};
struct EpiSwiGLU {
    bf16* O; const float* ss;
    __device__ __forceinline__ void operator()(const Acc& acc, const Unit& u, int wr, int wc, int fr, int fq) const {
        const int row0 = u.pm * BM + wr * 64 + fr, col0 = u.pn * HALF + wc * 32 + 8 * fq;
#pragma unroll
        for (int ai = 0; ai < 2; ++ai)
#pragma unroll
            for (int m = 0; m < 4; ++m) { const int row = row0 + ai * HALF + m * 16; const float rs = __builtin_amdgcn_rsqf(ss[row] * (1.0f / D) + RMS_EPS);
                float a[8];
#pragma unroll
                for (int n = 0; n < 2; ++n)
#pragma unroll
                    for (int e = 0; e < 4; ++e) { const float g = acc[ai][0][m][n][e] * rs, up = acc[ai][1][m][n][e] * rs;
                        a[4 * n + e] = g * __builtin_amdgcn_rcpf(1.0f + __builtin_amdgcn_exp2f(-LOG2E * g)) * up; }
                u32x4 w; w.x = cvtpk(a[0], a[1]); w.y = cvtpk(a[2], a[3]); w.z = cvtpk(a[4], a[5]); w.w = cvtpk(a[6], a[7]);
                *(u32x4*)(O + (size_t)row * FF + col0) = w; }
    }
};
__device__ __forceinline__ void rope8(float (&v)[8], const float* cs_row  , int fq) {
    const int f0 = 8 * (fq & 1);
#pragma unroll
    for (int e = 0; e < 8; ++e) { const float other = __shfl_xor(v[e], 32); const float c = cs_row[2 * (f0 + e)], s = cs_row[2 * (f0 + e) + 1];
        v[e] = (fq < 2) ? (v[e] * c - other * s) : (other * s + v[e] * c); }
}
struct EpiMlaIn {
    bf16* P; const float* ss; float* ssq; float* sskv; bf16* KF; const float* cs;
    __device__ __forceinline__ void operator()(const Acc& acc, const Unit& u, int wr, int wc, int fr, int fq) const {
        const int row0 = u.pm * BM + wr * 64 + fr, col0 = u.pn * BM + wc * 32 + 8 * fq;
#pragma unroll
        for (int ai = 0; ai < 2; ++ai)
#pragma unroll
            for (int m = 0; m < 4; ++m) { const int row = row0 + ai * HALF + m * 16; const float rs = __builtin_amdgcn_rsqf(ss[row] * (1.0f / D) + RMS_EPS);
                bf16* rowp = P + (size_t)row * NIN1P + col0;
                if (u.pn < 2) {
                    float sq[2];
#pragma unroll
                    for (int bj = 0; bj < 2; ++bj) { const f32x4 v0 = acc[ai][bj][m][0] * rs, v1 = acc[ai][bj][m][1] * rs;
                        u32x4 w; w.x = cvtpk(v0[0], v0[1]); w.y = cvtpk(v0[2], v0[3]); w.z = cvtpk(v1[0], v1[1]); w.w = cvtpk(v1[2], v1[3]);
                        *(u32x4*)(rowp + bj * HALF) = w;
                        sq[bj] = (v0[0] * v0[0] + v0[1] * v0[1]) + (v0[2] * v0[2] + v0[3] * v0[3]) + (v1[0] * v1[0] + v1[1] * v1[1]) + (v1[2] * v1[2] + v1[3] * v1[3]); }
                    float sa = (u.pn == 0) ? sq[0] + sq[1] : sq[0], sb = (u.pn == 0) ? 0.f : sq[1];
                    sa += __shfl_xor(sa, 16); sa += __shfl_xor(sa, 32); sb += __shfl_xor(sb, 16); sb += __shfl_xor(sb, 32);
                    if (fq == 0) { atomicAdd(ssq + row, sa); if (u.pn == 1) atomicAdd(sskv + row, sb); }
                } else {
                    const u32x4 z = {0u, 0u, 0u, 0u};
                    *(u32x4*)(rowp) = z; *(u32x4*)(rowp + HALF) = z;
                    if (wc == 0) {
                        float v[8];
#pragma unroll
                        for (int n = 0; n < 2; ++n)
#pragma unroll
                            for (int e = 0; e < 4; ++e) v[4 * n + e] = acc[ai][0][m][n][e] * rs;
                        rope8(v, cs + (size_t)row * 32, fq);
                        u32x4 w; w.x = cvtpk(v[0], v[1]); w.y = cvtpk(v[2], v[3]); w.z = cvtpk(v[4], v[5]); w.w = cvtpk(v[6], v[7]);
                        bf16* kp = KF + (size_t)row * KPITCH + 64 + 8 * fq;
#pragma unroll
                        for (int h = 0; h < 16; ++h) *(u32x4*)(kp + h * 96) = w;
                    }
                } }
    }
};
struct EpiMlaQ {
    bf16* Q; const float* ssq; const float* cs;
    __device__ __forceinline__ void operator()(const Acc& acc, const Unit& u, int wr, int wc, int fr, int fq) const {
        const int row0 = u.pm * BM + wr * 64 + fr;
#pragma unroll
        for (int ai = 0; ai < 2; ++ai)
#pragma unroll
            for (int m = 0; m < 4; ++m) { const int row = row0 + ai * HALF + m * 16; const float rs = __builtin_amdgcn_rsqf(ssq[row] * (1.0f / QL) + RMS_EPS);
#pragma unroll
                for (int bj = 0; bj < 2; ++bj) { const int g0 = u.pn * BM + bj * HALF + wc * 32;
                    float v[8];
#pragma unroll
                    for (int n = 0; n < 2; ++n)
#pragma unroll
                        for (int e = 0; e < 4; ++e) v[4 * n + e] = acc[ai][bj][m][n][e] * rs;
                    if ((g0 % 96) == 64) rope8(v, cs + (size_t)row * 32, fq);
                    u32x4 w; w.x = cvtpk(v[0] * C2_MLA, v[1] * C2_MLA); w.y = cvtpk(v[2] * C2_MLA, v[3] * C2_MLA); w.z = cvtpk(v[4] * C2_MLA, v[5] * C2_MLA); w.w = cvtpk(v[6] * C2_MLA, v[7] * C2_MLA);
                    *(u32x4*)(Q + (size_t)row * NQ1 + g0 + 8 * fq) = w; } }
    }
};
struct EpiMlaKV {
    bf16* KF; bf16* V; const float* sskv;
    __device__ __forceinline__ void operator()(const Acc& acc, const Unit& u, int wr, int wc, int fr, int fq) const {
        const int row0 = u.pm * BM + wr * 64 + fr;
#pragma unroll
        for (int ai = 0; ai < 2; ++ai)
#pragma unroll
            for (int m = 0; m < 4; ++m) { const int row = row0 + ai * HALF + m * 16; const float rs = __builtin_amdgcn_rsqf(sskv[row] * (1.0f / KVL) + RMS_EPS);
#pragma unroll
                for (int bj = 0; bj < 2; ++bj) { const int col = u.pn * BM + bj * HALF + wc * 32 + 8 * fq;
                    const f32x4 v0 = acc[ai][bj][m][0] * rs, v1 = acc[ai][bj][m][1] * rs;
                    u32x4 w; w.x = cvtpk(v0[0], v0[1]); w.y = cvtpk(v0[2], v0[3]); w.z = cvtpk(v1[0], v1[1]); w.w = cvtpk(v1[2], v1[3]);
                    bf16* dst = (col < 1024) ? KF + (size_t)row * KPITCH + (col >> 6) * 96 + (col & 63) : V + (size_t)row * D + (col - 1024);
                    *(u32x4*)dst = w; } }
    }
};

template <class Epi, bool ALIGN_EPI>
__device__ __forceinline__ void gemm_phase(LAS unsigned char* lds, const Gemm g, const StaticOrder& S, const Epi& E) {
    const int tid = threadIdx.x, wid = __builtin_amdgcn_readfirstlane(tid >> 6), lane = tid & 63, wr = wid >> 2, wc = wid & 3, fr = lane & 15, fq = lane >> 4;
    const int K = g.K, nt = K / BK, lda = g.lda, ldb = g.ldb ? g.ldb : g.K;
    unsigned voffA[2], voffB[2];
#pragma unroll
    for (int i = 0; i < 2; ++i) { int R, C; stage_rc(tid * 16 + i * 8192, R, C); const int Rb = (R & ~31) + perm32(R & 31);
        voffA[i] = (unsigned)(R * lda + C) * 2u; voffB[i] = (unsigned)(Rb * ldb + C) * 2u; }
    const size_t kstep = (size_t)(BK * 2);
    const size_t hsA = (size_t)HALF * lda * 2, hsB = (size_t)HALF * ldb * 2, tsA = 2 * hsA, tsB = 2 * hsB;
    const unsigned ldsw = (unsigned)wid * 1024u;
    const int aoff = lds_byte(wr * 64 + fr, fq * 8), boff = lds_byte(wc * 32 + fr, fq * 8);
#define PG8_SA(b, h) (((b) * 2 + (h)) * HTB)
#define PG8_SB(b, h) ((4 + (b) * 2 + (h)) * HTB)
#define PG8_STAGE(bufoff, gbase, voff) do { _Pragma("unroll") for (int _i = 0; _i < 2; ++_i) \
        __builtin_amdgcn_global_load_lds((const unsigned*)((const char*)(gbase) + (voff)[_i]), (LAS unsigned*)(lds + (bufoff) + ldsw + _i * 8192), 16, 0, 0); } while (0)
#define PG8_LDA(dst, b, h) do { _Pragma("unroll") for (int m = 0; m < 4; ++m) _Pragma("unroll") for (int k = 0; k < 2; ++k) dst[m][k] = *(const LAS bf16x8*)(lds + PG8_SA(b, h) + aoff + m * 2048 + k * 1024); } while (0)
#define PG8_LDB(dst, b, h) do { _Pragma("unroll") for (int n = 0; n < 2; ++n) _Pragma("unroll") for (int k = 0; k < 2; ++k) dst[n][k] = *(const LAS bf16x8*)(lds + PG8_SB(b, h) + boff + n * 2048 + k * 1024); } while (0)
#define PG8_MMA(ai, bj, At, Bt) do { __builtin_amdgcn_s_setprio(1); _Pragma("unroll") for (int m = 0; m < 4; ++m) _Pragma("unroll") for (int n = 0; n < 2; ++n) _Pragma("unroll") for (int k = 0; k < 2; ++k) \
        acc[ai][bj][m][n] = __builtin_amdgcn_mfma_f32_16x16x32_bf16(Bt[n][k], At[m][k], acc[ai][bj][m][n], 0, 0, 0); __builtin_amdgcn_s_setprio(0); } while (0)
#define PG8_WAIT_V(n) asm volatile("s_waitcnt vmcnt(" #n ")" ::: "memory")
#define PG8_WAIT_L(n) asm volatile("s_waitcnt lgkmcnt(" #n ")" ::: "memory")
#define PG8_BAR __builtin_amdgcn_s_barrier()
#define PG8_SCHED __builtin_amdgcn_sched_barrier(0)
    Unit cur, nxt; int ui = 0;
    if (!S.next(0, cur)) return;
    Acc acc;
#pragma unroll
    for (int a = 0; a < 2; ++a)
#pragma unroll
        for (int b = 0; b < 2; ++b)
#pragma unroll
            for (int m = 0; m < 4; ++m)
#pragma unroll
                for (int n = 0; n < 2; ++n) acc[a][b][m][n] = (f32x4){0.f, 0.f, 0.f, 0.f};
    bf16x8 At[4][2], B0[2][2], B1[2][2];
    const char* cA = (const char*)g.A + (size_t)cur.pm * tsA; const char* cB = (const char*)g.Bt + (size_t)cur.pn * tsB;
    PG8_STAGE(PG8_SB(0, 0), cB, voffB); PG8_STAGE(PG8_SB(0, 1), cB + hsB, voffB); PG8_STAGE(PG8_SA(0, 0), cA, voffA); PG8_STAGE(PG8_SA(0, 1), cA + hsA, voffA);
    if (wr == 1) PG8_BAR;
    PG8_WAIT_V(2); PG8_BAR;
    PG8_STAGE(PG8_SB(1, 0), cB + kstep, voffB); PG8_STAGE(PG8_SA(1, 0), cA + kstep, voffA); PG8_STAGE(PG8_SB(1, 1), cB + hsB + kstep, voffB);
    PG8_WAIT_V(6); PG8_BAR;
    for (;;) {
        const bool has_next = S.next(ui + 1, nxt);
        const char* nA = has_next ? (const char*)g.A + (size_t)nxt.pm * tsA : cA; const char* nB = has_next ? (const char*)g.Bt + (size_t)nxt.pn * tsB : cB;
#pragma unroll 1
        for (int t = 0; t < nt; t += 2) {
            const bool last = (t == nt - 2);
            const char* a1 = cA + (size_t)(t + 1) * kstep;
            const char* a2 = last ? nA : cA + (size_t)(t + 2) * kstep; const char* b2 = last ? nB : cB + (size_t)(t + 2) * kstep;
            const char* a3 = a2 + kstep; const char* b3 = b2 + kstep;
            PG8_LDB(B0, 0, 0); PG8_LDB(B1, 0, 1); PG8_SCHED; PG8_LDA(At, 0, 0); PG8_STAGE(PG8_SA(1, 1), a1 + hsA, voffA);
            PG8_WAIT_V(8); PG8_WAIT_L(0); PG8_BAR; PG8_MMA(0, 0, At, B0); PG8_MMA(0, 1, At, B1); PG8_BAR; PG8_SCHED;
            PG8_LDA(At, 0, 1); PG8_STAGE(PG8_SB(0, 0), b2, voffB); PG8_STAGE(PG8_SB(0, 1), b2 + hsB, voffB); PG8_STAGE(PG8_SA(0, 0), a2, voffA);
            PG8_WAIT_V(8); PG8_WAIT_L(0); PG8_BAR; PG8_MMA(1, 0, At, B0); PG8_MMA(1, 1, At, B1); PG8_BAR; PG8_SCHED;
            PG8_LDB(B0, 1, 0); PG8_LDB(B1, 1, 1); PG8_SCHED; PG8_LDA(At, 1, 0); PG8_STAGE(PG8_SA(0, 1), a2 + hsA, voffA);
            PG8_WAIT_V(8); PG8_WAIT_L(0); PG8_BAR; PG8_MMA(0, 0, At, B0); PG8_MMA(0, 1, At, B1); PG8_BAR; PG8_SCHED;
            PG8_LDA(At, 1, 1); PG8_STAGE(PG8_SB(1, 0), b3, voffB); PG8_STAGE(PG8_SB(1, 1), b3 + hsB, voffB); PG8_STAGE(PG8_SA(1, 0), a3, voffA);
            PG8_WAIT_V(8); PG8_WAIT_L(0); PG8_BAR; PG8_MMA(1, 0, At, B0); PG8_MMA(1, 1, At, B1); PG8_BAR; PG8_SCHED;
        }
        if constexpr (ALIGN_EPI) { if (wr == 0) PG8_BAR; }
        E(acc, cur, wr, wc, fr, fq);
        if (!has_next) break;
#pragma unroll
        for (int a = 0; a < 2; ++a)
#pragma unroll
            for (int b = 0; b < 2; ++b)
#pragma unroll
                for (int m = 0; m < 4; ++m)
#pragma unroll
                    for (int n = 0; n < 2; ++n) acc[a][b][m][n] = (f32x4){0.f, 0.f, 0.f, 0.f};
        cur = nxt; cA = nA; cB = nB; ++ui;
        if constexpr (ALIGN_EPI) { if (wr == 1) PG8_BAR; }
    }
    PG8_WAIT_V(0);
    if constexpr (!ALIGN_EPI) { if (wr == 0) PG8_BAR; }
    PG8_BAR;
#undef PG8_SA
#undef PG8_SB
#undef PG8_STAGE
#undef PG8_LDA
#undef PG8_LDB
#undef PG8_MMA
#undef PG8_WAIT_V
#undef PG8_WAIT_L
#undef PG8_BAR
#undef PG8_SCHED
}
}

typedef GAS unsigned gu32;
#define RLX_AGENT __ATOMIC_RELAXED, __HIP_MEMORY_SCOPE_AGENT
#define LDS_WAIT() asm volatile("s_waitcnt lgkmcnt(0)" ::: "memory")
#define VM_WAIT() asm volatile("s_waitcnt vmcnt(0)" ::: "memory")
#define XB_TMO      128
#define XB_XCNT(j)  (256  + 64 * (j))
#define XB_XSUB(j)  (1280 + 64 * (j))
#define XB_XGEN(j)  (2304 + 64 * (j))
#define XB_TOP      3328
#define XB_TOPGEN   3392
#define XCD_BAR_WORDS 3456
#define XB_SPIN_CAP (1u << 18)
__device__ __forceinline__ unsigned xb_ld(unsigned* p)              { return __hip_atomic_load(p, __ATOMIC_RELAXED, __HIP_MEMORY_SCOPE_AGENT); }
__device__ __forceinline__ unsigned xb_add(unsigned* p, unsigned v) { return __hip_atomic_fetch_add(p, v, __ATOMIC_RELAXED, __HIP_MEMORY_SCOPE_AGENT); }
__device__ __forceinline__ unsigned xb_xcc_id() { return (unsigned)__builtin_amdgcn_s_getreg((3 << 11) | 20) & 0xFu; }
#define XB_SPIN(cond, bar) do { unsigned _sp = 0; while (cond) { __builtin_amdgcn_s_sleep(1); \
    if ((++_sp & 255u) == 0u) { if (xb_ld(&(bar)[XB_TMO])) break; if (_sp > XB_SPIN_CAP) { atomicAdd(&(bar)[XB_TMO], 1u); break; } } } } while (0)
struct XcdBarrier { unsigned* bar; unsigned x; volatile LAS unsigned* st; };
__device__ __forceinline__ XcdBarrier xcd_barrier_post(unsigned* bar, volatile LAS unsigned* st) {
    XcdBarrier b; b.bar = bar; b.x = xb_xcc_id(); b.st = st;
    if (threadIdx.x == 0) (void)xb_add(&bar[XB_XCNT(b.x)], 1u);
    return b;
}
__device__ __forceinline__ void xcd_barrier_complete(unsigned* bar, unsigned x, unsigned& nloc, unsigned& nx) {
    const unsigned G = gridDim.x * gridDim.y * gridDim.z;
    unsigned sum, cnt, mine, sp = 0u;
    for (;;) {
        sum = 0u; cnt = 0u; mine = 0u;
#pragma unroll
        for (unsigned j = 0; j < 16; ++j) { const unsigned c = xb_ld(&bar[XB_XCNT(j)]); sum += c; cnt += (c > 0u) ? 1u : 0u; mine = (j == x) ? c : mine; }
        if (sum == G) break;
        __builtin_amdgcn_s_sleep(1);
        if ((++sp & 255u) == 0u) { if (xb_ld(&bar[XB_TMO])) break; if (sp > XB_SPIN_CAP) { atomicAdd(&bar[XB_TMO], 1u); break; } }
    }
    nloc = mine > 0u ? mine : 1u; nx = cnt > 0u ? cnt : 1u;
}
__device__ __forceinline__ void xcd_barrier(const XcdBarrier& b) {
    asm volatile("s_waitcnt vmcnt(0)" ::: "memory");
    __syncthreads();
    if (threadIdx.x == 0) {
        unsigned* bar = b.bar;
        __builtin_amdgcn_s_waitcnt(0);
        unsigned nloc = b.st[0], nx = b.st[1];
        if (nloc == 0u) { xcd_barrier_complete(bar, b.x, nloc, nx); b.st[0] = nloc; b.st[1] = nx; }
        const unsigned old = xb_add(&bar[XB_XSUB(b.x)], 1u);
        const unsigned gen = old / nloc;
        if (old + 1u == (gen + 1u) * nloc) {
            __builtin_amdgcn_fence(__ATOMIC_RELEASE, "agent");
            asm volatile("s_waitcnt vmcnt(0)" ::: "memory");
            const unsigned og = xb_add(&bar[XB_TOP], 1u);
            const unsigned tg = og / nx;
            if (og + 1u == (tg + 1u) * nx) xb_add(&bar[XB_TOPGEN], 1u);
            else XB_SPIN(xb_ld(&bar[XB_TOPGEN]) == tg, bar);
            __builtin_amdgcn_fence(__ATOMIC_ACQUIRE, "agent");
            xb_add(&bar[XB_XGEN(b.x)], 1u);
            asm volatile("s_waitcnt vmcnt(0)" ::: "memory");
        } else {
            XB_SPIN(xb_ld(&bar[XB_XGEN(b.x)]) == gen, bar);
            __builtin_amdgcn_fence(__ATOMIC_ACQUIRE, "agent");
            asm volatile("s_waitcnt vmcnt(0)" ::: "memory");
        }
    }
    __syncthreads();
}

__device__ __forceinline__ int t5_bucket(int rel) {
    const int n = rel < 0 ? -rel : rel;
    const float nf = (float)(n > 8 ? n : 8);
    int large = 8 + (int)(__logf(nf / 8.0f) / 4.852030263919617f * 8.0f);
    large = large < 15 ? large : 15;
    return (rel > 0 ? 16 : 0) + (n < 8 ? n : large);
}
__device__ __forceinline__ int t5_bucket_precise(int rel) {
    const int n = rel < 0 ? -rel : rel;
    const float nf = (float)(n > 8 ? n : 8);
    int large = 8 + (int)(logf(nf / 8.0f) / 4.852030263919617f * 8.0f);
    large = large < 15 ? large : 15;
    return (rel > 0 ? 16 : 0) + (n < 8 ? n : large);
}

struct Args {
    const float* in[18];
    float* out; unsigned char* ws;
    int ph_lo, ph_hi;
};
enum { I_X = 0, I_T5, I_ANORM, I_FNORM, I_EWIN, I_RPB, I_EWOUT, I_OWIN, I_QNORM, I_WUQ, I_KVNORM, I_WUK, I_WUV, I_OWOUT, I_WG, I_WU, I_WD, I_FINAL };
constexpr int NPH = 13;

__device__ __forceinline__ void p0_transpose_item(const float* W, int N, const float* gain, bf16* WT, int ldk, int dst_row0, int k0, int n0, LAS float* scr, int lane) {
    float v[32], gk[32];
#pragma unroll
    for (int i = 0; i < 32; ++i) { const int kk = 2 * i + (lane >> 5); v[i] = __builtin_nontemporal_load(W + (size_t)(k0 + kk) * N + n0 + (lane & 31)); gk[i] = gain ? gain[k0 + kk] : 1.0f; }
#pragma unroll
    for (int i = 0; i < 32; ++i) { const int kk = 2 * i + (lane >> 5); scr[kk * 33 + (lane & 31)] = v[i] * gk[i]; }
    LDS_WAIT(); asm volatile("" ::: "memory");
    const int c = lane & 7;
#pragma unroll
    for (int j = 0; j < 4; ++j) { const int n = (lane >> 3) + 8 * j; const LAS float* s = scr + (8 * c) * 33 + n;
        u32x4 o; o.x = cvtpk(s[0 * 33], s[1 * 33]); o.y = cvtpk(s[2 * 33], s[3 * 33]); o.z = cvtpk(s[4 * 33], s[5 * 33]); o.w = cvtpk(s[6 * 33], s[7 * 33]);
        *(u32x4*)(WT + (size_t)(dst_row0 + n) * ldk + k0 + 8 * c) = o; }
    LDS_WAIT(); asm volatile("" ::: "memory");
}
template <int MODE>
__device__ __forceinline__ bool p0_matrix(int& r, const float* W, int K, int N, const float* gain, bf16* WT, int ldk, int row_off, LAS float* scr, int lane) {
    const int nblk = N / 32, items = (K / 64) * nblk;
    if (r >= items) { r -= items; return false; }
    const int kb = r / nblk, nb = r % nblk, n0 = 32 * nb;
    int dr = row_off + n0;
    if (MODE != 0) dr = (n0 >> 7) * 256 + (n0 & 127) + (MODE == 2 ? 128 : 0);
    p0_transpose_item(W, N, gain, WT, ldk, dr, 64 * kb, n0, scr, lane);
    return true;
}

__device__ __forceinline__ const char* mla_sgpr_ptr(const char* p) { const unsigned long long b = (unsigned long long)p; const unsigned lo = __builtin_amdgcn_readfirstlane((unsigned)b), hi = __builtin_amdgcn_readfirstlane((unsigned)(b >> 32)); return (const char*)(((unsigned long long)hi << 32) | lo); }

namespace wattn {
__device__ __forceinline__ int crow(int r, int hi) { return (r & 3) + 8 * (r >> 2) + 4 * hi; }
typedef short v4i16_t __attribute__((ext_vector_type(4)));
__device__ __forceinline__ s16x4 vtr(const LAS unsigned char* p) { return __builtin_bit_cast(s16x4, __builtin_amdgcn_ds_read_tr16_b64_v4i16((LAS v4i16_t*)p)); }
constexpr int WREG = 16384;

template <bool SAFE, class F>
__device__ __forceinline__ bool run_unit(const F& f, const bf16* __restrict__ Qrow  , const char* __restrict__ Kbase  ,
                                         bf16* __restrict__ Orow  , LAS unsigned char* wl, int lane) {
    constexpr int ND = 4, PITCHB = NQKV * 2, TB = 8192;
    const int r32 = lane & 31, hi = lane >> 5;
    bf16x8 qf[ND];
#pragma unroll
    for (int d0 = 0; d0 < ND; ++d0) qf[d0] = *(const bf16x8*)(Qrow + 16 * d0 + 8 * hi);
    float m = NEGB, l = 0.f; f32x16 ot[2];
#pragma unroll
    for (int r = 0; r < 16; ++r) { ot[0][r] = 0.f; ot[1][r] = 0.f; }
    const int nt = f.ntiles();
    const int kg = lane >> 3, sl = lane & 7, kgv = (lane >> 2) & 7;
    const unsigned kce = (unsigned)((sl ^ (kg >> 1)) * 16), kco = kce ^ 64u;
    const unsigned vco = (unsigned)(1024 + (lane >> 5) * 64 + (lane & 3) * 16);
    const char* const Kb = mla_sgpr_ptr(Kbase);
    auto dma_tile = [&](int t, int bo) {
        LAS unsigned char* kd = wl + bo; LAS unsigned char* vd = wl + bo + 4096;
        int tb_, st_;
        if (f.affine(t, tb_, st_)) {
            const char* kt = mla_sgpr_ptr(Kbase + (size_t)tb_ * PITCHB);
            const unsigned rowk = (unsigned)(kg * st_ * PITCHB), rowv = (unsigned)(kgv * st_ * PITCHB) + vco; const unsigned stepb = (unsigned)(8 * st_ * PITCHB);
#pragma unroll
            for (int i = 0; i < 4; ++i) { const char* p = kt + (size_t)(i * stepb);
                __builtin_amdgcn_global_load_lds((const unsigned*)(p + (rowk + ((i & 1) ? kco : kce))), (LAS unsigned*)(kd + i * 1024), 16, 0, 0);
                __builtin_amdgcn_global_load_lds((const unsigned*)(p + rowv), (LAS unsigned*)(vd + i * 1024), 16, 0, 0); }
        } else {
#pragma unroll
            for (int i = 0; i < 4; ++i) { const unsigned offk = (unsigned)f.tok(t, kg + 8 * i) * (unsigned)PITCHB + ((i & 1) ? kco : kce), offv = (unsigned)f.tok(t, kgv + 8 * i) * (unsigned)PITCHB + vco;
                __builtin_amdgcn_global_load_lds((const unsigned*)(Kb + offk), (LAS unsigned*)(kd + i * 1024), 16, 0, 0);
                __builtin_amdgcn_global_load_lds((const unsigned*)(Kb + offv), (LAS unsigned*)(vd + i * 1024), 16, 0, 0); }
        }
    };
    const LAS unsigned char* kp[ND];
#pragma unroll
    for (int d0 = 0; d0 < ND; ++d0) kp[d0] = wl + r32 * 128 + (((2 * d0 + hi) ^ ((r32 >> 1) & 7)) * 16);
    const LAS unsigned char* vbase = wl + 4096 + (4 * hi + ((lane & 15) >> 2)) * 64 + ((lane >> 4) & 1) * 32 + (lane & 3) * 8;
    dma_tile(0, 0);
    if (nt > 1) dma_tile(1, TB);
    auto body = [&](int t, int bo) {
        if (t + 1 < nt) asm volatile("s_waitcnt vmcnt(8)" ::: "memory"); else asm volatile("s_waitcnt vmcnt(0)" ::: "memory");
        const int tc = f.cls(t);
        if (tc != 2) {
        float bb[16];
        f.bias16(t, hi, r32, bb, tc == 1);
        f32x16 s;
#pragma unroll
        for (int r = 0; r < 16; ++r) s[r] = bb[r];
#pragma unroll
        for (int d0 = 0; d0 < ND; ++d0) { const bf16x8 kf = *(const LAS bf16x8*)(kp[d0] + bo); s = __builtin_amdgcn_mfma_f32_32x32x16_bf16(kf, qf[d0], s, 0, 0, 0); }
        float ps = 0.f;
        if (SAFE) {
            float mx = NEGB;
#pragma unroll
            for (int r = 0; r < 16; ++r) mx = fmaxf(mx, s[r]);
            mx = fmaxf(mx, __shfl_xor(mx, 32));
            const float mnew = fmaxf(m, mx), alpha = __builtin_amdgcn_exp2f(m - mnew);
            m = mnew;
#pragma unroll
            for (int r = 0; r < 16; ++r) { s[r] = __builtin_amdgcn_exp2f(s[r] - mnew); ps += s[r]; }
            l = l * alpha + ps;
#pragma unroll
            for (int r = 0; r < 16; ++r) { ot[0][r] *= alpha; ot[1][r] *= alpha; }
        } else {
#pragma unroll
            for (int r = 0; r < 16; ++r) s[r] = __builtin_amdgcn_exp2f(s[r]);
            l += ((s[0] + s[1]) + (s[2] + s[3])) + ((s[4] + s[5]) + (s[6] + s[7])) + (((s[8] + s[9]) + (s[10] + s[11])) + ((s[12] + s[13]) + (s[14] + s[15])));
        }
        u32x4 pw[2];
#pragma unroll
        for (int ks = 0; ks < 2; ++ks) { pw[ks].x = cvtpk(s[8 * ks + 0], s[8 * ks + 1]); pw[ks].y = cvtpk(s[8 * ks + 2], s[8 * ks + 3]); pw[ks].z = cvtpk(s[8 * ks + 4], s[8 * ks + 5]); pw[ks].w = cvtpk(s[8 * ks + 6], s[8 * ks + 7]); }
#pragma unroll
        for (int db = 0; db < 2; ++db)
#pragma unroll
            for (int ks = 0; ks < 2; ++ks) {
                const s16x4 lo = vtr(vbase + bo + ks * 2048 + db * 512), hh = vtr(vbase + bo + ks * 2048 + 1024 + db * 512);
                const bf16x8 vf = (bf16x8){lo[0], lo[1], lo[2], lo[3], hh[0], hh[1], hh[2], hh[3]};
                ot[db] = __builtin_amdgcn_mfma_f32_32x32x16_bf16(vf, __builtin_bit_cast(bf16x8, pw[ks]), ot[db], 0, 0, 0);
            }
        }
        if (t + 2 < nt) {
            __builtin_amdgcn_sched_barrier(0);
            asm volatile("s_waitcnt lgkmcnt(0)" ::: "memory");
            dma_tile(t + 2, bo);
            asm volatile("" ::: "memory");
        }
    };
#pragma unroll 1
    for (int t = 0; t < nt; t += 2) { body(t, 0); if (t + 1 < nt) body(t + 1, TB); }
    l += __shfl_xor(l, 32);
    if (!SAFE && __any(!(l > 1.0e-30f && l < 1.0e37f))) return false;
    const float inv = 1.0f / l;
#pragma unroll
    for (int db = 0; db < 2; ++db)
#pragma unroll
        for (int g = 0; g < 4; ++g) { u32x2 w; w.x = cvtpk(ot[db][4 * g] * inv, ot[db][4 * g + 1] * inv); w.y = cvtpk(ot[db][4 * g + 2] * inv, ot[db][4 * g + 3] * inv);
            *(u32x2*)(Orow + 32 * db + 8 * g + 4 * hi) = w; }
    return true;
}

struct DilF {
    int t0, w; bool edge; const LAS float* tbl;
    __device__ __forceinline__ int ntiles() const { return 23; }
    __device__ __forceinline__ int tok_raw(int t, int j) const {
        if (t < 8) return t0 - 64 + 32 * t + j;
        const int ii = (t - 8) * 32 + j, e = ii < 240 ? ii - 256 : ii - 192;
        return t0 + w + 4 * e;
    }
    __device__ __forceinline__ int tok(int t, int j) const { int u = tok_raw(t, j); u = u < 0 ? 0 : u; return u > S - 1 ? S - 1 : u; }
    __device__ __forceinline__ bool affine(int t, int& base, int& step) const {
        if (t < 8) { base = t0 - 64 + 32 * t; step = 1; }
        else { if (t == 15) return false; base = t0 + w + 4 * ((t - 8) * 32 - (t < 15 ? 256 : 192)); step = 4; }
        return !(edge && (base < 0 || base + 31 * step >= S));
    }
    __device__ __forceinline__ float bias(int t, int r, int hi, int r32) const {
        const int u = tok_raw(t, crow(r, hi)), d = u - (t0 + w + 4 * r32);
        float b = tbl[((d + 1152) & 3) * 592 + ((d + 1152) >> 2)];
        if (edge && (u < 0 || u >= S)) b = NEGB;
        return b;
    }
    __device__ __forceinline__ int cls(int t) const {
        if (!edge) return 0;
        if (t == 15) return 1;
        const int lo = t < 8 ? t0 - 64 + 32 * t : t0 + w + 4 * ((t - 8) * 32 - (t < 15 ? 256 : 192)), hi_ = t < 8 ? lo + 31 : lo + 124;
        return (hi_ < 0 || lo >= S) ? 2 : ((lo >= 0 && hi_ < S) ? 0 : 1);
    }
    __device__ __forceinline__ void bias16(int t, int hi, int r32, float (&b)[16], const bool slow) const {
        if (slow) {
#pragma unroll
            for (int r = 0; r < 16; ++r) b[r] = bias(t, r, hi, r32);
        } else if (t < 8) {
            const LAS float* lb = tbl + (272 - r32 + hi + 8 * t);
#pragma unroll
            for (int j = 0; j < 4; ++j) { const LAS float* tp = lb + (((j - w) & 3) * 592 - (j < w ? 1 : 0));
#pragma unroll
                for (int c = 0; c < 4; ++c) b[4 * c + j] = tp[2 * c]; }
        } else {
            const LAS float* tp = tbl + (288 - r32 + 4 * hi + 32 * (t - 8) - (t > 15 ? 192 : 256));
            if (t == 15) {
#pragma unroll
                for (int r = 0; r < 16; ++r) b[r] = tp[(r & 3) + 8 * (r >> 2) + (r >= 8 ? 64 : 0)];
            } else {
#pragma unroll
                for (int r = 0; r < 16; ++r) b[r] = tp[(r & 3) + 8 * (r >> 2)];
            }
        }
    }
};
struct NaF {
    int r0, gr, jw; const LAS float* rpb;
    __device__ __forceinline__ int ntiles() const { return 16; }
    __device__ __forceinline__ int tok(int t, int j) const { return (r0 + (t >> 1)) * 64 + 32 * (t & 1) + j; }
    __device__ __forceinline__ bool affine(int t, int& base, int& step) const { base = (r0 + (t >> 1)) * 64 + 32 * (t & 1); step = 1; return true; }
    __device__ __forceinline__ int cls(int) const { return 0; }
    __device__ __forceinline__ void bias16(int t, int hi, int r32, float (&b)[16], const bool = false) const {
        const int c = 32 * jw + r32; int c0 = c - 8; c0 = c0 < 0 ? 0 : (c0 > 48 ? 48 : c0);
        const int kc0 = 32 * (t & 1) + 4 * hi;
        const LAS float* tp = rpb + ((r0 + (t >> 1) - gr + 7) * 31 + kc0 - c + 15);
        const int rel = kc0 - c0;
#pragma unroll
        for (int r = 0; r < 16; ++r) { const int o = (r & 3) + 8 * (r >> 2); b[r] = ((unsigned)(rel + o) < 16u) ? tp[o] : NEGB; }
    }
};
constexpr int NA_NS = 4, NA_SLOT = 16384, NA_FLAG = NA_NS * NA_SLOT;
template <bool SAFE>
__device__ __forceinline__ bool na_coop(int gr0, const bf16* __restrict__ Qb  , const char* __restrict__ Kbase  , bf16* __restrict__ Ob,
                                        const LAS float* rpb, LAS unsigned char* lds, int wave, int lane) {
    constexpr int ND = 4, PITCHB = NQKV * 2;
    const int r32 = lane & 31, hi = lane >> 5, g = wave >> 1, jw = wave & 1, gr = gr0 + g;
    int r0 = gr - 4; r0 = r0 < 0 ? 0 : (r0 > 248 ? 248 : r0);
    int rmin = gr0 - 4; rmin = rmin < 0 ? 0 : (rmin > 248 ? 248 : rmin);
    int rl = gr0 - 1; rl = rl < 0 ? 0 : (rl > 248 ? 248 : rl);
    const int NR = rl + 8 - rmin;
    const NaF f{r0, gr, jw, rpb};
    const int tq = gr * 64 + 32 * jw + r32;
    const bf16* Qrow = Qb + (size_t)tq * NQKV; bf16* Orow = Ob + (size_t)tq * D;
    bf16x8 qf[ND];
#pragma unroll
    for (int d0 = 0; d0 < ND; ++d0) qf[d0] = *(const bf16x8*)(Qrow + 16 * d0 + 8 * hi);
    float m = NEGB, l = 0.f; f32x16 ot[2];
#pragma unroll
    for (int r = 0; r < 16; ++r) { ot[0][r] = 0.f; ot[1][r] = 0.f; }
    const int kg = lane >> 3, sl = lane & 7, kgv = (lane >> 2) & 7, ph = wave >> 2, pi = wave & 3;
    const unsigned offk = (unsigned)((32 * ph + 8 * pi + kg) * PITCHB) + (unsigned)((((sl ^ (kg >> 1)) * 16) ^ ((pi & 1) ? 64 : 0)));
    const unsigned offv = (unsigned)((32 * ph + 8 * pi + kgv) * PITCHB) + (unsigned)(1024 + (lane >> 5) * 64 + (lane & 3) * 16);
    auto stage = [&](int k) {
        const char* rb = mla_sgpr_ptr(Kbase + (size_t)(rmin + k) * (64 * PITCHB));
        LAS unsigned char* sb = lds + (k & (NA_NS - 1)) * NA_SLOT + ph * 8192 + pi * 1024;
        __builtin_amdgcn_global_load_lds((const unsigned*)(rb + offk), (LAS unsigned*)sb, 16, 0, 0);
        __builtin_amdgcn_global_load_lds((const unsigned*)(rb + offv), (LAS unsigned*)(sb + 4096), 16, 0, 0);
    };
    __syncthreads();
    stage(0); stage(1); stage(2);
    unsigned kp[ND];
#pragma unroll
    for (int d0 = 0; d0 < ND; ++d0) kp[d0] = (unsigned)(r32 * 128 + (((2 * d0 + hi) ^ ((r32 >> 1) & 7)) * 16));
    const unsigned vb = (unsigned)(4096 + (4 * hi + ((lane & 15) >> 2)) * 64 + ((lane >> 4) & 1) * 32 + (lane & 3) * 8);
    auto tile = [&](int t, LAS unsigned char* tb) {
        float bb[16];
        f.bias16(t, hi, r32, bb);
        f32x16 s;
#pragma unroll
        for (int r = 0; r < 16; ++r) s[r] = bb[r];
#pragma unroll
        for (int d0 = 0; d0 < ND; ++d0) { const bf16x8 kf = *(const LAS bf16x8*)(tb + kp[d0]); s = __builtin_amdgcn_mfma_f32_32x32x16_bf16(kf, qf[d0], s, 0, 0, 0); }
        float ps = 0.f;
        if (SAFE) {
            float mx = NEGB;
#pragma unroll
            for (int r = 0; r < 16; ++r) mx = fmaxf(mx, s[r]);
            mx = fmaxf(mx, __shfl_xor(mx, 32));
            const float mnew = fmaxf(m, mx), alpha = __builtin_amdgcn_exp2f(m - mnew);
            m = mnew;
#pragma unroll
            for (int r = 0; r < 16; ++r) { s[r] = __builtin_amdgcn_exp2f(s[r] - mnew); ps += s[r]; }
            l = l * alpha + ps;
#pragma unroll
            for (int r = 0; r < 16; ++r) { ot[0][r] *= alpha; ot[1][r] *= alpha; }
        } else {
#pragma unroll
            for (int r = 0; r < 16; ++r) s[r] = __builtin_amdgcn_exp2f(s[r]);
            l += ((s[0] + s[1]) + (s[2] + s[3])) + ((s[4] + s[5]) + (s[6] + s[7])) + (((s[8] + s[9]) + (s[10] + s[11])) + ((s[12] + s[13]) + (s[14] + s[15])));
        }
        u32x4 pw[2];
#pragma unroll
        for (int ks = 0; ks < 2; ++ks) { pw[ks].x = cvtpk(s[8 * ks + 0], s[8 * ks + 1]); pw[ks].y = cvtpk(s[8 * ks + 2], s[8 * ks + 3]); pw[ks].z = cvtpk(s[8 * ks + 4], s[8 * ks + 5]); pw[ks].w = cvtpk(s[8 * ks + 6], s[8 * ks + 7]); }
#pragma unroll
        for (int db = 0; db < 2; ++db)
#pragma unroll
            for (int ks = 0; ks < 2; ++ks) {
                const s16x4 lo = vtr(tb + vb + ks * 2048 + db * 512), hh = vtr(tb + vb + ks * 2048 + 1024 + db * 512);
                const bf16x8 vf = (bf16x8){lo[0], lo[1], lo[2], lo[3], hh[0], hh[1], hh[2], hh[3]};
                ot[db] = __builtin_amdgcn_mfma_f32_32x32x16_bf16(vf, __builtin_bit_cast(bf16x8, pw[ks]), ot[db], 0, 0, 0);
            }
    };
#pragma unroll 1
    for (int k = 0; k < NR; ++k) {
        const int newer = (k + 2 < NR ? k + 2 : NR - 1) - k;
        if (newer == 2) asm volatile("s_waitcnt vmcnt(4) lgkmcnt(0)" ::: "memory"); else if (newer == 1) asm volatile("s_waitcnt vmcnt(2) lgkmcnt(0)" ::: "memory"); else asm volatile("s_waitcnt vmcnt(0) lgkmcnt(0)" ::: "memory");
        __builtin_amdgcn_s_barrier();
        asm volatile("" ::: "memory");
        if (k + 3 < NR) stage(k + 3);
        const int tr = rmin + k - r0;
        if (tr >= 0 && tr < 8) {
            LAS unsigned char* sb = lds + (k & (NA_NS - 1)) * NA_SLOT;
            tile(2 * tr, sb); tile(2 * tr + 1, sb + 8192);
        }
    }
    l += __shfl_xor(l, 32);
    bool ok = true;
    if (!SAFE) {
        LAS unsigned* fl = (LAS unsigned*)(lds + NA_FLAG);
        const bool bad = __any(!(l > 1.0e-30f && l < 1.0e37f));
        if (lane == 0) fl[wave] = bad ? 1u : 0u;
        __syncthreads();
        unsigned any = 0;
#pragma unroll
        for (int w = 0; w < 8; ++w) any |= fl[w];
        ok = (__builtin_amdgcn_readfirstlane(any) == 0u);
        if (!ok) return false;
    }
    const float inv = 1.0f / l;
#pragma unroll
    for (int db = 0; db < 2; ++db)
#pragma unroll
        for (int gq = 0; gq < 4; ++gq) { u32x2 w; w.x = cvtpk(ot[db][4 * gq] * inv, ot[db][4 * gq + 1] * inv); w.y = cvtpk(ot[db][4 * gq + 2] * inv, ot[db][4 * gq + 3] * inv);
            *(u32x2*)(Orow + 32 * db + 8 * gq + 4 * hi) = w; }
    return true;
}
struct MlaF {
    int tq0; const LAS float* tbl;
    __device__ __forceinline__ int ntiles() const { return S / 32; }
    __device__ __forceinline__ int tok(int t, int j) const { return 32 * t + j; }
    __device__ __forceinline__ float bias(int t, int r, int hi, int r32) const {
        int d = 32 * t + crow(r, hi) - (tq0 + r32); d = d < -600 ? -600 : (d > 600 ? 600 : d);
        return tbl[d + 600];
    }
};
}


namespace mla {
using wattn::crow; using wattn::vtr;
constexpr int NSLOT = 4, KSLOT = 12288, VSLOT = 8192, L_K = 0, L_V = NSLOT * KSLOT, L_TBL = L_V + NSLOT * VSLOT, L_FLAG = L_TBL + 7936, L_OST = L_TBL + 8192, L_END = L_OST + 8 * 4096;
constexpr int NT = S / 64;
constexpr float THR = 8.0f;
#define MLA_WAITBAR() do { asm volatile("s_waitcnt vmcnt(0) lgkmcnt(0)" ::: "memory"); __builtin_amdgcn_s_barrier(); asm volatile("" ::: "memory"); } while (0)
#define MLA_WAITBAR_N(n) do { asm volatile("s_waitcnt vmcnt(" #n ") lgkmcnt(0)" ::: "memory"); __builtin_amdgcn_s_barrier(); asm volatile("" ::: "memory"); } while (0)
#define MLA_BAR() do { asm volatile("s_waitcnt lgkmcnt(0)" ::: "memory"); __builtin_amdgcn_s_barrier(); asm volatile("" ::: "memory"); } while (0)
#define MLA_SB() __builtin_amdgcn_sched_barrier(0)
__device__ __forceinline__ float max3f(float a, float b, float c) { float r; asm("v_max3_f32 %0, %1, %2, %3" : "=v"(r) : "v"(a), "v"(b), "v"(c)); return r; }
__device__ __forceinline__ const char* sgpr_ptr(const char* p) { const unsigned long long b = (unsigned long long)p; const unsigned lo = __builtin_amdgcn_readfirstlane((unsigned)b), hi = __builtin_amdgcn_readfirstlane((unsigned)(b >> 32)); return (const char*)(((unsigned long long)hi << 32) | lo); }

struct St {
    bf16x8 qf[6]; f32x16 ot[2]; f32x16 accl; f32x16 negm; u32x4 pw[4]; float m, l, cbn; int qrow;
    const LAS unsigned char* kfb; const LAS unsigned char* vfb; const LAS float* tbl;
    int tl_end, tr_beg; float clo, chi;
};
__device__ __forceinline__ float tile_cb(const St& st, int t) { return t < st.tl_end ? st.clo : (t >= st.tr_beg ? st.chi : 0.f); }

template <bool SAFE, bool ONES>
__device__ __forceinline__ void h1(St& st, f32x16& s0, f32x16& s1, int t, int lane) {
    const int hi = lane >> 5;
    if (SAFE) asm volatile("s_nop 15\n\ts_nop 7" : "+v"(s0), "+v"(s1));
    if (t >= st.tl_end && t < st.tr_beg) {
        const LAS float* tp = st.tbl + (64 * t + 4 * hi - st.qrow + 960);
#pragma unroll
        for (int g = 0; g < 4; ++g) {
#pragma unroll
            for (int e = 0; e < 4; ++e) { s0[4 * g + e] += tp[8 * g + e]; s1[4 * g + e] += tp[32 + 8 * g + e]; }
            asm volatile("" ::: "memory");
        }
    }
    bool resc = false;
    if (SAFE) {
        float a = max3f(s0[0], s0[1], s1[0]), b = max3f(s0[2], s0[3], s1[1]); a = max3f(a, s1[2], s1[3]);
#pragma unroll
        for (int r = 4; r < 16; r += 4) { a = max3f(a, s0[r], s0[r + 1]); b = max3f(b, s0[r + 2], s0[r + 3]); a = max3f(a, s1[r], s1[r + 1]); b = max3f(b, s1[r + 2], s1[r + 3]); }
        float mx = fmaxf(a, b);
        { auto rr = __builtin_amdgcn_permlane32_swap(__float_as_uint(mx), __float_as_uint(mx), false, false); mx = fmaxf(__uint_as_float(rr[0]), __uint_as_float(rr[1])); }
        if (__any(mx > THR)) { const float dl = fmaxf(mx, 0.f), alpha = __builtin_amdgcn_exp2f(-dl); st.m += dl; st.l *= alpha; resc = true;
#pragma unroll
            for (int r = 0; r < 16; ++r) { s0[r] -= dl; s1[r] -= dl; st.ot[0][r] *= alpha; st.ot[1][r] *= alpha; if (ONES) st.accl[r] *= alpha; } }
    }
    { const float cbn = tile_cb(st, t + 1); if (resc || cbn != st.cbn) { st.cbn = cbn; const float v = cbn - st.m;
#pragma unroll
        for (int r = 0; r < 16; ++r) st.negm[r] = v;
        asm volatile("" : "+v"(st.negm)); } }
#pragma unroll
    for (int r = 0; r < 16; ++r) { s0[r] = __builtin_amdgcn_exp2f(s0[r]); s1[r] = __builtin_amdgcn_exp2f(s1[r]); }
    if (!ONES) {
#define H1_SUM8(out, v, o) do { float t1_, t2_, t3_; asm("s_nop 1\n\tv_add_f32 %0, %4, %5\n\tv_add_f32 %1, %6, %7\n\tv_add_f32 %2, %8, %9\n\tv_add_f32 %3, %10, %11\n\tv_add_f32 %0, %0, %1\n\tv_add_f32 %2, %2, %3\n\tv_add_f32 %0, %0, %2" \
          : "=&v"(out), "=&v"(t1_), "=&v"(t2_), "=&v"(t3_) : "v"(v[o + 0]), "v"(v[o + 1]), "v"(v[o + 2]), "v"(v[o + 3]), "v"(v[o + 4]), "v"(v[o + 5]), "v"(v[o + 6]), "v"(v[o + 7])); } while (0)
      float ua, ub, uc, ud;
      H1_SUM8(ua, s0, 0); H1_SUM8(ub, s0, 8); H1_SUM8(uc, s1, 0); H1_SUM8(ud, s1, 8);
#undef H1_SUM8
      asm("v_add_f32 %0, %0, %1\n\tv_add_f32 %2, %2, %3\n\tv_add_f32 %0, %0, %2" : "+v"(ua), "+v"(uc) : "v"(ub), "v"(ud));
      st.l += ua; }
#pragma unroll
    for (int ks = 0; ks < 2; ++ks) { st.pw[ks].x = cvtpk(s0[8 * ks + 0], s0[8 * ks + 1]); st.pw[ks].y = cvtpk(s0[8 * ks + 2], s0[8 * ks + 3]); st.pw[ks].z = cvtpk(s0[8 * ks + 4], s0[8 * ks + 5]); st.pw[ks].w = cvtpk(s0[8 * ks + 6], s0[8 * ks + 7]);
        st.pw[2 + ks].x = cvtpk(s1[8 * ks + 0], s1[8 * ks + 1]); st.pw[2 + ks].y = cvtpk(s1[8 * ks + 2], s1[8 * ks + 3]); st.pw[2 + ks].z = cvtpk(s1[8 * ks + 4], s1[8 * ks + 5]); st.pw[2 + ks].w = cvtpk(s1[8 * ks + 6], s1[8 * ks + 7]); }
    asm volatile("" : "+v"(st.pw[0]), "+v"(st.pw[1]), "+v"(st.pw[2]), "+v"(st.pw[3]));
}
template <bool ONES>
__device__ __forceinline__ void h2(St& st, f32x16& s0, f32x16& s1, const unsigned kaddr, const unsigned vaddr) {
    const bf16x8 ones = (bf16x8){16256, 16256, 16256, 16256, 16256, 16256, 16256, 16256};
    s16x4 vlo[5], vhi[5]; bf16x8 kfr[5];
#define H2_RDV(i) asm volatile("ds_read_b64_tr_b16 %0, %2 offset:%3\n\tds_read_b64_tr_b16 %1, %2 offset:%4" : "=&v"(vlo[(i) % 5]), "=&v"(vhi[(i) % 5]) : "v"(vaddr), "i"(((i) & 1) * 4096 + ((i) >> 1) * 1024), "i"(((i) & 1) * 4096 + ((i) >> 1) * 1024 + 512))
#define H2_RDK(i) asm volatile("ds_read_b128 %0, %1 offset:%2" : "=v"(kfr[(i) % 5]) : "v"(kaddr), "i"((((i) - 8) >> 1) * 2048 + (((i) - 8) & 1) * 512))
#define H2_WV(i, n) do { asm volatile("s_waitcnt %0" :: "i"(0xC07F | ((n) << 8)) : "memory"); MLA_SB(); } while (0)
#define H2_WK(i, n) do { asm volatile("s_waitcnt %0" :: "i"(0xC07F | ((n) << 8)) : "memory"); MLA_SB(); } while (0)
#define H2_MV(g) do { const bf16x8 vf = (bf16x8){vlo[(g) % 5][0], vlo[(g) % 5][1], vlo[(g) % 5][2], vlo[(g) % 5][3], vhi[(g) % 5][0], vhi[(g) % 5][1], vhi[(g) % 5][2], vhi[(g) % 5][3]}; \
        st.ot[(g) & 1] = __builtin_amdgcn_mfma_f32_32x32x16_bf16(vf, __builtin_bit_cast(bf16x8, st.pw[(g) >> 1]), st.ot[(g) & 1], 0, 0, 0); \
        } while (0)
#define H2_MK(g) do { if ((((g) - 8) & 1) == 0) s0 = __builtin_amdgcn_mfma_f32_32x32x16_bf16(kfr[(g) % 5], st.qf[((g) - 8) >> 1], (g) < 10 ? st.negm : s0, 0, 0, 0); \
        else s1 = __builtin_amdgcn_mfma_f32_32x32x16_bf16(kfr[(g) % 5], st.qf[((g) - 8) >> 1], (g) < 10 ? st.negm : s1, 0, 0, 0); } while (0)
    __builtin_amdgcn_s_setprio(1);
    H2_RDV(0); H2_RDV(1); H2_RDV(2); H2_RDV(3); H2_RDV(4);
    if (ONES) {
#pragma unroll
        for (int k4 = 0; k4 < 4; ++k4) st.accl = __builtin_amdgcn_mfma_f32_32x32x16_bf16(ones, __builtin_bit_cast(bf16x8, st.pw[k4]), st.accl, 0, 0, 0);
        MLA_SB(); }
    H2_WV(0, 8); H2_MV(0); MLA_SB(); H2_RDV(5);
    H2_WV(1, 8); H2_MV(1); MLA_SB(); H2_RDV(6);
    H2_WV(2, 8); H2_MV(2); MLA_SB(); H2_RDV(7);
    H2_WV(3, 8); H2_MV(3); MLA_SB(); H2_RDK(8);
    H2_WV(4, 7); H2_MV(4); MLA_SB(); H2_RDK(9);
    H2_WV(5, 6); H2_MV(5); MLA_SB(); H2_RDK(10);
    H2_WV(6, 5); H2_MV(6); MLA_SB(); H2_RDK(11);
    H2_WV(7, 4); H2_MV(7); MLA_SB(); H2_RDK(12);
    H2_WK(8, 4); H2_MK(8); MLA_SB(); H2_RDK(13);
    H2_WK(9, 4); H2_MK(9); MLA_SB(); H2_RDK(14);
    H2_WK(10, 4); H2_MK(10); MLA_SB(); H2_RDK(15);
    H2_WK(11, 4); H2_MK(11); MLA_SB(); H2_RDK(16);
    H2_WK(12, 4); H2_MK(12); MLA_SB(); H2_RDK(17);
    H2_WK(13, 4); H2_MK(13); MLA_SB(); H2_RDK(18);
    H2_WK(14, 4); H2_MK(14); MLA_SB(); H2_RDK(19);
    H2_WK(15, 4); H2_MK(15); MLA_SB();
    H2_WK(16, 3); H2_MK(16); MLA_SB();
    H2_WK(17, 2); H2_MK(17); MLA_SB();
    H2_WK(18, 1); H2_MK(18); MLA_SB();
    H2_WK(19, 0); H2_MK(19); MLA_SB();
    __builtin_amdgcn_s_setprio(0);
#undef H2_RDV
#undef H2_RDK
#undef H2_WV
#undef H2_WK
#undef H2_MV
#undef H2_MK
}

template <bool SAFE>
__device__ __forceinline__ bool unit(int h, int q0, const bf16* __restrict__ Q1, const bf16* __restrict__ K1, const bf16* __restrict__ V1, bf16* __restrict__ O,
                                     LAS unsigned char* lds, const float clo, const float chi, int wave, int lane, float* dbg_tp = nullptr) {
    const int r32 = lane & 31, hi = lane >> 5, grp = wave >> 2;
    St st;
    st.tbl = (const LAS float*)(lds + L_TBL); st.clo = clo; st.chi = chi;
    st.qrow = q0 + 32 * wave + r32;
    const unsigned koff0 = (unsigned)(lane * KPITCH + h * 96 + wave * 8) * 2u, koff1 = (unsigned)(lane * KPITCH + h * 96 + (8 + (wave & 3)) * 8) * 2u;
    const unsigned voff = (unsigned)((16 * (wave & 3) + (lane >> 2)) * D + h * 64 + (wave >> 2) * 32 + (lane & 3) * 8) * 2u;
#define MLA_DMA_K(t, slot) do { const char* kt_ = sgpr_ptr((const char*)K1 + (size_t)(t) * (64 * KPITCH * 2)); \
        __builtin_amdgcn_global_load_lds((const unsigned*)(kt_ + koff0), (LAS unsigned*)(lds + L_K + (slot) * KSLOT + wave * 1024), 16, 0, 0); \
        if (wave < 4) __builtin_amdgcn_global_load_lds((const unsigned*)(kt_ + koff1), (LAS unsigned*)(lds + L_K + (slot) * KSLOT + (8 + wave) * 1024), 16, 0, 0); } while (0)
#define MLA_DMA_V(t, slot) __builtin_amdgcn_global_load_lds((const unsigned*)(sgpr_ptr((const char*)V1 + (size_t)(t) * (64 * D * 2)) + voff), (LAS unsigned*)(lds + L_V + (slot) * VSLOT + wave * 1024), 16, 0, 0)
    MLA_DMA_K(0, 0); MLA_DMA_K(1, 1); MLA_DMA_V(0, 0); MLA_DMA_K(2, 2); MLA_DMA_V(1, 1);
    { const bf16* qp = Q1 + (size_t)st.qrow * NQ1 + h * 96 + 8 * hi;
#pragma unroll
      for (int d0 = 0; d0 < 6; ++d0) st.qf[d0] = *(const bf16x8*)(qp + 16 * d0); }
    st.l = 0.f;
#pragma unroll
    for (int r = 0; r < 16; ++r) { st.ot[0][r] = 0.f; st.ot[1][r] = 0.f; st.accl[r] = 0.f; }
    st.kfb = lds + L_K + hi * 1024 + r32 * 16;
    st.vfb = lds + L_V + (4 * hi + ((lane & 15) >> 2)) * 64 + ((lane >> 4) & 1) * 32 + (lane & 3) * 8;
    st.tl_end = (q0 - 622 >= 0) ? (q0 - 622) / 64 + 1 : 0;
    st.tr_beg = (q0 + 814 + 63) / 64;
    f32x16 s0, s1;
    MLA_WAITBAR();
    { const LAS unsigned char* kb = st.kfb;
#pragma unroll
      for (int r = 0; r < 16; ++r) { s0[r] = 0.f; s1[r] = 0.f; }
#pragma unroll
      for (int d0 = 0; d0 < 6; ++d0) { const bf16x8 a0 = *(const LAS bf16x8*)(kb + d0 * 2048), a1 = *(const LAS bf16x8*)(kb + d0 * 2048 + 512);
          s0 = __builtin_amdgcn_mfma_f32_32x32x16_bf16(a0, st.qf[d0], s0, 0, 0, 0); s1 = __builtin_amdgcn_mfma_f32_32x32x16_bf16(a1, st.qf[d0], s1, 0, 0, 0); }
      float mx = s0[0];
#pragma unroll
      for (int r = 0; r < 16; ++r) mx = fmaxf(mx, fmaxf(s0[r], s1[r]));
      mx = fmaxf(mx, __shfl_xor(mx, 32));
      st.m = mx + tile_cb(st, 0);
#pragma unroll
      for (int r = 0; r < 16; ++r) { s0[r] -= mx; s1[r] -= mx; }
      st.cbn = 1e30f; }
    MLA_BAR();
#define MLA_STAGE(t) do { if ((t) + 3 < NT) MLA_DMA_K((t) + 3, ((t) + 3) & 3); if ((t) + 2 < NT) MLA_DMA_V((t) + 2, ((t) + 2) & 3); } while (0)
#ifdef TIMING_SEL
    unsigned long long ta_[6] = {0, 0, 0, 0, 0, 0};
#define TS(x) const unsigned long long x = __builtin_amdgcn_s_memtime()
#define TACC(i, a, b) ta_[i] += (b) - (a)
#else
#define TS(x)
#define TACC(i, a, b)
#endif
#define H2_ADDRS(ks, vs) unsigned ka_ = (unsigned)(uintptr_t)(st.kfb + (ks) * KSLOT), va_ = (unsigned)(uintptr_t)(st.vfb + (vs) * VSLOT); asm volatile("" : "+v"(ka_), "+v"(va_))
    if (grp == 0) {
        MLA_STAGE(0);
        for (int t = 0; t < NT; ++t) {
            TS(t1_);
            h1<SAFE, false>(st, s0, s1, t, lane); TS(t2_);
            H2_ADDRS((t + 1) & 3, t & 3);
            if (t + 3 < NT) MLA_WAITBAR_N(6); else MLA_WAITBAR();
            TS(t3_); h2<false>(st, s0, s1, ka_, va_); TS(t4_);
            MLA_STAGE(t + 1); TS(t0_);
            MLA_BAR(); TS(t5_);
            TACC(2, t4_, t0_); TACC(0, t1_, t2_); TACC(1, t2_, t3_); TACC(3, t3_, t4_); TACC(4, t0_, t5_);
        }
    } else {
        unsigned ka1_ = 0, va1_ = 0;
        for (int t = 0; t < NT; ++t) {
            TS(t0_); TS(t1_);
            if (t > 0) h2<true>(st, s0, s1, ka1_, va1_);
            TS(t2_); if (t + 3 < NT) MLA_WAITBAR_N(2); else MLA_WAITBAR();
            TS(t3_); MLA_STAGE(t);
            h1<SAFE, true>(st, s0, s1, t, lane); TS(t4_);
            { H2_ADDRS((t + 1) & 3, t & 3); ka1_ = ka_; va1_ = va_; }
            MLA_BAR(); TS(t5_);
            TACC(2, t0_, t1_); TACC(3, t1_, t2_); TACC(1, t2_, t3_); TACC(0, t3_, t4_); TACC(4, t4_, t5_);
        }
        h2<true>(st, s0, s1, ka1_, va1_);
    }
#undef MLA_STAGE
#ifdef TIMING_SEL
    if (blockIdx.x == 0 && lane == 0 && (wave == 0 || wave == 4)) { float* tp = dbg_tp + (wave >> 2) * 8;
        for (int i = 0; i < 5; ++i) atomicAdd(tp + i, (float)ta_[i]); }
#endif
    float l = st.l; l += __shfl_xor(l, 32);
    if (grp == 1) l = st.accl[0];
    bool ok = true;
    if (!SAFE) { const bool bad = !(l > 0.f && l < 1.0e37f);
        LAS unsigned* flag = (LAS unsigned*)(lds + L_FLAG);
        const bool anybad = __any(bad);
        if (lane == 0) flag[wave] = anybad ? 1u : 0u;
        MLA_BAR();
        unsigned f = 0;
#pragma unroll
        for (int i = 0; i < 8; ++i) f |= flag[i];
        ok = (f == 0u); }
    const float inv = 1.0f / l;
    LAS bf16* stg = (LAS bf16*)(lds + L_OST) + wave * 2048;
#pragma unroll
    for (int db = 0; db < 2; ++db)
#pragma unroll
        for (int g = 0; g < 4; ++g) { u32x2 w; w.x = cvtpk(st.ot[db][4 * g] * inv, st.ot[db][4 * g + 1] * inv); w.y = cvtpk(st.ot[db][4 * g + 2] * inv, st.ot[db][4 * g + 3] * inv);
            *(LAS u32x2*)(stg + r32 * 64 + 32 * db + 8 * g + 4 * hi) = w; }
    asm volatile("s_waitcnt lgkmcnt(0)" ::: "memory");
    bf16* Ow = O + (size_t)(q0 + 32 * wave) * D + h * 64;
#pragma unroll
    for (int i = 0; i < 4; ++i) { const int row = i * 8 + (lane >> 3), ch = lane & 7; const u32x4 v = *(const LAS u32x4*)(stg + row * 64 + ch * 8); *(u32x4*)(Ow + (size_t)row * D + ch * 8) = v; }
    MLA_WAITBAR();
#undef MLA_DMA_K
#undef MLA_DMA_V
    return ok;
}
}

namespace mla {
struct Sc { f32x4 v[4][2]; };
struct St2 {
    bf16x8 qf[2][3]; f32x4 ot[4][2]; f32x4 accl[2]; f32x4 negm[2]; u32x4 pw[2][2]; float m[2], l[2], cbn; int qrow;
    const LAS unsigned char* kfb; const LAS unsigned char* vfb; const LAS float* tbl;
    int tl_end, tr_beg; float clo, chi;
};
__device__ __forceinline__ float tile_cb2(const St2& st, int t) { return t < st.tl_end ? st.clo : (t >= st.tr_beg ? st.chi : 0.f); }
#define MFMA16(a, b, c) __builtin_amdgcn_mfma_f32_16x16x32_bf16(a, b, c, 0, 0, 0)

template <bool SAFE, bool ONES>
__device__ __forceinline__ void h1x(St2& st, Sc& sc, int t, int lane) {
    const int g = lane >> 4;
    if (SAFE) asm volatile("s_nop 15\n\ts_nop 7" : "+v"(sc.v[0][0]), "+v"(sc.v[0][1]), "+v"(sc.v[1][0]), "+v"(sc.v[1][1]), "+v"(sc.v[2][0]), "+v"(sc.v[2][1]), "+v"(sc.v[3][0]), "+v"(sc.v[3][1]));
    if (t >= st.tl_end && t < st.tr_beg) {
#pragma unroll
        for (int qb = 0; qb < 2; ++qb) { const LAS float* tp = st.tbl + (64 * t + 4 * g - (st.qrow + 16 * qb) + 960);
#pragma unroll
            for (int kb = 0; kb < 4; ++kb) {
#pragma unroll
                for (int r = 0; r < 4; ++r) sc.v[kb][qb][r] += tp[16 * kb + r];
                if (kb & 1) asm volatile("" ::: "memory"); } }
    }
    bool resc = false;
    if (SAFE) {
        float mx[2];
#pragma unroll
        for (int qb = 0; qb < 2; ++qb) {
            float a = max3f(sc.v[0][qb][0], sc.v[0][qb][1], sc.v[0][qb][2]), b = max3f(sc.v[0][qb][3], sc.v[1][qb][0], sc.v[1][qb][1]);
            a = max3f(a, sc.v[1][qb][2], sc.v[1][qb][3]); b = max3f(b, sc.v[2][qb][0], sc.v[2][qb][1]); a = max3f(a, sc.v[2][qb][2], sc.v[2][qb][3]);
            b = max3f(b, sc.v[3][qb][0], sc.v[3][qb][1]); a = max3f(a, sc.v[3][qb][2], sc.v[3][qb][3]);
            float v = fmaxf(a, b); v = fmaxf(v, __shfl_xor(v, 16)); v = fmaxf(v, __shfl_xor(v, 32)); mx[qb] = v; }
        if (__any(mx[0] > THR || mx[1] > THR)) { resc = true;
#pragma unroll
            for (int qb = 0; qb < 2; ++qb) { const float dl = fmaxf(mx[qb], 0.f), alpha = __builtin_amdgcn_exp2f(-dl); st.m[qb] += dl; st.l[qb] *= alpha;
#pragma unroll
                for (int kb = 0; kb < 4; ++kb) { sc.v[kb][qb] -= dl; st.ot[kb][qb] *= alpha; }
                if (ONES) st.accl[qb] *= alpha; } }
    }
    { const float cbn = tile_cb2(st, t + 1); if (resc || cbn != st.cbn) { st.cbn = cbn;
#pragma unroll
        for (int qb = 0; qb < 2; ++qb) { const float v = cbn - st.m[qb]; st.negm[qb] = (f32x4){v, v, v, v}; }
        asm volatile("" : "+v"(st.negm[0]), "+v"(st.negm[1])); } }
#pragma unroll
    for (int r = 0; r < 4; ++r)
#pragma unroll
        for (int kb = 0; kb < 4; ++kb) { sc.v[kb][0][r] = __builtin_amdgcn_exp2f(sc.v[kb][0][r]); sc.v[kb][1][r] = __builtin_amdgcn_exp2f(sc.v[kb][1][r]); }
    if (!ONES) {
#pragma unroll
        for (int qb = 0; qb < 2; ++qb) { float ua, ub, t1_, t2_, t3_;
            asm("s_nop 1\n\tv_add_f32 %0, %4, %5\n\tv_add_f32 %1, %6, %7\n\tv_add_f32 %2, %8, %9\n\tv_add_f32 %3, %10, %11\n\tv_add_f32 %0, %0, %1\n\tv_add_f32 %2, %2, %3\n\tv_add_f32 %0, %0, %2"
                : "=&v"(ua), "=&v"(t1_), "=&v"(t2_), "=&v"(t3_) : "v"(sc.v[0][qb][0]), "v"(sc.v[0][qb][1]), "v"(sc.v[0][qb][2]), "v"(sc.v[0][qb][3]), "v"(sc.v[1][qb][0]), "v"(sc.v[1][qb][1]), "v"(sc.v[1][qb][2]), "v"(sc.v[1][qb][3]));
            asm("s_nop 1\n\tv_add_f32 %0, %4, %5\n\tv_add_f32 %1, %6, %7\n\tv_add_f32 %2, %8, %9\n\tv_add_f32 %3, %10, %11\n\tv_add_f32 %0, %0, %1\n\tv_add_f32 %2, %2, %3\n\tv_add_f32 %0, %0, %2"
                : "=&v"(ub), "=&v"(t1_), "=&v"(t2_), "=&v"(t3_) : "v"(sc.v[2][qb][0]), "v"(sc.v[2][qb][1]), "v"(sc.v[2][qb][2]), "v"(sc.v[2][qb][3]), "v"(sc.v[3][qb][0]), "v"(sc.v[3][qb][1]), "v"(sc.v[3][qb][2]), "v"(sc.v[3][qb][3]));
            asm("v_add_f32 %0, %0, %1" : "+v"(ua) : "v"(ub)); st.l[qb] += ua; } }
#pragma unroll
    for (int kp = 0; kp < 2; ++kp)
#pragma unroll
        for (int qb = 0; qb < 2; ++qb) { st.pw[kp][qb].x = cvtpk(sc.v[2 * kp][qb][0], sc.v[2 * kp][qb][1]); st.pw[kp][qb].y = cvtpk(sc.v[2 * kp][qb][2], sc.v[2 * kp][qb][3]);
            st.pw[kp][qb].z = cvtpk(sc.v[2 * kp + 1][qb][0], sc.v[2 * kp + 1][qb][1]); st.pw[kp][qb].w = cvtpk(sc.v[2 * kp + 1][qb][2], sc.v[2 * kp + 1][qb][3]); }
    asm volatile("" : "+v"(st.pw[0][0]), "+v"(st.pw[0][1]), "+v"(st.pw[1][0]), "+v"(st.pw[1][1]));
}

template <bool ONES>
__device__ __forceinline__ void h2x(St2& st, Sc& sc, int kslot, int vslot) {
    const bf16x8 ones = (bf16x8){16256, 16256, 16256, 16256, 16256, 16256, 16256, 16256};
    const unsigned kaddr = (unsigned)(uintptr_t)(st.kfb + kslot * KSLOT), vaddr = (unsigned)(uintptr_t)(st.vfb + vslot * VSLOT);
    s16x4 vlo[5], vhi[5]; bf16x8 kfr[5];
#define X2_RDV(i) asm volatile("ds_read_b64_tr_b16 %0, %2 offset:%3\n\tds_read_b64_tr_b16 %1, %2 offset:%4" : "=&v"(vlo[(i) % 5]), "=&v"(vhi[(i) % 5]) : "v"(vaddr), "i"(((i) & 3) * 2048 + ((i) >> 2) * 1024), "i"(((i) & 3) * 2048 + ((i) >> 2) * 1024 + 512))
#define X2_RDK(i) asm volatile("ds_read_b128 %0, %1 offset:%2" : "=v"(kfr[(i) % 5]) : "v"(kaddr), "i"((((i) - 8) >> 2) * 4096 + (((i) - 8) & 3) * 256))
#define X2_WV(i, n) do { asm volatile("s_waitcnt %0" :: "i"(0xC07F | ((n) << 8)) : "memory"); MLA_SB(); } while (0)
#define X2_WK(i, n) do { asm volatile("s_waitcnt %0" :: "i"(0xC07F | ((n) << 8)) : "memory"); MLA_SB(); } while (0)
#define X2_MV(g_) do { const bf16x8 vf = (bf16x8){vlo[(g_) % 5][0], vlo[(g_) % 5][1], vlo[(g_) % 5][2], vlo[(g_) % 5][3], vhi[(g_) % 5][0], vhi[(g_) % 5][1], vhi[(g_) % 5][2], vhi[(g_) % 5][3]}; \
        st.ot[(g_) & 3][0] = MFMA16(vf, __builtin_bit_cast(bf16x8, st.pw[(g_) >> 2][0]), st.ot[(g_) & 3][0]); st.ot[(g_) & 3][1] = MFMA16(vf, __builtin_bit_cast(bf16x8, st.pw[(g_) >> 2][1]), st.ot[(g_) & 3][1]); \
        } while (0)
#define X2_MK(g_) do { sc.v[((g_) - 8) & 3][0] = MFMA16(kfr[(g_) % 5], st.qf[0][((g_) - 8) >> 2], (g_) < 12 ? st.negm[0] : sc.v[((g_) - 8) & 3][0]); \
        sc.v[((g_) - 8) & 3][1] = MFMA16(kfr[(g_) % 5], st.qf[1][((g_) - 8) >> 2], (g_) < 12 ? st.negm[1] : sc.v[((g_) - 8) & 3][1]); } while (0)
    __builtin_amdgcn_s_setprio(1);
    X2_RDV(0); X2_RDV(1); X2_RDV(2); X2_RDV(3); X2_RDV(4);
    if (ONES) {
        st.accl[0] = MFMA16(ones, __builtin_bit_cast(bf16x8, st.pw[0][0]), st.accl[0]); st.accl[1] = MFMA16(ones, __builtin_bit_cast(bf16x8, st.pw[0][1]), st.accl[1]);
        st.accl[0] = MFMA16(ones, __builtin_bit_cast(bf16x8, st.pw[1][0]), st.accl[0]); st.accl[1] = MFMA16(ones, __builtin_bit_cast(bf16x8, st.pw[1][1]), st.accl[1]); MLA_SB(); }
    X2_WV(0, 8); X2_MV(0); MLA_SB(); X2_RDV(5);
    X2_WV(1, 8); X2_MV(1); MLA_SB(); X2_RDV(6);
    X2_WV(2, 8); X2_MV(2); MLA_SB(); X2_RDV(7);
    X2_WV(3, 8); X2_MV(3); MLA_SB(); X2_RDK(8);
    X2_WV(4, 7); X2_MV(4); MLA_SB(); X2_RDK(9);
    X2_WV(5, 6); X2_MV(5); MLA_SB(); X2_RDK(10);
    X2_WV(6, 5); X2_MV(6); MLA_SB(); X2_RDK(11);
    X2_WV(7, 4); X2_MV(7); MLA_SB(); X2_RDK(12);
    X2_WK(8, 4); X2_MK(8); MLA_SB(); X2_RDK(13);
    X2_WK(9, 4); X2_MK(9); MLA_SB(); X2_RDK(14);
    X2_WK(10, 4); X2_MK(10); MLA_SB(); X2_RDK(15);
    X2_WK(11, 4); X2_MK(11); MLA_SB(); X2_RDK(16);
    X2_WK(12, 4); X2_MK(12); MLA_SB(); X2_RDK(17);
    X2_WK(13, 4); X2_MK(13); MLA_SB(); X2_RDK(18);
    X2_WK(14, 4); X2_MK(14); MLA_SB(); X2_RDK(19);
    X2_WK(15, 4); X2_MK(15); MLA_SB();
    X2_WK(16, 3); X2_MK(16); MLA_SB();
    X2_WK(17, 2); X2_MK(17); MLA_SB();
    X2_WK(18, 1); X2_MK(18); MLA_SB();
    X2_WK(19, 0); X2_MK(19); MLA_SB();
    __builtin_amdgcn_s_setprio(0);
#undef X2_RDV
#undef X2_RDK
#undef X2_WV
#undef X2_WK
#undef X2_MV
#undef X2_MK
}

template <bool SAFE>
__device__ __forceinline__ bool unitx(int h, int q0, const bf16* __restrict__ Q1, const bf16* __restrict__ K1, const bf16* __restrict__ V1, bf16* __restrict__ O,
                                      LAS unsigned char* lds, const float clo, const float chi, int wave, int lane) {
    const int q16 = lane & 15, g = lane >> 4, grp = wave >> 2;
    St2 st;
    st.tbl = (const LAS float*)(lds + L_TBL); st.clo = clo; st.chi = chi;
    st.qrow = q0 + 32 * wave + q16;
    const unsigned koff0 = (unsigned)(lane * KPITCH + h * 96 + wave * 8) * 2u, koff1 = (unsigned)(lane * KPITCH + h * 96 + (8 + (wave & 3)) * 8) * 2u;
    const unsigned voff = (unsigned)((32 * (wave & 1) + (lane >> 1)) * D + h * 64 + (wave >> 1) * 16 + (lane & 1) * 8) * 2u;
#define MLA_DMA_K(t, slot) do { const char* kt_ = sgpr_ptr((const char*)K1 + (size_t)(t) * (64 * KPITCH * 2)); \
        __builtin_amdgcn_global_load_lds((const unsigned*)(kt_ + koff0), (LAS unsigned*)(lds + L_K + (slot) * KSLOT + wave * 1024), 16, 0, 0); \
        if (wave < 4) __builtin_amdgcn_global_load_lds((const unsigned*)(kt_ + koff1), (LAS unsigned*)(lds + L_K + (slot) * KSLOT + (8 + wave) * 1024), 16, 0, 0); } while (0)
#define MLA_DMA_V(t, slot) __builtin_amdgcn_global_load_lds((const unsigned*)(sgpr_ptr((const char*)V1 + (size_t)(t) * (64 * D * 2)) + voff), (LAS unsigned*)(lds + L_V + (slot) * VSLOT + wave * 1024), 16, 0, 0)
    MLA_DMA_K(0, 0); MLA_DMA_K(1, 1); MLA_DMA_V(0, 0); MLA_DMA_K(2, 2); MLA_DMA_V(1, 1);
#pragma unroll
    for (int qb = 0; qb < 2; ++qb) { const bf16* qp = Q1 + (size_t)(st.qrow + 16 * qb) * NQ1 + h * 96 + 8 * g;
#pragma unroll
        for (int db = 0; db < 3; ++db) st.qf[qb][db] = *(const bf16x8*)(qp + 32 * db); }
    st.l[0] = 0.f; st.l[1] = 0.f;
#pragma unroll
    for (int i = 0; i < 4; ++i) { st.ot[i][0] = (f32x4){0.f, 0.f, 0.f, 0.f}; st.ot[i][1] = (f32x4){0.f, 0.f, 0.f, 0.f}; }
    st.accl[0] = (f32x4){0.f, 0.f, 0.f, 0.f}; st.accl[1] = (f32x4){0.f, 0.f, 0.f, 0.f};
    st.kfb = lds + L_K + g * 1024 + q16 * 16;
    st.vfb = lds + L_V + (4 * g + (q16 >> 2)) * 32 + (lane & 3) * 8;
    st.tl_end = (q0 - 622 >= 0) ? (q0 - 622) / 64 + 1 : 0;
    st.tr_beg = (q0 + 814 + 63) / 64;
    Sc sc;
    MLA_WAITBAR();
    { const LAS unsigned char* kb_ = st.kfb;
#pragma unroll
      for (int kb = 0; kb < 4; ++kb) { sc.v[kb][0] = (f32x4){0.f, 0.f, 0.f, 0.f}; sc.v[kb][1] = (f32x4){0.f, 0.f, 0.f, 0.f}; }
#pragma unroll
      for (int db = 0; db < 3; ++db)
#pragma unroll
          for (int kb = 0; kb < 4; ++kb) { const bf16x8 a = *(const LAS bf16x8*)(kb_ + db * 4096 + kb * 256);
              sc.v[kb][0] = MFMA16(a, st.qf[0][db], sc.v[kb][0]); sc.v[kb][1] = MFMA16(a, st.qf[1][db], sc.v[kb][1]); }
      const float cb0 = tile_cb2(st, 0);
#pragma unroll
      for (int qb = 0; qb < 2; ++qb) { float mx = sc.v[0][qb][0];
#pragma unroll
          for (int kb = 0; kb < 4; ++kb)
#pragma unroll
              for (int r = 0; r < 4; ++r) mx = fmaxf(mx, sc.v[kb][qb][r]);
          mx = fmaxf(mx, __shfl_xor(mx, 16)); mx = fmaxf(mx, __shfl_xor(mx, 32));
          st.m[qb] = mx + cb0;
#pragma unroll
          for (int kb = 0; kb < 4; ++kb) sc.v[kb][qb] -= mx; }
      st.cbn = 1e30f; }
    MLA_BAR();
#define MLA_STAGE(t) do { if ((t) + 3 < NT) MLA_DMA_K((t) + 3, ((t) + 3) & 3); if ((t) + 2 < NT) MLA_DMA_V((t) + 2, ((t) + 2) & 3); } while (0)
    if (grp == 0) {
        MLA_STAGE(0);
        for (int t = 0; t < NT; ++t) {
            h1x<SAFE, false>(st, sc, t, lane);
            if (t + 3 < NT) MLA_WAITBAR_N(6); else MLA_WAITBAR();
            h2x<false>(st, sc, (t + 1) & 3, t & 3);
            MLA_STAGE(t + 1);
            MLA_BAR();
        }
    } else {
        for (int t = 0; t < NT; ++t) {
            if (t > 0) h2x<true>(st, sc, t & 3, (t - 1) & 3);
            if (t + 3 < NT) MLA_WAITBAR_N(2); else MLA_WAITBAR();
            MLA_STAGE(t);
            h1x<SAFE, true>(st, sc, t, lane);
            MLA_BAR();
        }
        h2x<true>(st, sc, NT & 3, (NT - 1) & 3);
    }
#undef MLA_STAGE
    float l[2];
#pragma unroll
    for (int qb = 0; qb < 2; ++qb) { float v = st.l[qb]; v += __shfl_xor(v, 16); v += __shfl_xor(v, 32); l[qb] = grp == 1 ? st.accl[qb][0] : v; }
    bool ok = true;
    if (!SAFE) { const bool bad = !(l[0] > 0.f && l[0] < 1.0e37f) || !(l[1] > 0.f && l[1] < 1.0e37f);
        LAS unsigned* flag = (LAS unsigned*)(lds + L_FLAG);
        const bool anybad = __any(bad);
        if (lane == 0) flag[wave] = anybad ? 1u : 0u;
        MLA_BAR();
        unsigned f = 0;
#pragma unroll
        for (int i = 0; i < 8; ++i) f |= flag[i];
        ok = (f == 0u); }
    LAS bf16* stg = (LAS bf16*)(lds + L_OST) + wave * 2048;
#pragma unroll
    for (int qb = 0; qb < 2; ++qb) { const float inv = 1.0f / l[qb];
#pragma unroll
        for (int dblk = 0; dblk < 4; ++dblk) { u32x2 w; w.x = cvtpk(st.ot[dblk][qb][0] * inv, st.ot[dblk][qb][1] * inv); w.y = cvtpk(st.ot[dblk][qb][2] * inv, st.ot[dblk][qb][3] * inv);
            *(LAS u32x2*)(stg + (16 * qb + q16) * 64 + 16 * dblk + 4 * g) = w; } }
    asm volatile("s_waitcnt lgkmcnt(0)" ::: "memory");
    bf16* Ow = O + (size_t)(q0 + 32 * wave) * D + h * 64;
    if (ok) {
#pragma unroll
    for (int i = 0; i < 4; ++i) { const int row = i * 8 + (lane >> 3), ch = lane & 7; const u32x4 v = *(const LAS u32x4*)(stg + row * 64 + ch * 8); *(u32x4*)(Ow + (size_t)row * D + ch * 8) = v; } }
    MLA_WAITBAR();
#undef MLA_DMA_K
#undef MLA_DMA_V
    return ok;
}
}

__device__ __forceinline__ void ffn_up_phase(LAS unsigned char* lds, const bf16* Xb, const bf16* Wgu, bf16* act, const float* ss, unsigned char* ws, int which, int G, int bx) {
    pg8::Gemm g{Xb, Wgu, S, 2 * FF, D, D}; pg8::StaticOrder So; So.init(S, 2 * FF, G, bx);
    const pg8::EpiSwiGLU E{act, ss};
    const int full = (So.nwg / G) * G, tail = So.nwg - full;
    const bool split = (tail * 2 == G) && (WS_V1 + (size_t)tail * 262144 <= WS_SAVE);
    if (split) So.hi = full;
    pg8::gemm_phase<pg8::EpiSwiGLU, true>(lds, g, So, E);
    if (split) {
        const int cc = bx < tail ? bx : bx - tail; const bool helper = bx >= tail;
        const pg8::Gemm g2{Xb + (helper ? D / 2 : 0), Wgu + (helper ? D / 2 : 0), S, 2 * FF, D / 2, D, D};
        pg8::StaticOrder So2; So2.init(S, 2 * FF, G, cc); So2.lo = full;
        float* part = (float*)(ws + WS_V1) + (size_t)cc * 65536; unsigned* fl = (unsigned*)(ws + CTL_SPLIT) + which * 2048 + cc * 16;
        pg8::gemm_phase<pg8::EpiSplit<pg8::EpiSwiGLU>, true>(lds, g2, So2, pg8::EpiSplit<pg8::EpiSwiGLU>{E, part, fl, helper});
    }
}

constexpr int NWAVES = 8;
__global__ void __launch_bounds__(NWAVES * 64, 2) fwd_kernel(Args args) {
    extern __shared__ __attribute__((aligned(16))) unsigned char lds_raw[];
    LAS unsigned char* lds = (LAS unsigned char*)lds_raw;
    volatile LAS unsigned* MISC = (volatile LAS unsigned*)(lds + MISC_OFF);
    const int tid = threadIdx.x, lane = tid & 63, wave = __builtin_amdgcn_readfirstlane(tid >> 6);
    const int G = gridDim.x; const int bx = blockIdx.x;
    const int vcu = (G % 8 == 0) ? (bx % 8) * (G / 8) + bx / 8 : bx;
    unsigned char* ws = args.ws;
    float* const out = args.out;
    const int lo = args.ph_lo, hi_ph = args.ph_hi;
    for (int u = tid; u < (LDS_BYTES - LDSCTL_OFF) / 4; u += NWAVES * 64) ((LAS unsigned*)(lds + LDSCTL_OFF))[u] = 0u;
    __syncthreads();
    const bool multi = (hi_ph - lo) > 1;
    XcdBarrier bar; bar.bar = (unsigned*)(ws + CTL_BAR); bar.x = 0; bar.st = nullptr;
    if (multi) bar = xcd_barrier_post((unsigned*)(ws + CTL_BAR), MISC + 8);
#ifndef PHASE_MASK
#define PHASE_MASK 0x1fff
#endif
#define IN(k) ((((PHASE_MASK) >> (k)) & 1) && lo <= (k) && (k) < hi_ph)
#ifndef REPEAT_MASK
#define REPEAT_MASK 0
#endif
#define REPS(k) ((((REPEAT_MASK) >> (k)) & 1) ? 2 : 1)
#define SEAM(k) do { if (IN(k) && IN((k) + 1)) xcd_barrier(bar); } while (0)

    float* const SS = (float*)(ws + CTL_SS);
    float* const SS0 = SS, * const SS1 = SS + S, * const SS2 = SS + 2 * S, * const SS3 = SS + 3 * S, * const SS4 = SS + 4 * S, * const SSQ = SS + 5 * S, * const SSKV = SS + 6 * S;
    bf16* const XB = (bf16*)(ws + WS_XB); bf16* const OB = (bf16*)(ws + WS_O); bf16* const BIG = (bf16*)(ws + WS_BIG);
    bf16* const Q1 = (bf16*)(ws + WS_Q1); bf16* const K1 = (bf16*)(ws + WS_K1); bf16* const V1 = (bf16*)(ws + WS_V1);
    const float* const ROPE = (const float*)(ws + WS_ROPE);
    const int gw = vcu * NWAVES + wave, NGW = G * NWAVES;

    if (IN(0)) {
        LAS float* scr = (LAS float*)(lds + wave * 16384);
        const float* an0 = args.in[I_ANORM], * an1 = args.in[I_ANORM] + D, * fn0 = args.in[I_FNORM], * fn1 = args.in[I_FNORM] + D;
        constexpr int NITEMS = 1536 + 512 + 1408 * 3 + 272 + 288 + 64 + 64 + 512 + 1408 * 3;
        for (int it = gw; it < NITEMS; it += NGW) {
            int r = it;
            if (p0_matrix<0>(r, args.in[I_EWIN], D, NQKV, an0, (bf16*)(ws + W_IN0), D, 0, scr, lane)) continue;
            if (p0_matrix<0>(r, args.in[I_EWOUT], D, D, nullptr, (bf16*)(ws + W_OUT0), D, 0, scr, lane)) continue;
            if (p0_matrix<1>(r, args.in[I_WG], D, FF, fn0, (bf16*)(ws + W_GU0), D, 0, scr, lane)) continue;
            if (p0_matrix<2>(r, args.in[I_WU], D, FF, fn0, (bf16*)(ws + W_GU0), D, 0, scr, lane)) continue;
            if (p0_matrix<0>(r, args.in[I_WD], FF, D, nullptr, (bf16*)(ws + W_D0), FF, 0, scr, lane)) continue;
            if (p0_matrix<0>(r, args.in[I_OWIN], D, NIN1, an1, (bf16*)(ws + W_IN1), D, 0, scr, lane)) continue;
            if (p0_matrix<0>(r, args.in[I_WUQ], QL, NQ1, args.in[I_QNORM], (bf16*)(ws + W_UQ), QL, 0, scr, lane)) continue;
            if (p0_matrix<0>(r, args.in[I_WUK], KVL, D, args.in[I_KVNORM], (bf16*)(ws + W_UKV), KVLP, 0, scr, lane)) continue;
            if (p0_matrix<0>(r, args.in[I_WUV], KVL, D, args.in[I_KVNORM], (bf16*)(ws + W_UKV), KVLP, 1024, scr, lane)) continue;
            if (p0_matrix<0>(r, args.in[I_OWOUT], D, D, nullptr, (bf16*)(ws + W_OUT1), D, 0, scr, lane)) continue;
            if (p0_matrix<1>(r, args.in[I_WG] + (size_t)D * FF, D, FF, fn1, (bf16*)(ws + W_GU1), D, 0, scr, lane)) continue;
            if (p0_matrix<2>(r, args.in[I_WU] + (size_t)D * FF, D, FF, fn1, (bf16*)(ws + W_GU1), D, 0, scr, lane)) continue;
            p0_matrix<0>(r, args.in[I_WD] + (size_t)FF * D, FF, D, nullptr, (bf16*)(ws + W_D1), FF, 0, scr, lane);
        }
        const int gt = vcu * (NWAVES * 64) + tid, NGT = G * NWAVES * 64;
        for (int i = gt; i < (NIN1P - NIN1) * D / 8; i += NGT) ((u32x4*)(ws + W_IN1 + (size_t)NIN1 * D * 2))[i] = (u32x4){0u, 0u, 0u, 0u};
        for (int i = gt; i < NKV1 * 16; i += NGT) { const int row = i >> 4, c = i & 15; *(u32x4*)(ws + W_UKV + ((size_t)row * KVLP + KVL + c * 8) * 2) = (u32x4){0u, 0u, 0u, 0u}; }
        for (int mrow = gw * 4; mrow < S; mrow += NGW * 4) {
            f32x4 v[4][4];
#pragma unroll
            for (int rr = 0; rr < 4; ++rr) { const f32x4* xr = (const f32x4*)(args.in[I_X] + (size_t)(mrow + rr) * D) + lane;
#pragma unroll
                for (int j = 0; j < 4; ++j) v[rr][j] = xr[64 * j]; }
#pragma unroll
            for (int rr = 0; rr < 4; ++rr) { float s2 = 0.f; unsigned long long* o8 = (unsigned long long*)(XB + (size_t)(mrow + rr) * D) + lane;
#pragma unroll
                for (int j = 0; j < 4; ++j) { const f32x4 w = v[rr][j]; s2 += (w.x * w.x + w.y * w.y) + (w.z * w.z + w.w * w.w);
                    o8[64 * j] = (unsigned long long)cvtpk(w.x, w.y) | ((unsigned long long)cvtpk(w.z, w.w) << 32); }
                s2 = wave_sum(s2);
                if (lane == 0) SS0[mrow + rr] = s2; }
        }
        float* rope = (float*)(ws + WS_ROPE);
        for (int i = gt; i < S * 16; i += NGT) { const int pos = i >> 4, fi = i & 15; const float fr = powf(10000.0f, -(float)fi / 16.0f), ang = (float)pos * fr;
            rope[2 * i] = cosf(ang); rope[2 * i + 1] = sinf(ang); }
        const float* t5 = args.in[I_T5];
        float* tdil = (float*)(ws + WS_TDIL);
        for (int i = gt; i < 8 * 2368; i += NGT) { const int h = i / 2368, d = i % 2368 - 1152, n = d < 0 ? -d : d; int mult = 0;
            if (n <= 64) ++mult; if ((d & 3) == 0 && n <= 256) ++mult; if ((d & 15) == 0 && n <= 1024) ++mult;
            tdil[i] = mult ? (t5[t5_bucket_precise(d) * 16 + h] + logf((float)mult)) * LOG2E : NEGB; }
        float* tmla = (float*)(ws + WS_TMLA);
        for (int i = gt; i < 16 * 1984; i += NGT) { const int h = i / 1984; int d = i % 1984 - 960; d = d > 960 ? 960 : d; tmla[i] = t5[t5_bucket_precise(d) * 16 + h] * LOG2E; }
        float* trpb = (float*)(ws + WS_TRPB);
        for (int i = gt; i < 8 * 465; i += NGT) trpb[i] = args.in[I_RPB][i] * LOG2E;
    }
    SEAM(0);

    if (IN(1)) for (int rep_ = 0; rep_ < REPS(1); ++rep_) {
        pg8::Gemm g{XB, (const bf16*)(ws + W_IN0), S, NQKV, D, D}; pg8::StaticOrder So; So.init(S, NQKV, G, bx);
        pg8::EpiRowScale E{BIG, NQKV, SS0, 1.0f / D, 1};
        pg8::gemm_phase<pg8::EpiRowScale, true>(lds, g, So, E);
    }
    SEAM(1);

    if (IN(2)) for (int rep_ = 0; rep_ < REPS(2); ++rep_) {
        const int hd = vcu >> 5;
        LAS float* tdl = (LAS float*)(lds + 132096); LAS float* trp = (LAS float*)(lds + 132096 + 9472);
        for (int i = tid; i < 2368; i += NWAVES * 64) tdl[(i & 3) * 592 + (i >> 2)] = ((const float*)(ws + WS_TDIL))[hd * 2368 + i];
        for (int i = tid; i < 465; i += NWAVES * 64) trp[i] = ((const float*)(ws + WS_TRPB))[hd * 465 + i];
        __syncthreads();
        LAS unsigned char* wl = lds + wave * wattn::WREG;
        const int r32 = lane & 31;
        for (int rd = 0; rd < 2; ++rd) {
            const int blk = rd * 64 + 2 * (vcu & 31) + (wave >> 2), t0 = blk * 128, w = wave & 3;
            wattn::DilF f{t0, w, (t0 < 1152) || (t0 + 128 + 1152 > S), tdl};
            const int tq = t0 + w + 4 * r32;
            if (!wattn::run_unit<false>(f, BIG + (size_t)tq * NQKV + hd * 64, (const char*)(BIG + 512 + hd * 64), OB + (size_t)tq * D + hd * 64, wl, lane))
                (void)wattn::run_unit<true>(f, BIG + (size_t)tq * NQKV + hd * 64, (const char*)(BIG + 512 + hd * 64), OB + (size_t)tq * D + hd * 64, wl, lane);
        }
        for (int rn = 0; rn < 2; ++rn) {
            const int gr0 = rn * 128 + 4 * (vcu & 31);
            if (!wattn::na_coop<false>(gr0, BIG + 1536 + hd * 64, (const char*)(BIG + 2048 + hd * 64), OB + 512 + hd * 64, trp, lds, wave, lane))
                (void)wattn::na_coop<true>(gr0, BIG + 1536 + hd * 64, (const char*)(BIG + 2048 + hd * 64), OB + 512 + hd * 64, trp, lds, wave, lane);
        }
        __syncthreads();
    }
    SEAM(2);

    if (IN(3)) {
        pg8::Gemm g{OB, (const bf16*)(ws + W_OUT0), S, D, D, D}; pg8::StaticOrder So; So.init(S, D, G, bx);
#if DBG_CHECK
        pg8::EpiResid E{args.in[I_X], nullptr, out, XB, SS1};
#else
        pg8::EpiResid E{args.in[I_X], nullptr, nullptr, XB, SS1};
#endif
        pg8::gemm_phase<pg8::EpiResid, true>(lds, g, So, E);
    }
    SEAM(3);
    if (IN(4)) for (int rep_ = 0; rep_ < REPS(4); ++rep_) {
        ffn_up_phase(lds, XB, (const bf16*)(ws + W_GU0), BIG, SS1, ws, 0, G, bx);
    }
    SEAM(4);
    if (IN(5)) {
        pg8::Gemm g{BIG, (const bf16*)(ws + W_D0), S, D, FF, FF}; pg8::StaticOrder So; So.init(S, D, G, bx);
#if DBG_CHECK
        pg8::EpiResid E{out, nullptr, out, XB, SS2};
#else
        pg8::EpiResid E{nullptr, XB, nullptr, XB, SS2};
#endif
        pg8::gemm_phase<pg8::EpiResid, true>(lds, g, So, E);
    }
    SEAM(5);
    if (IN(6)) {
        pg8::Gemm g{XB, (const bf16*)(ws + W_IN1), S, NIN1P, D, D}; pg8::StaticOrder So; So.init(S, NIN1P, G, bx);
        pg8::EpiMlaIn E{OB, SS2, SSQ, SSKV, K1, ROPE};
        pg8::gemm_phase<pg8::EpiMlaIn, true>(lds, g, So, E);
    }
    SEAM(6);
    if (IN(7)) for (int rep_ = 0; rep_ < REPS(7); ++rep_) {
        { pg8::Gemm g{OB, (const bf16*)(ws + W_UQ), S, NQ1, QL, NIN1P}; pg8::StaticOrder So; So.init(S, NQ1, G, bx);
          pg8::EpiMlaQ E{Q1, SSQ, ROPE};
          pg8::gemm_phase<pg8::EpiMlaQ, true>(lds, g, So, E); }
        { pg8::Gemm g{OB + QL, (const bf16*)(ws + W_UKV), S, NKV1, KVLP, NIN1P}; pg8::StaticOrder So; So.init(S, NKV1, G, bx);
          pg8::EpiMlaKV E{K1, V1, SSKV};
          pg8::gemm_phase<pg8::EpiMlaKV, true>(lds, g, So, E); }
    }
    SEAM(7);
    if (IN(8)) for (int rep_ = 0; rep_ < REPS(8); ++rep_) {
        const int hm = vcu >> 4;
        LAS float* tml = (LAS float*)(lds + mla::L_TBL);
        const float* tg = (const float*)(ws + WS_TMLA) + hm * 1984;
        for (int i = tid; i < 1921; i += NWAVES * 64) tml[i] = tg[i];
        const float clo = tg[0], chi = tg[1920];
        __syncthreads();
        for (int rd = 0; rd < 4; ++rd) { const int q0 = ((vcu & 15) * 4 + rd) * 256;
            if (!mla::unitx<false>(hm, q0, Q1, K1, V1, OB, lds, clo, chi, wave, lane)) (void)mla::unitx<true>(hm, q0, Q1, K1, V1, OB, lds, clo, chi, wave, lane); }
        __syncthreads();
    }
    SEAM(8);
    if (IN(9)) {
        pg8::Gemm g{OB, (const bf16*)(ws + W_OUT1), S, D, D, D}; pg8::StaticOrder So; So.init(S, D, G, bx);
#if DBG_CHECK
        pg8::EpiResid E{out, nullptr, out, XB, SS3};
#else
        pg8::EpiResid E{nullptr, XB, nullptr, XB, SS3};
#endif
        pg8::gemm_phase<pg8::EpiResid, true>(lds, g, So, E);
    }
    SEAM(9);
    if (IN(10)) for (int rep_ = 0; rep_ < REPS(10); ++rep_) {
        ffn_up_phase(lds, XB, (const bf16*)(ws + W_GU1), BIG, SS3, ws, 1, G, bx);
    }
    SEAM(10);
#if DBG_CHECK || !defined(FUSE_FINAL_NORM)
    if (IN(11)) {
        pg8::Gemm g{BIG, (const bf16*)(ws + W_D1), S, D, FF, FF}; pg8::StaticOrder So; So.init(S, D, G, bx);
        pg8::EpiResid E{out, nullptr, out, XB, SS4};
        pg8::gemm_phase<pg8::EpiResid, true>(lds, g, So, E);
    }
    SEAM(11);
    if (IN(12)) {
        const f32x4* gf = (const f32x4*)args.in[I_FINAL] + lane;
        for (int mrow = gw; mrow < S; mrow += NGW) {
            f32x4* xr = (f32x4*)(out + (size_t)mrow * D) + lane; f32x4 v[4]; float s2 = 0.f;
#pragma unroll
            for (int j = 0; j < 4; ++j) { v[j] = xr[64 * j]; s2 += (v[j].x * v[j].x + v[j].y * v[j].y) + (v[j].z * v[j].z + v[j].w * v[j].w); }
            const float rs = 1.0f / sqrtf(wave_sum(s2) * (1.0f / D) + RMS_EPS);
#pragma unroll
            for (int j = 0; j < 4; ++j) xr[64 * j] = v[j] * rs * gf[64 * j];
        }
    }
#else
    if (IN(11)) {
        pg8::Gemm g{BIG, (const bf16*)(ws + W_D1), S, D, FF, FF}; pg8::StaticOrder So; So.init(S, D, G, bx);
        pg8::EpiFinal E{nullptr, XB, out, SS4, (unsigned*)(ws + CTL_PANEL), args.in[I_FINAL]};
        pg8::gemm_phase<pg8::EpiFinal, true>(lds, g, So, E);
    }
#endif
#ifdef TIMING_SEL
    if (IN(12)) { __syncthreads(); if (blockIdx.x == 0) { const float* tp = (const float*)(ws + CTL_STATS); const float A = rintf(tp[TIMING_SEL] * (1.0f / 1024.0f) * (1.0f / 32.0f)) * 32.0f, B = rintf(tp[TIMING_SEL2] * (1.0f / 1024.0f) * (1.0f / 32.0f)) * 0.32f;
        if (tid == 0) out[0] += A; for (int i = tid; i < 16384; i += NWAVES * 64) if (i) out[(size_t)i * 1024] += B; } }
#endif
#undef IN
#undef SEAM
}

#if DBG_CHECK
namespace dbg {
constexpr int NSAMP = 1024;
__device__ __forceinline__ int srow(int i) { return 16 * i + ((i * 5) & 15); }
__device__ __forceinline__ void accum(float err, float ref, float* stats, int slot) {
    __shared__ float se[8], sr[8];
    err = wave_sum(err); ref = wave_sum(ref);
    const int w = threadIdx.x >> 6;
    if ((threadIdx.x & 63) == 0) { se[w] = err; sr[w] = ref; }
    __syncthreads();
    if (threadIdx.x == 0) { float e = 0.f, r = 0.f; for (int i = 0; i < (int)(blockDim.x >> 6); ++i) { e += se[i]; r += sr[i]; } atomicAdd(stats + 2 * slot, e); atomicAdd(stats + 2 * slot + 1, r); }
    __syncthreads();
}
__global__ void k_rowrstd(const float* src, int ld, int ncols, int compact, float* outv) {
    const int i = blockIdx.x, m = compact ? i : srow(i); float s = 0.f;
    for (int k = threadIdx.x; k < ncols; k += 64) { const float v = src[(size_t)m * ld + k]; s += v * v; }
    s = wave_sum(s);
    if (threadIdx.x == 0) outv[i] = 1.0f / sqrtf(s / ncols + RMS_EPS);
}
__global__ void k_rowrstd_bf(const bf16* src, int ld, int ncols, float* outv) {
    const int i = blockIdx.x, m = srow(i); float s = 0.f;
    for (int k = threadIdx.x; k < ncols; k += 64) { const float v = bf2f(src[(size_t)m * ld + k]); s += v * v; }
    s = wave_sum(s);
    if (threadIdx.x == 0) outv[i] = 1.0f / sqrtf(s / ncols + RMS_EPS);
}
__global__ void k_save_rows(const float* src, float* dst) {
    const int i = blockIdx.x, m = srow(i);
    for (int k = threadIdx.x; k < D; k += blockDim.x) dst[(size_t)i * D + k] = src[(size_t)m * D + k];
}
template <int ABF, int GOTBF>
__global__ void k_chk_lin(const void* A, int lda, int acomp, const float* rs, const float* gain, const float* W, int ldw, int K, int N,
                          const float* resid, int ldr, int rcomp, const void* got, int ldg, float gscale, float* stats, int slot) {
    const int i = blockIdx.y, m = srow(i), n = blockIdx.x * 256 + threadIdx.x;
    float err = 0.f, ref2 = 0.f;
    if (n < N) {
        const size_t arow = (size_t)(acomp ? i : m) * lda; float acc = 0.f;
        for (int k = 0; k < K; ++k) { const float a = ABF ? bf2f(((const bf16*)A)[arow + k]) : ((const float*)A)[arow + k]; acc += a * (gain ? gain[k] : 1.0f) * W[(size_t)k * ldw + n]; }
        float ref = acc * (rs ? rs[i] : 1.0f);
        if (resid) ref += resid[(size_t)(rcomp ? i : m) * ldr + n];
        float g = (GOTBF ? bf2f(((const bf16*)got)[(size_t)m * ldg + n]) : ((const float*)got)[(size_t)m * ldg + n]) * gscale;
        if (slot == 1 && (n < 512 || (n >= 1536 && n < 2048))) g *= (1.0f / C2_LOCAL);
        err = (g - ref) * (g - ref); ref2 = ref * ref;
    }
    accum(err, ref2, stats, slot);
}
__global__ void k_chk_swiglu(const float* X, const float* rs, const float* gain, const float* Wg, const float* Wu, const bf16* got, float* stats, int slot) {
    const int i = blockIdx.y, m = srow(i), n = blockIdx.x * 256 + threadIdx.x;
    float a = 0.f, b = 0.f;
    for (int k = 0; k < D; ++k) { const float h = X[(size_t)m * D + k] * gain[k]; a += h * Wg[(size_t)k * FF + n]; b += h * Wu[(size_t)k * FF + n]; }
    a *= rs[i]; b *= rs[i];
    const float ref = a / (1.0f + expf(-a)) * b, g = bf2f(got[(size_t)m * FF + n]);
    accum((g - ref) * (g - ref), ref * ref, stats, slot);
}
__global__ void k_chk_krope(const float* X, const float* rs, const float* gain, const float* Win1, const bf16* K1, float* stats, int slot) {
    const int si = blockIdx.x, m = srow(si), i = threadIdx.x & 31, f = i & 15;
    float x1 = 0.f, x2 = 0.f;
    for (int k = 0; k < D; ++k) { const float h = X[(size_t)m * D + k] * gain[k]; x1 += h * Win1[(size_t)k * NIN1 + 512 + f]; x2 += h * Win1[(size_t)k * NIN1 + 528 + f]; }
    x1 *= rs[si]; x2 *= rs[si];
    const float fr = powf(10000.0f, -(float)f / 16.0f), ang = (float)m * fr, c = cosf(ang), sn = sinf(ang);
    const float ref = (i < 16) ? (x1 * c - x2 * sn) : (x1 * sn + x2 * c);
    float err = 0.f, r2 = 0.f;
    for (int h = (threadIdx.x >> 5) * 8; h < (threadIdx.x >> 5) * 8 + 8; ++h) { const float g = bf2f(K1[(size_t)m * KPITCH + h * 96 + 64 + i]); err += (g - ref) * (g - ref); r2 += ref * ref; }
    accum(err, r2, stats, slot);
}
__global__ void k_chk_q(const bf16* P, const float* rsq, const float* qnorm, const float* Wuq, const bf16* Q1, float* stats, int slot) {
    const int si = blockIdx.y, m = srow(si), n = blockIdx.x * 256 + threadIdx.x, off = n % 96;
    const bool rope = off >= 64; const int f = (off - 64) & 15; const int n1 = n - off + 64 + f, n2 = n1 + 16;
    float a = 0.f, b = 0.f;
    for (int k = 0; k < QL; ++k) { const float c = bf2f(P[(size_t)m * NIN1P + k]) * qnorm[k];
        if (rope) { a += c * Wuq[(size_t)k * NQ1 + n1]; b += c * Wuq[(size_t)k * NQ1 + n2]; } else a += c * Wuq[(size_t)k * NQ1 + n]; }
    a *= rsq[si]; b *= rsq[si];
    float ref = a;
    if (rope) { const float fr = powf(10000.0f, -(float)f / 16.0f), ang = (float)m * fr, c = cosf(ang), sn = sinf(ang); ref = (off < 80) ? (a * c - b * sn) : (a * sn + b * c); }
    const float g = bf2f(Q1[(size_t)m * NQ1 + n]) / C2_MLA;
    accum((g - ref) * (g - ref), ref * ref, stats, slot);
}
__global__ void k_chk_kv(const bf16* P, const float* rskv, const float* kvnorm, const float* W, const bf16* got, int iskf, float* stats, int slot) {
    const int si = blockIdx.y, m = srow(si), n = blockIdx.x * 256 + threadIdx.x;
    float a = 0.f;
    for (int k = 0; k < KVL; ++k) a += bf2f(P[(size_t)m * NIN1P + QL + k]) * kvnorm[k] * W[(size_t)k * D + n];
    a *= rskv[si];
    const float g = iskf ? bf2f(got[(size_t)m * KPITCH + (n >> 6) * 96 + (n & 63)]) : bf2f(got[(size_t)m * D + n]);
    accum((g - a) * (g - a), a * a, stats, slot);
}
__device__ __forceinline__ int ltok(int i) { if (i < 4) return i; if (i < 8) return S - 1 - (i - 4); return 32 * i + ((i * 13) & 31); }
__global__ void __launch_bounds__(64) k_chk_local(const bf16* QKV, const float* t5, const float* rpb, const bf16* O, float* stats, int slot) {
    const int idx = blockIdx.x * 64 + threadIdx.x, i = idx >> 4, h = idx & 15, t = ltok(i);
    float q[64], o[64];
    float err = 0.f, r2 = 0.f;
    if (h < 8) {
        const bf16* qp = QKV + (size_t)t * NQKV + h * 64;
        _Pragma("unroll") for (int d = 0; d < 64; ++d) { q[d] = bf2f(qp[d]) * (1.0f / C2_LOCAL); o[d] = 0.f; }
        float mb[3], denb[3];
        _Pragma("unroll") for (int b = 0; b < 3; ++b) { const int dil = b == 0 ? 1 : (b == 1 ? 4 : 16); float mx = -3e38f;
            for (int j = -64; j <= 64; ++j) { const int u = t + dil * j; if (u < 0 || u >= S) continue;
                const bf16* kp = QKV + (size_t)u * NQKV + 512 + h * 64; float sc = 0.f; _Pragma("unroll") for (int d = 0; d < 64; ++d) sc += q[d] * bf2f(kp[d]);
                sc = sc * 0.125f + t5[t5_bucket_precise(dil * j) * 16 + h]; mx = fmaxf(mx, sc); }
            float den = 0.f;
            for (int j = -64; j <= 64; ++j) { const int u = t + dil * j; if (u < 0 || u >= S) continue;
                const bf16* kp = QKV + (size_t)u * NQKV + 512 + h * 64; float sc = 0.f; _Pragma("unroll") for (int d = 0; d < 64; ++d) sc += q[d] * bf2f(kp[d]);
                sc = sc * 0.125f + t5[t5_bucket_precise(dil * j) * 16 + h]; den += expf(sc - mx); }
            mb[b] = mx; denb[b] = den; }
        float lse[3], M = -3e38f; _Pragma("unroll") for (int b = 0; b < 3; ++b) { lse[b] = mb[b] + logf(denb[b]); M = fmaxf(M, lse[b]); }
        float wsum = 0.f, wb[3]; _Pragma("unroll") for (int b = 0; b < 3; ++b) { wb[b] = expf(lse[b] - M); wsum += wb[b]; }
        _Pragma("unroll") for (int b = 0; b < 3; ++b) { const int dil = b == 0 ? 1 : (b == 1 ? 4 : 16); const float coef = wb[b] / wsum / denb[b];
            for (int j = -64; j <= 64; ++j) { const int u = t + dil * j; if (u < 0 || u >= S) continue;
                const bf16* kp = QKV + (size_t)u * NQKV + 512 + h * 64; const bf16* vp = QKV + (size_t)u * NQKV + 1024 + h * 64; float sc = 0.f; _Pragma("unroll") for (int d = 0; d < 64; ++d) sc += q[d] * bf2f(kp[d]);
                sc = sc * 0.125f + t5[t5_bucket_precise(dil * j) * 16 + h]; const float p = expf(sc - mb[b]) * coef;
                _Pragma("unroll") for (int d = 0; d < 64; ++d) o[d] += p * bf2f(vp[d]); } }
        const bf16* op = O + (size_t)t * D + h * 64;
        _Pragma("unroll") for (int d = 0; d < 64; ++d) { const float g = bf2f(op[d]); err += (g - o[d]) * (g - o[d]); r2 += o[d] * o[d]; }
    } else {
        const int hb = h - 8, r = t >> 6, c = t & 63;
        int r0 = r - 4; r0 = r0 < 0 ? 0 : (r0 > 248 ? 248 : r0); int c0 = c - 8; c0 = c0 < 0 ? 0 : (c0 > 48 ? 48 : c0);
        const bf16* qp = QKV + (size_t)t * NQKV + 1536 + hb * 64;
        _Pragma("unroll") for (int d = 0; d < 64; ++d) { q[d] = bf2f(qp[d]) * (1.0f / C2_LOCAL); o[d] = 0.f; }
        float mx = -3e38f;
        for (int kr = 0; kr < 8; ++kr) for (int kc = c0; kc < c0 + 16; ++kc) { const int u = (r0 + kr) * 64 + kc;
            const bf16* kp = QKV + (size_t)u * NQKV + 2048 + hb * 64; float sc = 0.f; _Pragma("unroll") for (int d = 0; d < 64; ++d) sc += q[d] * bf2f(kp[d]);
            sc = sc * 0.125f + rpb[(hb * 15 + (r0 + kr - r + 7)) * 31 + (kc - c + 15)]; mx = fmaxf(mx, sc); }
        float den = 0.f;
        for (int kr = 0; kr < 8; ++kr) for (int kc = c0; kc < c0 + 16; ++kc) { const int u = (r0 + kr) * 64 + kc;
            const bf16* kp = QKV + (size_t)u * NQKV + 2048 + hb * 64; const bf16* vp = QKV + (size_t)u * NQKV + 2560 + hb * 64; float sc = 0.f; _Pragma("unroll") for (int d = 0; d < 64; ++d) sc += q[d] * bf2f(kp[d]);
            sc = sc * 0.125f + rpb[(hb * 15 + (r0 + kr - r + 7)) * 31 + (kc - c + 15)]; const float p = expf(sc - mx); den += p;
            _Pragma("unroll") for (int d = 0; d < 64; ++d) o[d] += p * bf2f(vp[d]); }
        const bf16* op = O + (size_t)t * D + 512 + hb * 64;
        _Pragma("unroll") for (int d = 0; d < 64; ++d) { const float g = bf2f(op[d]); const float rf = o[d] / den; err += (g - rf) * (g - rf); r2 += rf * rf; }
    }
    accum(err, r2, stats, slot);
}
__global__ void __launch_bounds__(256) k_chk_mla(const bf16* Q1, const bf16* K1, const bf16* V1, const float* t5, const bf16* O, float* stats, int slot) {
    const int i = blockIdx.x >> 4, h = blockIdx.x & 15, t = 256 * i + ((i * 37) & 255), tid = threadIdx.x;
    __shared__ float qs[96], red[8], so[64];
    if (tid < 96) qs[tid] = bf2f(Q1[(size_t)t * NQ1 + h * 96 + tid]);
    if (tid < 64) so[tid] = 0.f;
    __syncthreads();
    float mx = -3e38f;
    for (int k = tid; k < S; k += 256) { const bf16* kp = K1 + (size_t)k * KPITCH + h * 96; float sc = 0.f; _Pragma("unroll") for (int d = 0; d < 96; ++d) sc += qs[d] * bf2f(kp[d]);
        sc += t5[t5_bucket_precise(k - t) * 16 + h] * LOG2E; mx = fmaxf(mx, sc); }
    for (int o = 1; o < 64; o <<= 1) mx = fmaxf(mx, __shfl_xor(mx, o));
    if ((tid & 63) == 0) red[tid >> 6] = mx;
    __syncthreads();
    mx = fmaxf(fmaxf(red[0], red[1]), fmaxf(red[2], red[3]));
    __syncthreads();
    float den = 0.f, o[64];
    _Pragma("unroll") for (int d = 0; d < 64; ++d) o[d] = 0.f;
    for (int k = tid; k < S; k += 256) { const bf16* kp = K1 + (size_t)k * KPITCH + h * 96; const bf16* vp = V1 + (size_t)k * D + h * 64; float sc = 0.f; _Pragma("unroll") for (int d = 0; d < 96; ++d) sc += qs[d] * bf2f(kp[d]);
        sc += t5[t5_bucket_precise(k - t) * 16 + h] * LOG2E; const float p = exp2f(sc - mx); den += p;
        _Pragma("unroll") for (int d = 0; d < 64; ++d) o[d] += p * bf2f(vp[d]); }
    den = wave_sum(den);
    if ((tid & 63) == 0) red[4 + (tid >> 6)] = den;
    _Pragma("unroll") for (int d = 0; d < 64; ++d) { const float v = wave_sum(o[d]); if ((tid & 63) == 0) atomicAdd(&so[d], v); }
    __syncthreads();
    den = red[4] + red[5] + red[6] + red[7];
    float err = 0.f, r2 = 0.f;
    if (tid < 64) { const float rf = so[tid] / den, g = bf2f(O[(size_t)t * D + h * 64 + tid]); err = (g - rf) * (g - rf); r2 = rf * rf; }
    accum(err, r2, stats, slot);
}
__global__ void k_chk_final(const float* save, const float* rs, const float* gf, const float* outp, float* stats, int slot) {
    const int i = blockIdx.x, m = srow(i); float err = 0.f, r2 = 0.f;
    for (int k = threadIdx.x; k < D; k += 256) { const float ref = save[(size_t)i * D + k] * rs[i] * gf[k], g = outp[(size_t)m * D + k]; err += (g - ref) * (g - ref); r2 += ref * ref; }
    accum(err, r2, stats, slot);
}
__global__ void k_finalize(const float* stats, float* outp, float tol, int magslot) {
    if (threadIdx.x != 0 || blockIdx.x != 0) return;
    int fail = 0; float relf = 0.f;
    for (int s = 1; s <= 16; ++s) { const float e = stats[2 * s], r = stats[2 * s + 1]; const float rel = sqrtf(e / fmaxf(r, 1e-30f)); const bool bad = !(rel <= tol) || !(r > 0.f);
        if (bad && !fail) { fail = s; relf = rel; } }
    if (magslot > 0) { const float e = stats[2 * magslot], r = stats[2 * magslot + 1]; outp[0] += 1.0e4f * fminf(sqrtf(e / fmaxf(r, 1e-30f)), 10.f) + 1.0f; }
    else if (fail) outp[0] += 100.0f + 10.0f * fail;
}
}

#endif

extern "C" void kernel_launch(void* const* d_in, const int* in_sizes, int n_in, void* d_out, int out_size, void* d_ws, size_t ws_size, hipStream_t stream) {
    static int grid = 0;
    if (grid == 0) {
        if (n_in != 18 || in_sizes[0] != S * D || out_size != S * D || ws_size < WS_END) { fprintf(stderr, "kernel_launch: unexpected shapes (n_in %d, in0 %d, out %d, ws %zu)\n", n_in, n_in > 0 ? in_sizes[0] : -1, out_size, ws_size); grid = -1; return; }
        int dev = 0, cus = 0, per_cu = 0;
        if (hipGetDevice(&dev) != hipSuccess || hipDeviceGetAttribute(&cus, hipDeviceAttributeMultiprocessorCount, dev) != hipSuccess) { grid = -1; return; }
        if (hipFuncSetAttribute((const void*)fwd_kernel, hipFuncAttributeMaxDynamicSharedMemorySize, LDS_BYTES) != hipSuccess) { fprintf(stderr, "kernel_launch: hipFuncSetAttribute failed\n"); grid = -1; return; }
        if (hipOccupancyMaxActiveBlocksPerMultiprocessor(&per_cu, (const void*)fwd_kernel, NWAVES * 64, LDS_BYTES) != hipSuccess || per_cu < 1) fprintf(stderr, "kernel_launch: occupancy query reports %d\n", per_cu);
        (void)hipGetLastError();
        grid = cus;
        if (grid != 256) fprintf(stderr, "kernel_launch: %d CUs; this kernel's unit maps assume 256\n", grid);
    }
    if (grid < 0) return;
    (void)hipMemsetAsync((char*)d_ws + WS_CTL, 0, CTL_ZERO_BYTES, stream);
    Args a{};
    for (int i = 0; i < 18; ++i) a.in[i] = (const float*)d_in[i];
    a.out = (float*)d_out; a.ws = (unsigned char*)d_ws;
#if DBG_CHECK
    {
        using namespace dbg;
        unsigned char* ws = (unsigned char*)d_ws; float* outp = (float*)d_out;
        float* stats = (float*)(ws + CTL_STATS); float* rstd = (float*)(ws + CTL_RSTD); float* rstd2 = rstd + 1024; float* save = (float*)(ws + WS_SAVE);
        bf16* XBp = (bf16*)(ws + WS_XB); bf16* OBp = (bf16*)(ws + WS_O); bf16* BIGp = (bf16*)(ws + WS_BIG); bf16* Q1p = (bf16*)(ws + WS_Q1); bf16* K1p = (bf16*)(ws + WS_K1); bf16* V1p = (bf16*)(ws + WS_V1);
        const float* x = a.in[I_X];
        for (int ph = 0; ph < NPH; ++ph) {
            if (ph == 5 || ph == 9 || ph == 11 || ph == 12) hipLaunchKernelGGL(k_save_rows, dim3(NSAMP), dim3(256), 0, stream, (const float*)outp, save);
            a.ph_lo = ph; a.ph_hi = ph + 1;
            hipLaunchKernelGGL(fwd_kernel, dim3(grid), dim3(NWAVES * 64), LDS_BYTES, stream, a);
            switch (ph) {
            case 1: hipLaunchKernelGGL(k_rowrstd, dim3(NSAMP), dim3(64), 0, stream, x, D, D, 0, rstd);
                hipLaunchKernelGGL((k_chk_lin<0, 1>), dim3(12, NSAMP), dim3(256), 0, stream, (const void*)x, D, 0, (const float*)rstd, a.in[I_ANORM], a.in[I_EWIN], NQKV, D, NQKV, (const float*)nullptr, 0, 0, (const void*)BIGp, NQKV, 1.0f, stats, 1); break;
            case 2: hipLaunchKernelGGL(k_chk_local, dim3(512 * 16 / 64), dim3(64), 0, stream, (const bf16*)BIGp, a.in[I_T5], a.in[I_RPB], (const bf16*)OBp, stats, 2); break;
            case 3: hipLaunchKernelGGL((k_chk_lin<1, 0>), dim3(4, NSAMP), dim3(256), 0, stream, (const void*)OBp, D, 0, (const float*)nullptr, (const float*)nullptr, a.in[I_EWOUT], D, D, D, x, D, 0, (const void*)outp, D, 1.0f, stats, 3);
                hipLaunchKernelGGL((k_chk_lin<1, 1>), dim3(4, NSAMP), dim3(256), 0, stream, (const void*)OBp, D, 0, (const float*)nullptr, (const float*)nullptr, a.in[I_EWOUT], D, D, D, x, D, 0, (const void*)XBp, D, 1.0f, stats, 16); break;
            case 4: hipLaunchKernelGGL(k_rowrstd, dim3(NSAMP), dim3(64), 0, stream, (const float*)outp, D, D, 0, rstd);
                hipLaunchKernelGGL(k_chk_swiglu, dim3(11, NSAMP), dim3(256), 0, stream, (const float*)outp, (const float*)rstd, a.in[I_FNORM], a.in[I_WG], a.in[I_WU], (const bf16*)BIGp, stats, 4); break;
            case 5: hipLaunchKernelGGL((k_chk_lin<1, 0>), dim3(4, NSAMP), dim3(256), 0, stream, (const void*)BIGp, FF, 0, (const float*)nullptr, (const float*)nullptr, a.in[I_WD], D, FF, D, (const float*)save, D, 1, (const void*)outp, D, 1.0f, stats, 5); break;
            case 6: hipLaunchKernelGGL(k_rowrstd, dim3(NSAMP), dim3(64), 0, stream, (const float*)outp, D, D, 0, rstd);
                hipLaunchKernelGGL((k_chk_lin<0, 1>), dim3(2, NSAMP), dim3(256), 0, stream, (const void*)outp, D, 0, (const float*)rstd, a.in[I_ANORM] + D, a.in[I_OWIN], NIN1, D, 512, (const float*)nullptr, 0, 0, (const void*)OBp, NIN1P, 1.0f, stats, 6);
                hipLaunchKernelGGL(k_chk_krope, dim3(NSAMP), dim3(64), 0, stream, (const float*)outp, (const float*)rstd, a.in[I_ANORM] + D, a.in[I_OWIN], (const bf16*)K1p, stats, 7); break;
            case 7: hipLaunchKernelGGL(k_rowrstd_bf, dim3(NSAMP), dim3(64), 0, stream, (const bf16*)OBp, NIN1P, QL, rstd);
                hipLaunchKernelGGL(k_rowrstd_bf, dim3(NSAMP), dim3(64), 0, stream, (const bf16*)OBp + QL, NIN1P, KVL, rstd2);
                hipLaunchKernelGGL(k_chk_q, dim3(6, NSAMP), dim3(256), 0, stream, (const bf16*)OBp, (const float*)rstd, a.in[I_QNORM], a.in[I_WUQ], (const bf16*)Q1p, stats, 8);
                hipLaunchKernelGGL(k_chk_kv, dim3(4, NSAMP), dim3(256), 0, stream, (const bf16*)OBp, (const float*)rstd2, a.in[I_KVNORM], a.in[I_WUK], (const bf16*)K1p, 1, stats, 9);
                hipLaunchKernelGGL(k_chk_kv, dim3(4, NSAMP), dim3(256), 0, stream, (const bf16*)OBp, (const float*)rstd2, a.in[I_KVNORM], a.in[I_WUV], (const bf16*)V1p, 0, stats, 10); break;
            case 8: hipLaunchKernelGGL(k_chk_mla, dim3(64 * 16), dim3(256), 0, stream, (const bf16*)Q1p, (const bf16*)K1p, (const bf16*)V1p, a.in[I_T5], (const bf16*)OBp, stats, 11); break;
            case 9: hipLaunchKernelGGL((k_chk_lin<1, 0>), dim3(4, NSAMP), dim3(256), 0, stream, (const void*)OBp, D, 0, (const float*)nullptr, (const float*)nullptr, a.in[I_OWOUT], D, D, D, (const float*)save, D, 1, (const void*)outp, D, 1.0f, stats, 12); break;
            case 10: hipLaunchKernelGGL(k_rowrstd, dim3(NSAMP), dim3(64), 0, stream, (const float*)outp, D, D, 0, rstd);
                hipLaunchKernelGGL(k_chk_swiglu, dim3(11, NSAMP), dim3(256), 0, stream, (const float*)outp, (const float*)rstd, a.in[I_FNORM] + D, a.in[I_WG] + (size_t)D * FF, a.in[I_WU] + (size_t)D * FF, (const bf16*)BIGp, stats, 13); break;
            case 11: hipLaunchKernelGGL((k_chk_lin<1, 0>), dim3(4, NSAMP), dim3(256), 0, stream, (const void*)BIGp, FF, 0, (const float*)nullptr, (const float*)nullptr, a.in[I_WD] + (size_t)FF * D, D, FF, D, (const float*)save, D, 1, (const void*)outp, D, 1.0f, stats, 14); break;
            case 12: hipLaunchKernelGGL(k_rowrstd, dim3(NSAMP), dim3(64), 0, stream, (const float*)save, D, D, 1, rstd);
                hipLaunchKernelGGL(k_chk_final, dim3(NSAMP), dim3(256), 0, stream, (const float*)save, (const float*)rstd, a.in[I_FINAL], (const float*)outp, stats, 15); break;
            default: break;
            }
        }
        hipLaunchKernelGGL(k_finalize, dim3(1), dim3(64), 0, stream, (const float*)stats, outp, DBG_TOL, DBG_MAGSLOT);
    }
#else
    a.ph_lo = 0; a.ph_hi = NPH;
    hipLaunchKernelGGL(fwd_kernel, dim3(grid), dim3(NWAVES * 64), LDS_BYTES, stream, a);
#endif
}
```
